# Optimizing an MI355X kernel written in HIP

```python
import math
import jax, jax.numpy as jnp
from jax import lax
import numpy as np

D_MODEL = 2048
BATCH = 2
SEQ = 4096
DEPTH = 1

MEM_LEN = 256
CONV_WIDTH = D_MODEL // 2
CONV_GROUPS = 8
CONV_KERNEL = 31
DIFF_HEADS = 8
DIFF_HEAD_DIM = (D_MODEL - CONV_WIDTH) // DIFF_HEADS // 2
DIFF_V_DIM = 2 * DIFF_HEAD_DIM
ATTN_QK_WIDTH = DIFF_HEADS * 2 * DIFF_HEAD_DIM
ATTN_V_WIDTH = DIFF_HEADS * DIFF_V_DIM
MIX_WIDTH = CONV_WIDTH + ATTN_V_WIDTH
IN_WIDTH = 2 * CONV_WIDTH + 2 * ATTN_QK_WIDTH + ATTN_V_WIDTH
Q_BLOCK = 128
CROSS_HEADS = 4
CROSS_HEAD_DIM = D_MODEL // CROSS_HEADS
PEER_HEADS = 8
PEER_N_KEYS = 128
PEER_N_EXPERTS = PEER_N_KEYS * PEER_N_KEYS
PEER_TOPK = 16
PEER_KEY_DIM = 256
PEER_HALF = PEER_KEY_DIM // 2
PEER_CHUNK = 128
RMS_EPS = 1e-6
LN_EPS = 1e-5
NEG_INF = -1e30

kernel_name = "hybrid_conv_diffattn_peer_block"


def rmsnorm(x, g):
    xf = x.astype(jnp.float32)
    y = xf * lax.rsqrt(jnp.mean(xf * xf, axis=-1, keepdims=True) + RMS_EPS)
    return (y * g.astype(jnp.float32)).astype(x.dtype)


def lambda_init_for(layer_idx):
    return 0.8 - 0.6 * math.exp(-0.3 * layer_idx)


def conformer_conv_group(z, w_dw, b_dw, ln_g, ln_b):
    B, S, _ = z.shape
    a, gate = jnp.split(z, 2, axis=-1)
    u = a * jax.nn.sigmoid(gate)
    y = lax.conv_general_dilated(
        u, w_dw[:, None, :].astype(u.dtype), window_strides=(1,),
        padding=[(CONV_KERNEL - 1, 0)],
        dimension_numbers=('NWC', 'WIO', 'NWC'),
        feature_group_count=CONV_WIDTH) + b_dw
    yf = y.astype(jnp.float32).reshape(B, S, CONV_GROUPS, CONV_WIDTH // CONV_GROUPS)
    mu = jnp.mean(yf, axis=-1, keepdims=True)
    var = jnp.mean(jnp.square(yf - mu), axis=-1, keepdims=True)
    yf = ((yf - mu) * lax.rsqrt(var + LN_EPS)).reshape(B, S, CONV_WIDTH)
    yf = yf * ln_g.astype(jnp.float32) + ln_b.astype(jnp.float32)
    return jax.nn.silu(yf).astype(z.dtype)


def diff_attention_group(q, k, v, lam, subln_g, lam_init):
    B, S = q.shape[0], q.shape[1]
    nb = S // Q_BLOCK
    scale = DIFF_HEAD_DIM ** -0.5
    k_pos = jnp.arange(S)

    def block(i):
        qb = lax.dynamic_slice_in_dim(q, i * Q_BLOCK, Q_BLOCK, axis=1)
        s = jnp.einsum('bqhcd,bkhcd->bchqk', qb, k).astype(jnp.float32) * scale
        q_pos = i * Q_BLOCK + jnp.arange(Q_BLOCK)
        mask = k_pos[None, :] <= q_pos[:, None]
        p = jax.nn.softmax(jnp.where(mask, s, NEG_INF), axis=-1)
        a = p[:, 0] - lam * p[:, 1]
        o = jnp.einsum('bhqk,bkhd->bqhd', a.astype(v.dtype), v)
        of = o.astype(jnp.float32)
        of = of * lax.rsqrt(jnp.mean(of * of, axis=-1, keepdims=True) + RMS_EPS)
        of = of * subln_g.astype(jnp.float32) * (1.0 - lam_init)
        return of.astype(v.dtype)

    out = lax.map(block, jnp.arange(nb))
    return out.transpose(1, 0, 2, 3, 4).reshape(B, S, ATTN_V_WIDTH)


def memory_cross_attention(hn, mem, mem_g, w_cq, w_ckv, w_co):
    B, S, D = hn.shape
    mn = rmsnorm(mem, mem_g)
    q = (hn @ w_cq).reshape(B, S, CROSS_HEADS, CROSS_HEAD_DIM)
    kv = (mn @ w_ckv).reshape(B, mem.shape[1], 2, CROSS_HEADS, CROSS_HEAD_DIM)
    k, v = kv[:, :, 0], kv[:, :, 1]
    s = jnp.einsum('bqhd,bkhd->bhqk', q, k).astype(jnp.float32) * (CROSS_HEAD_DIM ** -0.5)
    p = jax.nn.softmax(s, axis=-1).astype(v.dtype)
    o = jnp.einsum('bhqk,bkhd->bqhd', p, v).reshape(B, S, D)
    return o @ w_co


def peer_ffn(xn, w_pq, keys1, keys2, u_tab, v_tab):
    B, S, D = xn.shape
    T = B * S
    xt = xn.reshape(T, D)
    q = (xt @ w_pq).reshape(T, PEER_HEADS, 2, PEER_HALF)
    s1 = jnp.einsum('thd,hnd->thn', q[:, :, 0], keys1).astype(jnp.float32)
    s2 = jnp.einsum('thd,hnd->thn', q[:, :, 1], keys2).astype(jnp.float32)
    v1, i1 = lax.top_k(s1, PEER_TOPK)
    v2, i2 = lax.top_k(s2, PEER_TOPK)
    cand = (v1[..., :, None] + v2[..., None, :]).reshape(T, PEER_HEADS, PEER_TOPK * PEER_TOPK)
    sc, ci = lax.top_k(cand, PEER_TOPK)
    e1 = jnp.take_along_axis(i1, ci // PEER_TOPK, axis=-1)
    e2 = jnp.take_along_axis(i2, ci % PEER_TOPK, axis=-1)
    ids = (e1 * PEER_N_KEYS + e2).reshape(T, PEER_HEADS * PEER_TOPK)
    g = jax.nn.softmax(sc, axis=-1).reshape(T, PEER_HEADS * PEER_TOPK)

    def chunk(args):
        xc, idc, gc = args
        uc = jnp.take(u_tab, idc, axis=0)
        h = jnp.einsum('cd,ckd->ck', xc, uc)
        w = gc.astype(xc.dtype) * jax.nn.gelu(h, approximate=False)
        return jnp.einsum('ck,ckd->cd', w, jnp.take(v_tab, idc, axis=0))

    nc = T // PEER_CHUNK
    y = lax.map(chunk, (xt.reshape(nc, PEER_CHUNK, D),
                        ids.reshape(nc, PEER_CHUNK, -1),
                        g.reshape(nc, PEER_CHUNK, -1)))
    return y.reshape(B, S, D)


def setup_inputs(seed: int = 0) -> dict:
    key = jax.random.key(seed)
    ks = iter(jax.random.split(key, 32))
    L, D = DEPTH, D_MODEL
    f32 = jnp.float32

    def nrm(shape, scale):
        return jax.random.normal(next(ks), shape, f32) * scale

    def gain(shape):
        return 1.0 + 0.02 * jax.random.normal(next(ks), shape, f32)

    return {
        "x": nrm((BATCH, SEQ, D), 1.0),
        "mem": nrm((BATCH, MEM_LEN, D), 1.0),
        "norm_mix_g": gain((L, D)),
        "w_in": nrm((L, D, IN_WIDTH), D ** -0.5),
        "conv_dw_w": nrm((L, CONV_KERNEL, CONV_WIDTH), CONV_KERNEL ** -0.5),
        "conv_dw_b": nrm((L, CONV_WIDTH), 0.02),
        "conv_ln_g": gain((L, CONV_WIDTH)),
        "conv_ln_b": nrm((L, CONV_WIDTH), 0.02),
        "lambda_q1": nrm((L, DIFF_HEAD_DIM), 0.1),
        "lambda_k1": nrm((L, DIFF_HEAD_DIM), 0.1),
        "lambda_q2": nrm((L, DIFF_HEAD_DIM), 0.1),
        "lambda_k2": nrm((L, DIFF_HEAD_DIM), 0.1),
        "diff_subln_g": gain((L, DIFF_V_DIM)),
        "w_out": nrm((L, MIX_WIDTH, D), MIX_WIDTH ** -0.5),
        "norm_cross_g": gain((L, D)),
        "norm_mem_g": gain((L, D)),
        "w_cq": nrm((L, D, D), D ** -0.5),
        "w_ckv": nrm((L, D, 2 * D), D ** -0.5),
        "w_co": nrm((L, D, D), D ** -0.5),
        "norm_peer_g": gain((L, D)),
        "w_pq": nrm((L, D, PEER_HEADS * PEER_KEY_DIM), D ** -0.5),
        "peer_keys1": nrm((L, PEER_HEADS, PEER_N_KEYS, PEER_HALF), PEER_HALF ** -0.5),
        "peer_keys2": nrm((L, PEER_HEADS, PEER_N_KEYS, PEER_HALF), PEER_HALF ** -0.5),
        "peer_u": nrm((L, PEER_N_EXPERTS, D), D ** -0.5),
        "peer_v": nrm((L, PEER_N_EXPERTS, D), PEER_HEADS ** -0.5),
        "final_norm_g": gain((D,)),
    }


def reference(x, mem, norm_mix_g, w_in, conv_dw_w, conv_dw_b, conv_ln_g, conv_ln_b,
              lambda_q1, lambda_k1, lambda_q2, lambda_k2, diff_subln_g, w_out,
              norm_cross_g, norm_mem_g, w_cq, w_ckv, w_co,
              norm_peer_g, w_pq, peer_keys1, peer_keys2, peer_u, peer_v, final_norm_g):
    B, S, D = x.shape
    h = x
    for l in range(DEPTH):
        hn = rmsnorm(h, norm_mix_g[l])
        z = hn @ w_in[l]
        o0 = 2 * CONV_WIDTH
        o1 = o0 + ATTN_QK_WIDTH
        o2 = o1 + ATTN_QK_WIDTH
        conv_out = conformer_conv_group(z[..., :o0], conv_dw_w[l], conv_dw_b[l],
                                        conv_ln_g[l], conv_ln_b[l])
        q = z[..., o0:o1].reshape(B, S, DIFF_HEADS, 2, DIFF_HEAD_DIM)
        k = z[..., o1:o2].reshape(B, S, DIFF_HEADS, 2, DIFF_HEAD_DIM)
        v = z[..., o2:].reshape(B, S, DIFF_HEADS, DIFF_V_DIM)
        lam_init = lambda_init_for(l)
        lam = (jnp.exp(jnp.sum(lambda_q1[l].astype(jnp.float32) * lambda_k1[l].astype(jnp.float32)))
               - jnp.exp(jnp.sum(lambda_q2[l].astype(jnp.float32) * lambda_k2[l].astype(jnp.float32)))
               + lam_init)
        attn_out = diff_attention_group(q, k, v, lam, diff_subln_g[l], lam_init)
        mix = jnp.concatenate([conv_out, attn_out], axis=-1)
        h = h + mix @ w_out[l]
        h = h + memory_cross_attention(rmsnorm(h, norm_cross_g[l]), mem, norm_mem_g[l],
                                       w_cq[l], w_ckv[l], w_co[l])
        h = h + peer_ffn(rmsnorm(h, norm_peer_g[l]), w_pq[l], peer_keys1[l], peer_keys2[l],
                         peer_u[l], peer_v[l])
    return rmsnorm(h, final_norm_g)
```

```cpp
#include <hip/hip_runtime.h>
#include <hip/hip_bf16.h>
#include <cstdio>
#include <cstdint>
#include <cmath>

#ifndef MK_LAUNCH_PER_PHASE
#define MK_LAUNCH_PER_PHASE 1
#endif
#ifndef MK_NAIVE_GEMM
#define MK_NAIVE_GEMM 0
#endif
#ifndef MK_NAIVE_ATTN
#define MK_NAIVE_ATTN 0
#endif

namespace pg8 {
#define PG8_LAS __attribute__((address_space(3)))
typedef unsigned short bf16_t;
typedef short bf16x8 __attribute__((ext_vector_type(8)));
typedef float f32x4 __attribute__((ext_vector_type(4)));
typedef unsigned u32x4 __attribute__((ext_vector_type(4)));
typedef float f32x2_t __attribute__((ext_vector_type(2)));
typedef __bf16 bf16x2_t __attribute__((ext_vector_type(2)));
constexpr int BM = 256, BK = 64, HALF = 128, HTB = HALF * BK * 2  , STAGE_BYTES = 8 * HTB, NXCD = 8, WGM = 8;

__host__ __device__ __forceinline__ int lds_byte(int r, int c) { const int st = (r >> 4) * 2 + (c >> 5), rr = r & 15, cc = c & 31, ob = rr * 64 + cc * 2; return st * 1024 + (ob ^ (((ob >> 9) & 1) << 5)); }
__host__ __device__ __forceinline__ void stage_rc(int b, int& R, int& C) { const int st = b / 1024, sb = b % 1024, swz = sb ^ (((sb >> 9) & 1) << 5); R = (st >> 1) * 16 + swz / 64; C = (st & 1) * 32 + (swz % 64) / 2; }
__host__ __device__ __forceinline__ int perm32(int rho) { const int n = rho >> 4, i = rho & 15; return 8 * (i >> 2) + 4 * n + (i & 3); }

struct Unit { int pm, pn, z; };
struct Gemm { const bf16_t* A; const bf16_t* Bt; int lda, ldb, K, Z1; long sa0, sa1, sb0, sb1; };
__device__ __forceinline__ const char* a_tile(const Gemm& g, const Unit& u) { const int z0 = u.z / g.Z1, z1 = u.z % g.Z1; return (const char*)(g.A + z0 * g.sa0 + z1 * g.sa1 + (long)u.pm * BM * g.lda); }
__device__ __forceinline__ const char* b_tile(const Gemm& g, const Unit& u) { const int z0 = u.z / g.Z1, z1 = u.z % g.Z1; return (const char*)(g.Bt + z0 * g.sb0 + z1 * g.sb1 + (long)u.pn * BM * g.ldb); }

struct TileOrder {
    int nM, nN, per, nwg, G, c;
    __device__ __forceinline__ void init(int nM_, int nN_, int Z, int G_, int c_) { nM = nM_; nN = nN_; per = nM_ * nN_; nwg = per * Z; G = G_; c = c_; }
    __device__ __forceinline__ bool next(int i, Unit& u) const {
        if (c < 0) return false;
        const long L = (long)i * G + c; if (L >= nwg) return false;
        int wgid = (int)L; { const int q = nwg / NXCD, r = nwg % NXCD, xcd = wgid % NXCD, off = wgid / NXCD; wgid = (xcd < r ? xcd * (q + 1) : r * (q + 1) + (xcd - r) * q) + off; }
        u.z = wgid / per; const int w = wgid % per;
        const int nig = WGM * nN, gid = w / nig, fm = gid * WGM, gsz = (nM - fm) < WGM ? (nM - fm) : WGM;
        u.pm = fm + ((w % nig) % gsz); u.pn = (w % nig) / gsz; return true;
    }
    __device__ __forceinline__ void a_ready(const Unit&) const {}
    __device__ __forceinline__ void done(const Unit&) const {}
};

__device__ __forceinline__ unsigned pk2(float lo, float hi) { f32x2_t v = {lo, hi}; bf16x2_t b = __builtin_convertvector(v, bf16x2_t); return __builtin_bit_cast(unsigned, b); }
__device__ __forceinline__ u32x4 pk8(const f32x4& a, const f32x4& b) { u32x4 w; w.x = pk2(a[0], a[1]); w.y = pk2(a[2], a[3]); w.z = pk2(b[0], b[1]); w.w = pk2(b[2], b[3]); return w; }
__device__ __forceinline__ float dot2bf(unsigned a, unsigned b, float c) { return __builtin_amdgcn_fdot2_f32_bf16(__builtin_bit_cast(bf16x2_t, a), __builtin_bit_cast(bf16x2_t, b), c, false); }

__device__ __forceinline__ float rstd_from_parts(const float* part, int row) {
    const f32x4* p = (const f32x4*)(part + (size_t)row * 32); float s = 0.f;
#pragma unroll
    for (int i = 0; i < 8; ++i) { const f32x4 v = p[i]; s += (v[0] + v[1]) + (v[2] + v[3]); }
    return 1.0f / sqrtf(s * (1.0f / 2048.0f) + 1e-6f);
}


struct EpiZ {
    static constexpr bool PERM = true, AFTER_DRAIN = false;
    bf16_t *U, *Q; long qkv_stride; float qscale;
    __device__ __forceinline__ void operator()(const f32x4 (&acc)[2][2][4][2], const Unit& u, int wr, int wc, int fr, int fq) const {
        const int row0 = u.pm * BM + wr * 64 + fr;
        if (u.pn < 8) {
            const int col = 128 * u.pn + 32 * wc + 8 * fq;
#pragma unroll
            for (int ai = 0; ai < 2; ++ai)
#pragma unroll
                for (int m = 0; m < 4; ++m) {
                    f32x4 o[2];
#pragma unroll
                    for (int n = 0; n < 2; ++n)
#pragma unroll
                        for (int e = 0; e < 4; ++e) { const float a = acc[ai][0][m][n][e], g = acc[ai][1][m][n][e]; o[n][e] = a * __builtin_amdgcn_rcpf(1.0f + __builtin_amdgcn_exp2f(-1.4426950408889634f * g)); }
                    *(u32x4*)(U + (size_t)(row0 + ai * HALF + m * 16) * 1024 + col) = pk8(o[0], o[1]);
                }
        } else {
            const int t = (u.pn - 8) >> 2; bf16_t* base = Q + (long)t * qkv_stride; const float sc = (t == 0) ? qscale : 1.0f;
            const int colt = ((u.pn - 8) & 3) * BM + 32 * wc + 8 * fq;
#pragma unroll
            for (int ai = 0; ai < 2; ++ai)
#pragma unroll
                for (int m = 0; m < 4; ++m)
#pragma unroll
                    for (int bj = 0; bj < 2; ++bj) { const f32x4 v0 = acc[ai][bj][m][0] * sc, v1 = acc[ai][bj][m][1] * sc;
                        *(u32x4*)(base + (size_t)(row0 + ai * HALF + m * 16) * 1024 + colt + bj * HALF) = pk8(v0, v1); }
        }
    }
};
struct EpiBf16S {
    static constexpr bool PERM = true, AFTER_DRAIN = false;
    bf16_t* O; int ldc, Z1; long so0, so1; const float* colscale; float cs;
    __device__ __forceinline__ void operator()(const f32x4 (&acc)[2][2][4][2], const Unit& u, int wr, int wc, int fr, int fq) const {
        const int row0 = u.pm * BM + wr * 64 + fr, col0 = u.pn * BM + wc * 32 + 8 * fq;
        bf16_t* base = O + (u.z / Z1) * so0 + (u.z % Z1) * so1;
        f32x4 sv[2][2];
#pragma unroll
        for (int bj = 0; bj < 2; ++bj)
#pragma unroll
            for (int n = 0; n < 2; ++n) { sv[bj][n] = colscale ? *(const f32x4*)(colscale + col0 + bj * HALF + 4 * n) : (f32x4){1.f, 1.f, 1.f, 1.f}; sv[bj][n] = sv[bj][n] * cs; }
#pragma unroll
        for (int ai = 0; ai < 2; ++ai)
#pragma unroll
            for (int m = 0; m < 4; ++m)
#pragma unroll
                for (int bj = 0; bj < 2; ++bj) { const f32x4 v0 = acc[ai][bj][m][0] * sv[bj][0], v1 = acc[ai][bj][m][1] * sv[bj][1];
                    *(u32x4*)(base + (size_t)(row0 + ai * HALF + m * 16) * ldc + col0 + bj * HALF) = pk8(v0, v1); }
    }
};
struct EpiRes {
    static constexpr bool PERM = true, AFTER_DRAIN = false;
    const float* res; float* H; bf16_t* Hb; float* part; int rows_per_z;
    __device__ __forceinline__ void operator()(const f32x4 (&acc)[2][2][4][2], const Unit& u, int wr, int wc, int fr, int fq) const {
        const int row0 = u.z * rows_per_z + u.pm * BM + wr * 64 + fr, colw = u.pn * BM + wc * 32 + 8 * fq;
#pragma unroll
        for (int ai = 0; ai < 2; ++ai)
#pragma unroll
            for (int m = 0; m < 4; ++m) { const int row = row0 + ai * HALF + m * 16; float ss = 0.f;
#pragma unroll
                for (int bj = 0; bj < 2; ++bj) { const size_t off = (size_t)row * 2048 + colw + bj * HALF;
                    const f32x4 h0 = *(const f32x4*)(res + off) + acc[ai][bj][m][0], h1 = *(const f32x4*)(res + off + 4) + acc[ai][bj][m][1];
                    *(f32x4*)(H + off) = h0; *(f32x4*)(H + off + 4) = h1; *(u32x4*)(Hb + off) = pk8(h0, h1);
                    ss += (h0[0] * h0[0] + h0[1] * h0[1]) + (h0[2] * h0[2] + h0[3] * h0[3]) + (h1[0] * h1[0] + h1[1] * h1[1]) + (h1[2] * h1[2] + h1[3] * h1[3]); }
                ss += __shfl_xor(ss, 16); ss += __shfl_xor(ss, 32);
                if (fq == 0) part[(size_t)row * 32 + u.pn * 4 + wc] = ss;
                if (m & 1) asm volatile("" ::: "memory"); }
    }
};
struct EpiScore {
    static constexpr bool PERM = true, AFTER_DRAIN = false;
    const float* part; float* S;
    __device__ __forceinline__ void operator()(const f32x4 (&acc)[2][2][4][2], const Unit& u, int wr, int wc, int fr, int fq) const {
        const int row0 = u.pm * BM + wr * 64 + fr, colw = u.pn * BM + wc * 32 + 8 * fq;
#pragma unroll
        for (int ai = 0; ai < 2; ++ai)
#pragma unroll
            for (int m = 0; m < 4; ++m) { const int row = row0 + ai * HALF + m * 16; const float rs = rstd_from_parts(part, row);
#pragma unroll
                for (int bj = 0; bj < 2; ++bj) { const size_t off = (size_t)row * 2048 + colw + bj * HALF;
                    *(f32x4*)(S + off) = acc[ai][bj][m][0] * rs; *(f32x4*)(S + off + 4) = acc[ai][bj][m][1] * rs; }
                asm volatile("" ::: "memory"); }
    }
};
struct EpiSoftmax {
    static constexpr bool PERM = true, AFTER_DRAIN = true;
    const float* part; bf16_t* P; int rows_per_z;
    __device__ __forceinline__ void fused(f32x4 (&acc)[2][2][4][2], const Unit& u, int wr, int wc, int fr, int fq, PG8_LAS unsigned char* lds, int wid, int lane) const {
        PG8_LAS float* Pm = (PG8_LAS float*)lds; PG8_LAS float* Ps = (PG8_LAS float*)(lds + 4096);
        const int rl0 = wr * 64 + fr, grow0 = u.z * rows_per_z + u.pm * BM + rl0;
#pragma unroll
        for (int ai = 0; ai < 2; ++ai)
#pragma unroll
            for (int m = 0; m < 4; ++m) { const float rs = rstd_from_parts(part, grow0 + ai * HALF + m * 16); float mx = -INFINITY;
#pragma unroll
                for (int bj = 0; bj < 2; ++bj)
#pragma unroll
                    for (int n = 0; n < 2; ++n) { acc[ai][bj][m][n] = acc[ai][bj][m][n] * rs; const f32x4 v = acc[ai][bj][m][n]; mx = fmaxf(mx, fmaxf(fmaxf(v[0], v[1]), fmaxf(v[2], v[3]))); }
                mx = fmaxf(mx, __shfl_xor(mx, 16)); mx = fmaxf(mx, __shfl_xor(mx, 32));
                if (fq == 0) Pm[(rl0 + ai * HALF + m * 16) * 4 + wc] = mx;
                asm volatile("" ::: "memory"); }
        asm volatile("s_waitcnt lgkmcnt(0)" ::: "memory"); __builtin_amdgcn_s_barrier(); asm volatile("" ::: "memory");
#pragma unroll
        for (int ai = 0; ai < 2; ++ai)
#pragma unroll
            for (int m = 0; m < 4; ++m) { const int rl = rl0 + ai * HALF + m * 16; const f32x4 q = *(const PG8_LAS f32x4*)(Pm + rl * 4);
                const float mx = fmaxf(fmaxf(q[0], q[1]), fmaxf(q[2], q[3])); float s = 0.f;
#pragma unroll
                for (int bj = 0; bj < 2; ++bj)
#pragma unroll
                    for (int n = 0; n < 2; ++n)
#pragma unroll
                        for (int e = 0; e < 4; ++e) { const float p = __builtin_amdgcn_exp2f(acc[ai][bj][m][n][e] - mx); acc[ai][bj][m][n][e] = p; s += p; }
                s += __shfl_xor(s, 16); s += __shfl_xor(s, 32);
                if (fq == 0) Ps[rl * 4 + wc] = s; }
        asm volatile("s_waitcnt lgkmcnt(0)" ::: "memory"); __builtin_amdgcn_s_barrier(); asm volatile("" ::: "memory");
#pragma unroll
        for (int ai = 0; ai < 2; ++ai)
#pragma unroll
            for (int m = 0; m < 4; ++m) { const int rl = rl0 + ai * HALF + m * 16; const f32x4 q = *(const PG8_LAS f32x4*)(Ps + rl * 4);
                const float inv = 1.0f / ((q[0] + q[1]) + (q[2] + q[3]));
#pragma unroll
                for (int bj = 0; bj < 2; ++bj) { const f32x4 v0 = acc[ai][bj][m][0] * inv, v1 = acc[ai][bj][m][1] * inv;
                    *(u32x4*)(P + (size_t)(grow0 + ai * HALF + m * 16) * 1024 + u.pn * BM + bj * HALF + wc * 32 + 8 * fq) = pk8(v0, v1); } }
        asm volatile("s_waitcnt lgkmcnt(0)" ::: "memory"); __builtin_amdgcn_s_barrier(); asm volatile("" ::: "memory");
    }
};

template <class Epi, class Sched>
__device__ __forceinline__ void gemm_phase_naive(PG8_LAS unsigned char* lds, const Gemm g, const Sched& S, const Epi& E) {
    const int tid = threadIdx.x, wid = __builtin_amdgcn_readfirstlane(tid >> 6), lane = tid & 63, wr = wid >> 2, wc = wid & 3, fr = lane & 15, fq = lane >> 4;
    Unit cur;
    for (int ui = 0; S.next(ui, cur); ++ui) {
        f32x4 acc[2][2][4][2];
#pragma unroll
        for (int a = 0; a < 2; ++a)
#pragma unroll
            for (int b = 0; b < 2; ++b)
#pragma unroll
                for (int m = 0; m < 4; ++m)
#pragma unroll
                    for (int n = 0; n < 2; ++n) acc[a][b][m][n] = (f32x4){0.f, 0.f, 0.f, 0.f};
        const bf16_t* At = (const bf16_t*)a_tile(g, cur); const bf16_t* Bt = (const bf16_t*)b_tile(g, cur);
        for (int k = 0; k < g.K; k += 8) {
            u32x4 a[2][4];
#pragma unroll
            for (int ai = 0; ai < 2; ++ai)
#pragma unroll
                for (int m = 0; m < 4; ++m) a[ai][m] = *(const u32x4*)(At + (size_t)(ai * HALF + wr * 64 + m * 16 + fr) * g.lda + k);
#pragma unroll
            for (int bj = 0; bj < 2; ++bj)
#pragma unroll
                for (int n = 0; n < 2; ++n)
#pragma unroll
                    for (int e = 0; e < 4; ++e) {
                        const int col = bj * HALF + wc * 32 + (Epi::PERM ? (8 * fq + 4 * n + e) : (16 * n + 4 * fq + e));
                        const u32x4 b = *(const u32x4*)(Bt + (size_t)col * g.ldb + k);
#pragma unroll
                        for (int ai = 0; ai < 2; ++ai)
#pragma unroll
                            for (int m = 0; m < 4; ++m) { float s = acc[ai][bj][m][n][e]; s = dot2bf(a[ai][m].x, b.x, s); s = dot2bf(a[ai][m].y, b.y, s); s = dot2bf(a[ai][m].z, b.z, s); s = dot2bf(a[ai][m].w, b.w, s); acc[ai][bj][m][n][e] = s; }
                    }
        }
        if constexpr (!Epi::AFTER_DRAIN) { E(acc, cur, wr, wc, fr, fq); }
        else { __syncthreads(); E.fused(acc, cur, wr, wc, fr, fq, lds, wid, lane); __syncthreads(); }
    }
}

template <class Epi, class Sched, bool ALIGN_EPI = false, bool SP2 = false>
__device__ __forceinline__ void gemm_phase(PG8_LAS unsigned char* lds, const Gemm g, const Sched& S, const Epi& E) {
    const int tid = threadIdx.x, wid = __builtin_amdgcn_readfirstlane(tid >> 6), lane = tid & 63, wr = wid >> 2, wc = wid & 3, fr = lane & 15, fq = lane >> 4;
    const int K = g.K, nt = K / BK;
    unsigned voffA[2], voffB[2];
#pragma unroll
    for (int i = 0; i < 2; ++i) { int R, C; stage_rc(tid * 16 + i * 8192, R, C); const int Rb = Epi::PERM ? ((R & ~31) + perm32(R & 31)) : R;
        voffA[i] = (unsigned)(R * g.lda + C) * 2u; voffB[i] = (unsigned)(Rb * g.ldb + C) * 2u; }
    const size_t kstep = (size_t)(BK * 2);
    const size_t hstepA = (size_t)HALF * g.lda * 2, hstepB = (size_t)HALF * g.ldb * 2;
    const unsigned ldsw = (unsigned)wid * 1024u;
    const int aoff = lds_byte(wr * 64 + fr, fq * 8), boff = lds_byte(wc * 32 + fr, fq * 8);
#define PG8_SA(b, h) (((b) * 2 + (h)) * HTB)
#define PG8_SB(b, h) ((4 + (b) * 2 + (h)) * HTB)
#define PG8_STAGE(bufoff, gbase, voff) do { _Pragma("unroll") for (int _i = 0; _i < 2; ++_i) \
        __builtin_amdgcn_global_load_lds((const unsigned*)((const char*)(gbase) + (voff)[_i]), (PG8_LAS unsigned*)(lds + (bufoff) + ldsw + _i * 8192), 16, 0, 0); } while (0)
#define PG8_LDA(dst, b, h) do { _Pragma("unroll") for (int m = 0; m < 4; ++m) _Pragma("unroll") for (int k = 0; k < 2; ++k) dst[m][k] = *(const PG8_LAS bf16x8*)(lds + PG8_SA(b, h) + aoff + m * 2048 + k * 1024); } while (0)
#define PG8_LDB(dst, b, h) do { _Pragma("unroll") for (int n = 0; n < 2; ++n) _Pragma("unroll") for (int k = 0; k < 2; ++k) dst[n][k] = *(const PG8_LAS bf16x8*)(lds + PG8_SB(b, h) + boff + n * 2048 + k * 1024); } while (0)
#define PG8_MMA(ai, bj, At, Bt) do { __builtin_amdgcn_s_setprio(1); _Pragma("unroll") for (int m = 0; m < 4; ++m) _Pragma("unroll") for (int n = 0; n < 2; ++n) _Pragma("unroll") for (int k = 0; k < 2; ++k) \
        acc[ai][bj][m][n] = __builtin_amdgcn_mfma_f32_16x16x32_bf16(Bt[n][k], At[m][k], acc[ai][bj][m][n], 0, 0, 0); __builtin_amdgcn_s_setprio(0); } while (0)
#define PG8_WAIT_V(n) asm volatile("s_waitcnt vmcnt(" #n ")" ::: "memory")
#define PG8_WAIT_L(n) asm volatile("s_waitcnt lgkmcnt(" #n ")" ::: "memory")
#define PG8_BAR __builtin_amdgcn_s_barrier()
#define PG8_SCHED __builtin_amdgcn_sched_barrier(0)
    Unit cur, nxt; int ui = 0;
    if (!S.next(0, cur)) return;
    f32x4 acc[2][2][4][2];
#pragma unroll
    for (int a = 0; a < 2; ++a)
#pragma unroll
        for (int b = 0; b < 2; ++b)
#pragma unroll
            for (int m = 0; m < 4; ++m)
#pragma unroll
                for (int n = 0; n < 2; ++n) acc[a][b][m][n] = (f32x4){0.f, 0.f, 0.f, 0.f};
    bf16x8 At[4][2], B0[2][2], B1[2][2];
    const char* cA = a_tile(g, cur); const char* cB = b_tile(g, cur);
    S.a_ready(cur);
    if constexpr (SP2) {
        PG8_STAGE(PG8_SB(0, 0), cB, voffB); PG8_STAGE(PG8_SB(0, 1), cB + hstepB, voffB); PG8_STAGE(PG8_SA(0, 0), cA, voffA); PG8_STAGE(PG8_SA(0, 1), cA + hstepA, voffA);
        if (wr == 1) PG8_BAR;
        PG8_WAIT_V(2); PG8_BAR;
        PG8_STAGE(PG8_SB(1, 0), cB + kstep, voffB); PG8_STAGE(PG8_SA(1, 0), cA + kstep, voffA); PG8_STAGE(PG8_SB(1, 1), cB + hstepB + kstep, voffB);
        PG8_WAIT_V(6); PG8_BAR;
    } else {
        PG8_STAGE(PG8_SB(0, 0), cB, voffB); PG8_STAGE(PG8_SA(0, 0), cA, voffA); PG8_STAGE(PG8_SB(0, 1), cB + hstepB, voffB); PG8_STAGE(PG8_SA(0, 1), cA + hstepA, voffA);
        if (wr == 1) PG8_BAR;
        PG8_WAIT_V(4); PG8_BAR;
        PG8_STAGE(PG8_SB(1, 0), cB + kstep, voffB); PG8_STAGE(PG8_SA(1, 0), cA + kstep, voffA); PG8_STAGE(PG8_SB(1, 1), cB + hstepB + kstep, voffB);
        PG8_WAIT_V(6); PG8_BAR;
    }
    for (;;) {
        const bool has_next = S.next(ui + 1, nxt);
        const char* nA = has_next ? a_tile(g, nxt) : cA; const char* nB = has_next ? b_tile(g, nxt) : cB;
        for (int t = 0; t < nt; t += 2) {
            const bool last = (t == nt - 2);
            const char* a1 = cA + (size_t)(t + 1) * kstep;
            const char* a2 = last ? nA : cA + (size_t)(t + 2) * kstep; const char* b2 = last ? nB : cB + (size_t)(t + 2) * kstep;
            const char* a3 = a2 + kstep; const char* b3 = b2 + kstep;
            if (last && has_next) S.a_ready(nxt);
            if constexpr (SP2) {
            PG8_LDB(B0, 0, 0); PG8_LDB(B1, 0, 1); PG8_SCHED; PG8_LDA(At, 0, 0); PG8_STAGE(PG8_SA(1, 1), a1 + hstepA, voffA);
            PG8_WAIT_V(8); PG8_WAIT_L(0); PG8_BAR; PG8_MMA(0, 0, At, B0); PG8_MMA(0, 1, At, B1); PG8_BAR; PG8_SCHED;
            PG8_LDA(At, 0, 1); PG8_STAGE(PG8_SB(0, 0), b2, voffB); PG8_STAGE(PG8_SB(0, 1), b2 + hstepB, voffB); PG8_STAGE(PG8_SA(0, 0), a2, voffA);
            PG8_WAIT_V(8); PG8_WAIT_L(0); PG8_BAR; PG8_MMA(1, 0, At, B0); PG8_MMA(1, 1, At, B1); PG8_BAR; PG8_SCHED;
            PG8_LDB(B0, 1, 0); PG8_LDB(B1, 1, 1); PG8_SCHED; PG8_LDA(At, 1, 0); PG8_STAGE(PG8_SA(0, 1), a2 + hstepA, voffA);
            PG8_WAIT_V(8); PG8_WAIT_L(0); PG8_BAR; PG8_MMA(0, 0, At, B0); PG8_MMA(0, 1, At, B1); PG8_BAR; PG8_SCHED;
            PG8_LDA(At, 1, 1); PG8_STAGE(PG8_SB(1, 0), b3, voffB); PG8_STAGE(PG8_SB(1, 1), b3 + hstepB, voffB); PG8_STAGE(PG8_SA(1, 0), a3, voffA);
            PG8_WAIT_V(8); PG8_WAIT_L(0); PG8_BAR; PG8_MMA(1, 0, At, B0); PG8_MMA(1, 1, At, B1); PG8_BAR; PG8_SCHED;
            } else {
            PG8_LDB(B0, 0, 0); PG8_SCHED; PG8_LDA(At, 0, 0); PG8_STAGE(PG8_SA(1, 1), a1 + hstepA, voffA);
            PG8_WAIT_L(8); PG8_BAR; PG8_WAIT_L(0); PG8_MMA(0, 0, At, B0); PG8_BAR; PG8_SCHED;
            PG8_LDB(B1, 0, 1); PG8_STAGE(PG8_SB(0, 0), b2, voffB);
            PG8_BAR; PG8_WAIT_L(0); PG8_MMA(0, 1, At, B1); PG8_BAR;
            PG8_LDA(At, 0, 1); PG8_STAGE(PG8_SA(0, 0), a2, voffA);
            PG8_BAR; PG8_WAIT_L(0); PG8_MMA(1, 0, At, B0); PG8_BAR; PG8_SCHED;
            PG8_STAGE(PG8_SB(0, 1), b2 + hstepB, voffB);
            PG8_WAIT_V(6); PG8_BAR; PG8_MMA(1, 1, At, B1); PG8_BAR;
            PG8_LDB(B0, 1, 0); PG8_SCHED; PG8_LDA(At, 1, 0); PG8_STAGE(PG8_SA(0, 1), a2 + hstepA, voffA);
            PG8_WAIT_L(8); PG8_BAR; PG8_WAIT_L(0); PG8_MMA(0, 0, At, B0); PG8_BAR; PG8_SCHED;
            PG8_LDB(B1, 1, 1); PG8_STAGE(PG8_SB(1, 0), b3, voffB);
            PG8_BAR; PG8_WAIT_L(0); PG8_MMA(0, 1, At, B1); PG8_BAR;
            PG8_LDA(At, 1, 1); PG8_STAGE(PG8_SA(1, 0), a3, voffA);
            PG8_BAR; PG8_WAIT_L(0); PG8_MMA(1, 0, At, B0); PG8_BAR; PG8_SCHED;
            PG8_STAGE(PG8_SB(1, 1), b3 + hstepB, voffB);
            PG8_WAIT_V(6); PG8_BAR; PG8_MMA(1, 1, At, B1); PG8_BAR;
            }
        }
        if constexpr (ALIGN_EPI) { if (wr == 0) PG8_BAR; }
        if constexpr (!Epi::AFTER_DRAIN) { E(acc, cur, wr, wc, fr, fq); S.done(cur); }
        if (!has_next) break;
#pragma unroll
        for (int a = 0; a < 2; ++a)
#pragma unroll
            for (int b = 0; b < 2; ++b)
#pragma unroll
                for (int m = 0; m < 4; ++m)
#pragma unroll
                    for (int n = 0; n < 2; ++n) acc[a][b][m][n] = (f32x4){0.f, 0.f, 0.f, 0.f};
        cur = nxt; cA = nA; cB = nB; ++ui;
        if constexpr (ALIGN_EPI) { if (wr == 1) PG8_BAR; }
    }
    PG8_WAIT_V(0);
    if constexpr (!ALIGN_EPI) { if (wr == 0) PG8_BAR; }
    PG8_BAR;
    if constexpr (Epi::AFTER_DRAIN) { E.fused(acc, cur, wr, wc, fr, fq, lds, wid, lane); S.done(cur); }
#undef PG8_SA
#undef PG8_SB
#undef PG8_STAGE
#undef PG8_LDA
#undef PG8_LDB
#undef PG8_MMA
#undef PG8_WAIT_V
#undef PG8_WAIT_L
#undef PG8_BAR
#undef PG8_SCHED
}
}
namespace attn_body {
using bf16=__hip_bfloat16;
using bf16x8=__attribute__((ext_vector_type(8)))short;
using s16x4=__attribute__((ext_vector_type(4)))short;
using f32x16=__attribute__((ext_vector_type(16)))float;
using u32x4=__attribute__((ext_vector_type(4)))unsigned;
constexpr int BATCH=2,NHEAD=16,SEQ=4096,D=64,DM=NHEAD*D;
constexpr int NW=8,QBLK=32,QB=QBLK*NW,KVBLK=64,NQB=SEQ/QB;
constexpr int ATTN_PITCH=DM, ATTN_UNIT_ROWS=QB;
__device__ __forceinline__ int crow(int r,int hi){return (r&3)+8*(r>>2)+4*hi;}
#define SBAR() __builtin_amdgcn_sched_barrier(0)
__device__ __forceinline__ void cmask(f32x16&p0,f32x16&p1,int jb,int qrel,int hi){
  const float NEG=-INFINITY; int kb=64*jb+4*hi;
  #pragma unroll
  for(int r=0;r<16;++r){int kv=kb+(r&3)+8*(r>>2); if(kv>qrel)p0[r]=NEG; if(kv+32>qrel)p1[r]=NEG;}
}

constexpr int NSLOT=3, SLOTB=8192;
constexpr int LDS_K=0, LDS_V=NSLOT*SLOTB, LDS_WS=2*NSLOT*SLOTB, LDS_OST=LDS_WS+NW*64*4, LDS_BYTES=LDS_OST+NW*4096;
constexpr float C2=0.125f*1.4426950408889634f;
__device__ __forceinline__ void glds16(const void*gsrc,unsigned lds_dst){unsigned keep;
  asm volatile("s_mov_b32 %0, m0\n\ts_mov_b32 m0, %2\n\ts_nop 0\n\tglobal_load_lds_dwordx4 %1, off\n\ts_mov_b32 m0, %0":"=&s"(keep):"v"(gsrc),"s"(lds_dst):"memory");}
__device__ __forceinline__ float max3f(float a,float b,float c){float r;asm("v_max3_f32 %0, %1, %2, %3":"=v"(r):"v"(a),"v"(b),"v"(c));return r;}
__device__ __forceinline__ float max2f(float a,float b){float r;asm("v_max_f32_e32 %0, %1, %2":"=v"(r):"v"(a),"v"(b));return r;}
__device__ __forceinline__ float fadd_s(float a,float b){float r;asm("v_add_f32_e32 %0, %1, %2":"=v"(r):"v"(a),"v"(b));return r;}
__device__ __forceinline__ float fsub_s(float a,float b){float r;asm("v_sub_f32_e32 %0, %1, %2":"=v"(r):"v"(a),"v"(b));return r;}
typedef float f32x2_t __attribute__((ext_vector_type(2))); typedef __bf16 bf16x2_t __attribute__((ext_vector_type(2)));
__device__ __forceinline__ unsigned cvtpk_s(float lo,float hi){f32x2_t v={lo,hi};bf16x2_t b=__builtin_convertvector(v,bf16x2_t);return __builtin_bit_cast(unsigned,b);}
#define WAIT_BAR(N) asm volatile("s_waitcnt vmcnt(" #N ") lgkmcnt(0)\n\ts_barrier":::"memory")

__device__ __forceinline__ void qkt(f32x16&p0,f32x16&p1,const char*Kslot,const bf16x8*qr,const f32x16&negm,int r32,int hi){
  const char*kb=Kslot+hi*1024+r32*16;
  #pragma unroll
  for(int d0=0;d0<4;++d0){
    const bf16x8 b0=*reinterpret_cast<const bf16x8*>(kb+d0*2048);
    const bf16x8 b1=*reinterpret_cast<const bf16x8*>(kb+d0*2048+512);
    if(d0==0){p0=__builtin_amdgcn_mfma_f32_32x32x16_bf16(b0,qr[0],negm,0,0,0);p1=__builtin_amdgcn_mfma_f32_32x32x16_bf16(b1,qr[0],negm,0,0,0);}
    else{p0=__builtin_amdgcn_mfma_f32_32x32x16_bf16(b0,qr[d0],p0,0,0,0);p1=__builtin_amdgcn_mfma_f32_32x32x16_bf16(b1,qr[d0],p1,0,0,0);}}
}
typedef __attribute__((address_space(3))) const char* lds_cptr;
typedef short v4i16_t __attribute__((ext_vector_type(4)));
__device__ __forceinline__ void kload8(bf16x8*kf,lds_cptr kp){
  kf[0]=*(const __attribute__((address_space(3))) bf16x8*)(kp);      kf[1]=*(const __attribute__((address_space(3))) bf16x8*)(kp+512);
  kf[2]=*(const __attribute__((address_space(3))) bf16x8*)(kp+2048); kf[3]=*(const __attribute__((address_space(3))) bf16x8*)(kp+2560);
  kf[4]=*(const __attribute__((address_space(3))) bf16x8*)(kp+4096); kf[5]=*(const __attribute__((address_space(3))) bf16x8*)(kp+4608);
  kf[6]=*(const __attribute__((address_space(3))) bf16x8*)(kp+6144); kf[7]=*(const __attribute__((address_space(3))) bf16x8*)(kp+6656);
}
__device__ __forceinline__ void kload2(bf16x8*kf,lds_cptr kp,int j){ kf[2*j]=*(const __attribute__((address_space(3))) bf16x8*)(kp+j*2048); kf[2*j+1]=*(const __attribute__((address_space(3))) bf16x8*)(kp+j*2048+512); }
__device__ __forceinline__ s16x4 vtr(lds_cptr p){ return __builtin_bit_cast(s16x4,__builtin_amdgcn_ds_read_tr16_b64_v4i16((__attribute__((address_space(3))) v4i16_t*)p)); }
__device__ __forceinline__ float rowmax(const f32x16&p0,const f32x16&p1){
  float a=max3f(p0[0],p0[1],p1[0]),b=max3f(p0[2],p0[3],p1[1]);a=max3f(a,p1[2],p1[3]);
  #pragma unroll
  for(int r=4;r<16;r+=4){a=max3f(a,p0[r],p0[r+1]);b=max3f(b,p0[r+2],p0[r+3]);a=max3f(a,p1[r],p1[r+1]);b=max3f(b,p1[r+2],p1[r+3]);}
  const float m=max2f(a,b);
  auto rr=__builtin_amdgcn_permlane32_swap(__float_as_uint(m),__float_as_uint(m),false,false);
  return max2f(__uint_as_float(rr[0]),__uint_as_float(rr[1]));
}
__device__ __forceinline__ void pv(f32x16*o,int vb,bf16x8 pa0,bf16x8 pa1,bf16x8 pa2,bf16x8 pa3){
  #pragma unroll
  for(int d0=0;d0<2;++d0){s16x4 lo[4],hi[4];
    #pragma unroll
    for(int ks=0;ks<4;++ks){
      asm volatile("ds_read_b64_tr_b16 %0,%1 offset:%c2":"=&v"(lo[ks]):"v"(vb),"i"(d0*4096+ks*1024):"memory");
      asm volatile("ds_read_b64_tr_b16 %0,%1 offset:%c2":"=&v"(hi[ks]):"v"(vb),"i"(d0*4096+ks*1024+512):"memory");}
    asm volatile("s_waitcnt lgkmcnt(0)":::"memory");SBAR();
    #define PK(k) (bf16x8){lo[k][0],lo[k][1],lo[k][2],lo[k][3],hi[k][0],hi[k][1],hi[k][2],hi[k][3]}
    o[d0]=__builtin_amdgcn_mfma_f32_32x32x16_bf16(pa0,PK(0),o[d0],0,0,0);
    o[d0]=__builtin_amdgcn_mfma_f32_32x32x16_bf16(pa1,PK(1),o[d0],0,0,0);
    o[d0]=__builtin_amdgcn_mfma_f32_32x32x16_bf16(pa2,PK(2),o[d0],0,0,0);
    o[d0]=__builtin_amdgcn_mfma_f32_32x32x16_bf16(pa3,PK(3),o[d0],0,0,0);
    #undef PK
  }
}

#ifndef ATTN_STORE16
#define ATTN_STORE16(p,v) (*(u32x4*)(p)=(v))
#endif
template<int THRL> __device__ __forceinline__ void attn_unit(int b,int hq,int hv,int qb,const bf16*Q,const bf16*__restrict__ K,const bf16*__restrict__ V,bf16*O,char*shm){
  int tid_=threadIdx.x; asm volatile("":"+v"(tid_)); const int tid=tid_,lane=tid&63,r32=lane&31,hi=lane>>5; const int wid=__builtin_amdgcn_readfirstlane(tid>>6);
  const long rowbase=(long)b*SEQ; const int q0=qb*QB;
  const bf16*Qw=Q+(rowbase+q0+wid*QBLK)*DM+hq*D;
  const bf16*Kh=K+rowbase*DM+hq*D,*Vh=V+rowbase*DM+hv*D;
  const unsigned lds0=(unsigned)(uintptr_t)shm;
  float*wsf=(float*)(shm+LDS_WS)+wid*64;
  const bf16*ksrc=Kh+(long)lane*DM+wid*8;
  const bf16*vsrc=Vh+(long)(16*(wid&3)+(lane>>2))*DM+(wid>>2)*32+(lane&3)*8;
  const unsigned kdst=lds0+LDS_K+wid*1024, vdst=lds0+LDS_V+wid*1024;
  #define DMA_K(t,slot) glds16(ksrc+(long)(t)*KVBLK*DM,(unsigned)__builtin_amdgcn_readfirstlane(kdst+(slot)))
  #define DMA_V(t,slot) glds16(vsrc+(long)(t)*KVBLK*DM,(unsigned)__builtin_amdgcn_readfirstlane(vdst+(slot)))
  const int vb0=(int)(lds0+LDS_V)+((lane>>4)&1)*32+(lane&3)*8+(4*hi+((lane&15)>>2))*64;
  const char*Kbase=shm+LDS_K; bf16x8 kf[8];
  const lds_cptr shm3=(lds_cptr)shm; const lds_cptr kp0=shm3+LDS_K+hi*1024+r32*16; const lds_cptr vp0=shm3+LDS_V+((lane>>4)&1)*32+(lane&3)*8+(4*hi+((lane&15)>>2))*64;
  const int NT=(q0+QB)/KVBLK;
  DMA_K(0,0);DMA_V(0,0);DMA_K(1,SLOTB);
  bf16x8 qr[4];
  #pragma unroll
  for(int d0=0;d0<4;++d0)qr[d0]=*reinterpret_cast<const bf16x8*>(&Qw[(long)r32*DM+d0*16+hi*8]);
  float zz_=0.f; asm volatile("":"+v"(zz_)); float mhat=0.f,l_reg=0.f;f32x16 o[2],negm;
  #pragma unroll
  for(int r=0;r<16;++r){o[0][r]=zz_;o[1][r]=zz_;negm[r]=zz_;}
  asm volatile("":"+v"(negm));
  const int qrel=wid*QBLK+r32;
  #define CMASK(P0,P1,t) do{int jb_=(t)-(NT-4); if(jb_>=0)cmask(P0,P1,jb_,qrel,hi);}while(0)
  bool resc=false;
  #define START(P0,P1) do{ const float rm=rowmax(P0,P1); resc=false; \
    { const float dl=rm; mhat=fadd_s(mhat,dl); \
      _Pragma("unroll") for(int r=0;r<16;++r){P0[r]=fsub_s(P0[r],dl);P1[r]=fsub_s(P1[r],dl);} \
      _Pragma("unroll") for(int r=0;r<16;++r)negm[r]=-mhat; asm volatile("":"+v"(negm)); } \
    _Pragma("unroll") for(int r=0;r<16;++r)P0[r]=__builtin_amdgcn_exp2f(P0[r]); }while(0)
  #define RESC() do{ if(resc){ asm volatile("s_waitcnt lgkmcnt(0)":::"memory"); \
      _Pragma("unroll") for(int d_=0;d_<2;++d_) _Pragma("unroll") for(int r=0;r<16;++r)o[d_][r]*=wsf[crow(r,hi)]; } }while(0)
  f32x16 pA0,pA1,pB0,pB1;
  int sl_prev=0,sl_cur=0,sl_next=SLOTB;
  #define ROT() do{sl_prev=sl_cur;sl_cur=sl_next;sl_next=(sl_next==(NSLOT-1)*SLOTB)?0:sl_next+SLOTB;}while(0)
  DMA_K(2,2*SLOTB);
  WAIT_BAR(3);
  qkt(pA0,pA1,Kbase,qr,negm,r32,hi);asm volatile("s_nop 15\n\ts_nop 7":"+v"(pA0),"+v"(pA1));CMASK(pA0,pA1,0);
  START(pA0,pA1);
  _Pragma("unroll") for(int r=0;r<16;++r)pA1[r]=__builtin_amdgcn_exp2f(pA1[r]);
  WAIT_BAR(0);
  DMA_K(3,0);DMA_V(1,SLOTB);
  ROT();
  kload8(kf,kp0+sl_cur);
  WAIT_BAR(2);
  s16x4 vlo[8],vhi[8]; u32x4 pw0,pw1,pw2,pw3;
  #define PKW(P,B) cvtpk_s(P[B],P[B+1])
  #define PAF(k) __builtin_bit_cast(bf16x8,pw##k)
  #define VFR(i) (bf16x8){vlo[i][0],vlo[i][1],vlo[i][2],vlo[i][3],vhi[i][0],vhi[i][1],vhi[i][2],vhi[i][3]}
  #define PIN(x) asm volatile("":"+v"(x))
  #define MX3(a,b,c) __builtin_fmaxf(__builtin_fmaxf((a),(b)),(c))
  #define GAPA(MF,A0,A1,A2,A3,W0,W1,PW) do{ MF; sacc+=A0; sacc+=A1; sacc+=A2; sacc+=A3; PIN(sacc); W0; W1; PIN(PW); SBAR(); }while(0)
  #define EX(v) __builtin_amdgcn_exp2f(v)
  #define GAPB(MF,X,B) do{ MF; X[B]=EX(X[B]); X[B+1]=EX(X[B+1]); X[B+2]=EX(X[B+2]); X[B+3]=EX(X[B+3]); PIN(X); SBAR(); }while(0)
  #define VRD(i) do{ vlo[i]=vtr(vp_+(((i)>>2)*4096+((i)&3)*1024)); vhi[i]=vtr(vp_+(((i)>>2)*4096+((i)&3)*1024+512)); }while(0)
  #define KRD(G,j) do{ if(G){ kload2(kf,kp0+sl_next,j); SBAR(); } }while(0)
  #define STEP(C0,C1,P0,P1,t,GK,GV,GL) do{ SBAR(); \
    const lds_cptr vp_=vp0+sl_prev; \
    VRD(0); SBAR(); float sacc=(P0[0]+P0[1]); \
    GAPA(C0=__builtin_amdgcn_mfma_f32_32x32x16_bf16(kf[0],qr[0],negm,0,0,0), P0[2],P0[3],P0[4],P0[5],     pw0[0]=PKW(P0,0), pw0[1]=PKW(P0,2), pw0); \
    VRD(4); SBAR(); GAPA(C1=__builtin_amdgcn_mfma_f32_32x32x16_bf16(kf[1],qr[0],negm,0,0,0), P0[6],P0[7],P0[8],P0[9],     pw0[2]=PKW(P0,4), pw0[3]=PKW(P0,6), pw0); \
    VRD(1); SBAR(); GAPA(C0=__builtin_amdgcn_mfma_f32_32x32x16_bf16(kf[2],qr[1],C0,0,0,0),   P0[10],P0[11],P0[12],P0[13], pw1[0]=PKW(P0,8), pw1[1]=PKW(P0,10), pw1); \
    VRD(5); SBAR(); GAPA(C1=__builtin_amdgcn_mfma_f32_32x32x16_bf16(kf[3],qr[1],C1,0,0,0),   P0[14],P0[15],P1[0],P1[1],   pw1[2]=PKW(P0,12),pw1[3]=PKW(P0,14), pw1); \
    VRD(2); SBAR(); GAPA(C0=__builtin_amdgcn_mfma_f32_32x32x16_bf16(kf[4],qr[2],C0,0,0,0),   P1[2],P1[3],P1[4],P1[5],     pw2[0]=PKW(P1,0), pw2[1]=PKW(P1,2), pw2); \
    VRD(6); SBAR(); GAPA(C1=__builtin_amdgcn_mfma_f32_32x32x16_bf16(kf[5],qr[2],C1,0,0,0),   P1[6],P1[7],P1[8],P1[9],     pw2[2]=PKW(P1,4), pw2[3]=PKW(P1,6), pw2); \
    VRD(3); SBAR(); GAPA(C0=__builtin_amdgcn_mfma_f32_32x32x16_bf16(kf[6],qr[3],C0,0,0,0),   P1[10],P1[11],P1[12],P1[13], pw3[0]=PKW(P1,8), pw3[1]=PKW(P1,10), pw3); \
    VRD(7); SBAR(); GAPA(C1=__builtin_amdgcn_mfma_f32_32x32x16_bf16(kf[7],qr[3],C1,0,0,0),   P1[14],P1[15],0.f,0.f,       pw3[2]=PKW(P1,12),pw3[3]=PKW(P1,14), pw3); \
    l_reg+=sacc; \
    if(GK){DMA_K((t)+3,sl_cur);} if(GV){DMA_V((t)+1,sl_next);} \
    CMASK(C0,C1,t); \
    { float a=MX3(C0[0],C0[1],C1[0]),b=MX3(C0[2],C0[3],C1[1]); a=MX3(a,C1[2],C1[3]); \
      _Pragma("unroll") for(int r=4;r<16;r+=4){a=MX3(a,C0[r],C0[r+1]);b=MX3(b,C0[r+2],C0[r+3]);a=MX3(a,C1[r],C1[r+1]);b=MX3(b,C1[r+2],C1[r+3]);} \
      float rm=__builtin_fmaxf(a,b); { auto rr=__builtin_amdgcn_permlane32_swap(__float_as_uint(rm),__float_as_uint(rm),false,false); rm=__builtin_fmaxf(__uint_as_float(rr[0]),__uint_as_float(rr[1])); } \
      resc=false; \
      if(__builtin_expect(__any(rm>(float)THRL),0)){ const float dl=__builtin_fmaxf(rm,0.f); mhat+=dl; \
        _Pragma("unroll") for(int r=0;r<16;++r){C0[r]-=dl;C1[r]-=dl;} \
        _Pragma("unroll") for(int r=0;r<16;++r)negm[r]=-mhat; asm volatile("":"+v"(negm)); \
        const float f=__builtin_amdgcn_exp2f(-dl); l_reg*=f; if(hi==0)wsf[r32]=f; resc=true; } } \
    SBAR(); \
    GAPB(o[0]=__builtin_amdgcn_mfma_f32_32x32x16_bf16(PAF(0),VFR(0),o[0],0,0,0), C0,0); \
    GAPB(o[1]=__builtin_amdgcn_mfma_f32_32x32x16_bf16(PAF(0),VFR(4),o[1],0,0,0), C0,4); \
    KRD(GL,0); GAPB(o[0]=__builtin_amdgcn_mfma_f32_32x32x16_bf16(PAF(1),VFR(1),o[0],0,0,0), C0,8); \
    KRD(GL,1); GAPB(o[1]=__builtin_amdgcn_mfma_f32_32x32x16_bf16(PAF(1),VFR(5),o[1],0,0,0), C0,12); \
    KRD(GL,2); GAPB(o[0]=__builtin_amdgcn_mfma_f32_32x32x16_bf16(PAF(2),VFR(2),o[0],0,0,0), C1,0); \
    KRD(GL,3); GAPB(o[1]=__builtin_amdgcn_mfma_f32_32x32x16_bf16(PAF(2),VFR(6),o[1],0,0,0), C1,4); \
    GAPB(o[0]=__builtin_amdgcn_mfma_f32_32x32x16_bf16(PAF(3),VFR(3),o[0],0,0,0), C1,8); \
    GAPB(o[1]=__builtin_amdgcn_mfma_f32_32x32x16_bf16(PAF(3),VFR(7),o[1],0,0,0), C1,12); \
    }while(0)
  int t=1;
  #undef CMASK
  #define CMASK(P0,P1,t) do{}while(0)
  for(;t+5<NT;t+=2){
    STEP(pB0,pB1,pA0,pA1,t,true,true,true);     WAIT_BAR(2); RESC(); ROT();
    STEP(pA0,pA1,pB0,pB1,t+1,true,true,true);   WAIT_BAR(2); RESC(); ROT();
  }
  #undef CMASK
  #define CMASK(P0,P1,t) do{int jb_=(t)-(NT-4); if(jb_>=0)cmask(P0,P1,jb_,qrel,hi);}while(0)
  #define ENDW(tt) do{ if((tt)+3<NT){WAIT_BAR(2);} else if((tt)+2<NT){WAIT_BAR(1);} else {WAIT_BAR(0);} }while(0)
  for(;t+1<NT;t+=2){
    STEP(pB0,pB1,pA0,pA1,t,(t+3<NT),(t+1<NT),(t+1<NT));       ENDW(t);   RESC(); ROT();
    STEP(pA0,pA1,pB0,pB1,t+1,(t+4<NT),(t+2<NT),(t+2<NT));     ENDW(t+1); RESC(); ROT();
  }
  STEP(pB0,pB1,pA0,pA1,NT-1,false,false,false); RESC();
  { float sacc=pB0[0]+pB0[1]; _Pragma("unroll") for(int r=2;r<16;++r)sacc+=pB0[r]; _Pragma("unroll") for(int r=0;r<16;++r)sacc+=pB1[r]; l_reg+=sacc;
    pw0=(u32x4){PKW(pB0,0),PKW(pB0,2),PKW(pB0,4),PKW(pB0,6)};pw1=(u32x4){PKW(pB0,8),PKW(pB0,10),PKW(pB0,12),PKW(pB0,14)};pw2=(u32x4){PKW(pB1,0),PKW(pB1,2),PKW(pB1,4),PKW(pB1,6)};pw3=(u32x4){PKW(pB1,8),PKW(pB1,10),PKW(pB1,12),PKW(pB1,14)};
    SBAR(); pv(o,vb0+sl_cur,PAF(0),PAF(1),PAF(2),PAF(3)); }
  #undef PKW
  #undef PAF
  #undef VFR
  #undef PIN
  #undef MX3
  #undef GAPA
  #undef GAPB
  #undef EX
  #undef VRD
  #undef KRD
  #undef STEP
  #undef ENDW
  {auto rr=__builtin_amdgcn_permlane32_swap(__float_as_uint(l_reg),__float_as_uint(l_reg),false,false);l_reg=__uint_as_float(rr[0])+__uint_as_float(rr[1]);}
  if(hi==0)wsf[32+r32]=l_reg;asm volatile("s_waitcnt lgkmcnt(0)":::"memory");
  float rli[16];
  #pragma unroll
  for(int r=0;r<16;++r)rli[r]=__builtin_amdgcn_rcpf(wsf[32+crow(r,hi)]);
  bf16*Ow=O+(rowbase+q0+wid*QBLK)*DM+hv*D;
  { bf16*stg=(bf16*)(shm+LDS_OST)+wid*2048;
    #pragma unroll
    for(int r=0;r<16;++r){const int orow=crow(r,hi);
      #pragma unroll
      for(int d0=0;d0<2;++d0)stg[orow*64+d0*32+r32]=__float2bfloat16(o[d0][r]*rli[r]);}
    asm volatile("s_waitcnt lgkmcnt(0)":::"memory");
    #pragma unroll
    for(int i=0;i<4;++i){const int row=i*8+(lane>>3),ch=lane&7; const u32x4 v=*(const u32x4*)(stg+row*64+ch*8); ATTN_STORE16(Ow+(long)row*DM+ch*8,v);} }
  asm volatile("s_waitcnt lgkmcnt(0)\n\ts_barrier":::"memory");
  #undef DMA_K
  #undef DMA_V
  #undef CMASK
  #undef START
  #undef RESC
  #undef ROT
}
constexpr int ATTN_LDS_BYTES=LDS_BYTES;
#undef SBAR
#undef WAIT_BAR
}
#define GAS __attribute__((address_space(1)))
#define LAS __attribute__((address_space(3)))
typedef unsigned short bf16;
typedef unsigned v4u __attribute__((ext_vector_type(4)));
typedef float f32x4 __attribute__((ext_vector_type(4)));
typedef short bf16x8 __attribute__((ext_vector_type(8)));
typedef GAS unsigned gu32;
typedef GAS unsigned long long gu64;
#define RLX_AGENT __ATOMIC_RELAXED, __HIP_MEMORY_SCOPE_AGENT
#define LDS_WAIT() asm volatile("s_waitcnt lgkmcnt(0)" ::: "memory")
#define VM_WAIT() asm volatile("s_waitcnt vmcnt(0)" ::: "memory")
__device__ __forceinline__ unsigned long long rt() { return __builtin_amdgcn_s_memrealtime(); }
__device__ __forceinline__ unsigned f2bf(float f) { unsigned u = __builtin_bit_cast(unsigned, f); return (u + 0x7fffu + ((u >> 16) & 1u)) >> 16; }
__device__ __forceinline__ unsigned pk2(float lo, float hi) { return f2bf(lo) | (f2bf(hi) << 16); }

#define XB_TMO      128
#define XB_XCNT(j)  (256  + 64 * (j))
#define XB_XSUB(j)  (1280 + 64 * (j))
#define XB_XGEN(j)  (2304 + 64 * (j))
#define XB_TOP      3328
#define XB_TOPGEN   3392
#define XCD_BAR_WORDS 3456
#define XB_SPIN_CAP (1u << 18)

__device__ __forceinline__ unsigned xb_ld(unsigned* p)              { return __hip_atomic_load(p, __ATOMIC_RELAXED, __HIP_MEMORY_SCOPE_AGENT); }
__device__ __forceinline__ unsigned xb_add(unsigned* p, unsigned v) { return __hip_atomic_fetch_add(p, v, __ATOMIC_RELAXED, __HIP_MEMORY_SCOPE_AGENT); }
__device__ __forceinline__ unsigned xb_xcc_id() { return (unsigned)__builtin_amdgcn_s_getreg((3 << 11) | 20) & 0xFu; }
#define XB_SPIN(cond, bar) do { unsigned _sp = 0; while (cond) { __builtin_amdgcn_s_sleep(1); \
    if ((++_sp & 255u) == 0u) { if (xb_ld(&(bar)[XB_TMO])) break; if (_sp > XB_SPIN_CAP) { atomicAdd(&(bar)[XB_TMO], 1u); break; } } } } while (0)

struct XcdBarrier {
    unsigned* bar; unsigned x;
    volatile LAS unsigned* st;
};

__device__ __forceinline__ XcdBarrier xcd_barrier_post(unsigned* bar, volatile LAS unsigned* st) {
    XcdBarrier b; b.bar = bar; b.x = xb_xcc_id(); b.st = st;
    if (threadIdx.x == 0) (void)xb_add(&bar[XB_XCNT(b.x)], 1u);
    return b;
}
__device__ __forceinline__ void xcd_barrier_complete(unsigned* bar, unsigned x, unsigned& nloc, unsigned& nx) {
    const unsigned G = gridDim.x * gridDim.y * gridDim.z;
    unsigned sum, cnt, mine, sp = 0u;
    for (;;) {
        sum = 0u; cnt = 0u; mine = 0u;
#pragma unroll
        for (unsigned j = 0; j < 16; ++j) { const unsigned c = xb_ld(&bar[XB_XCNT(j)]); sum += c; cnt += (c > 0u) ? 1u : 0u; mine = (j == x) ? c : mine; }
        if (sum == G) break;
        __builtin_amdgcn_s_sleep(1);
        if ((++sp & 255u) == 0u) { if (xb_ld(&bar[XB_TMO])) break; if (sp > XB_SPIN_CAP) { atomicAdd(&bar[XB_TMO], 1u); break; } }
    }
    nloc = mine > 0u ? mine : 1u; nx = cnt > 0u ? cnt : 1u;
}

__device__ __forceinline__ void xcd_barrier(const XcdBarrier& b) {
    asm volatile("s_waitcnt vmcnt(0)" ::: "memory");
    __syncthreads();
    if (threadIdx.x == 0) {
        unsigned* bar = b.bar;
        __builtin_amdgcn_s_waitcnt(0);
        unsigned nloc = b.st[0], nx = b.st[1];
        if (nloc == 0u) { xcd_barrier_complete(bar, b.x, nloc, nx); b.st[0] = nloc; b.st[1] = nx; }
        const unsigned old = xb_add(&bar[XB_XSUB(b.x)], 1u);
        const unsigned gen = old / nloc;
        if (old + 1u == (gen + 1u) * nloc) {
            __builtin_amdgcn_fence(__ATOMIC_RELEASE, "agent");
            asm volatile("s_waitcnt vmcnt(0)" ::: "memory");
            const unsigned og = xb_add(&bar[XB_TOP], 1u);
            const unsigned tg = og / nx;
            if (og + 1u == (tg + 1u) * nx) xb_add(&bar[XB_TOPGEN], 1u);
            else XB_SPIN(xb_ld(&bar[XB_TOPGEN]) == tg, bar);
            __builtin_amdgcn_fence(__ATOMIC_ACQUIRE, "agent");
            xb_add(&bar[XB_XGEN(b.x)], 1u);
            asm volatile("s_waitcnt vmcnt(0)" ::: "memory");
        } else {
            XB_SPIN(xb_ld(&bar[XB_XGEN(b.x)]) == gen, bar);
            __builtin_amdgcn_fence(__ATOMIC_ACQUIRE, "agent");
            asm volatile("s_waitcnt vmcnt(0)" ::: "memory");
        }
    }
    __syncthreads();
}

constexpr int NWAVES = 8;
constexpr int DMODEL = 2048, NBATCH = 2, SEQL = 4096, NTOK = NBATCH * SEQL, MEMLEN = 256, NMEM = NBATCH * MEMLEN;
constexpr int CONVW = 1024, INW = 5120, NEXP = 16384;
constexpr float C2Q = 0.125f * 1.4426950408889634f;
constexpr float CROSS_SC = 0.044194173824159216f * 1.4426950408889634f;
constexpr float LAM_INIT = 0.2f;

constexpr size_t MiB = 1u << 20;
constexpr size_t WS_CTL = 0, CTL_ZERO_BYTES = 1 * MiB;
constexpr size_t WS_PART1 = 1 * MiB, WS_PART2 = 2 * MiB;
constexpr size_t WS_ABD = 3 * MiB;
constexpr size_t WS_W1T = 4 * MiB;
constexpr size_t WS_WOUTT = 24 * MiB;
constexpr size_t WS_WCQ = 32 * MiB;
constexpr size_t WS_WCKVT = 40 * MiB;
constexpr size_t WS_WCOT = 56 * MiB;
constexpr size_t WS_WPQ = 64 * MiB;
constexpr size_t WS_MN = 72 * MiB;
constexpr size_t WS_KV = 74 * MiB;
constexpr size_t WS_WKT = 78 * MiB;
constexpr size_t WS_VWT = 86 * MiB;
constexpr size_t WS_WST = 94 * MiB;
constexpr size_t WS_ACT = 104 * MiB;
constexpr size_t WS_U = 136 * MiB, WS_Q = 152 * MiB, WS_K = 168 * MiB, WS_V = 184 * MiB;
constexpr size_t WS_O0 = 200 * MiB, WS_O1 = 216 * MiB;
constexpr size_t WS_MIX = 232 * MiB;
constexpr size_t WS_P = 264 * MiB;
constexpr size_t WS_SALL = 280 * MiB;
constexpr size_t WS_UTAB = 352 * MiB, WS_VTAB = 416 * MiB;
constexpr size_t WS_END = 480 * MiB;
constexpr int CW_BAR = 4096;

constexpr int RING_OFF = 0, RING_BYTES = 131072;
constexpr int LDSCTL_OFF = RING_BYTES, MISC_OFF = LDSCTL_OFF + 320;
constexpr int LDS_BYTES = 147456;

template <int CTRL, int RM> __device__ __forceinline__ float dpp_mov(float old, float src) {
    return __builtin_bit_cast(float, __builtin_amdgcn_update_dpp(__builtin_bit_cast(int, old), __builtin_bit_cast(int, src), CTRL, RM, 0xF, false)); }
__device__ __forceinline__ float rdlane63(float v) { return __builtin_bit_cast(float, __builtin_amdgcn_readlane(__builtin_bit_cast(int, v), 63)); }
__device__ __forceinline__ float wave_max_u(float v) {
    v = fmaxf(v, dpp_mov<0xB1, 0xF>(v, v)); v = fmaxf(v, dpp_mov<0x4E, 0xF>(v, v)); v = fmaxf(v, dpp_mov<0x141, 0xF>(v, v)); v = fmaxf(v, dpp_mov<0x140, 0xF>(v, v));
    v = fmaxf(v, dpp_mov<0x142, 0xA>(v, v)); v = fmaxf(v, dpp_mov<0x143, 0xC>(v, v)); return rdlane63(v); }
__device__ __forceinline__ float wave_sum_u(float v) {
    v += dpp_mov<0xB1, 0xF>(0.f, v); v += dpp_mov<0x4E, 0xF>(0.f, v); v += dpp_mov<0x141, 0xF>(0.f, v); v += dpp_mov<0x140, 0xF>(0.f, v);
    v += dpp_mov<0x142, 0xA>(0.f, v); v += dpp_mov<0x143, 0xC>(0.f, v); return rdlane63(v); }
__device__ __forceinline__ float wave_sum(float v) {
#pragma unroll
    for (int o = 1; o < 64; o <<= 1) v += __shfl_xor(v, o);
    return v;
}
__device__ __forceinline__ float bflo(unsigned w) { return __builtin_bit_cast(float, w << 16); }
__device__ __forceinline__ float bfhi(unsigned w) { return __builtin_bit_cast(float, w & 0xffff0000u); }

template <int NV> __device__ __forceinline__ void wave_top16(float (&a)[NV], int lane, float& outv, int& outi) {
    outv = 0.f; outi = 0;
#pragma unroll
    for (int r = 0; r < 16; ++r) {
        float m = a[0];
#pragma unroll
        for (int q = 1; q < NV; ++q) m = fmaxf(m, a[q]);
        m = wave_max_u(m);
        int idx = -1;
#pragma unroll
        for (int q = 0; q < NV; ++q) { if (idx < 0) { const unsigned long long bl = __ballot(a[q] == m); if (bl) idx = q * 64 + (int)__builtin_ctzll(bl); } }
#pragma unroll
        for (int q = 0; q < NV; ++q) if (idx == q * 64 + lane) a[q] = -INFINITY;
        if (lane == r) { outv = m; outi = idx; }
    }
}

__device__ __forceinline__ void p0_transpose_item(const float* W, int K, int N, bf16* WT, int k0, int n0, int dst_row0, LAS float* scr, int lane) {
#pragma unroll 8
    for (int i = 0; i < 32; ++i) { const int kk = 2 * i + (lane >> 5); scr[kk * 33 + (lane & 31)] = W[(size_t)(k0 + kk) * N + n0 + (lane & 31)]; }
    LDS_WAIT(); asm volatile("" ::: "memory");
    const int c = lane & 7;
#pragma unroll
    for (int j = 0; j < 4; ++j) { const int n = (lane >> 3) + 8 * j; const LAS float* s = scr + (8 * c) * 33 + n;
        v4u o; o.x = pk2(s[0 * 33], s[1 * 33]); o.y = pk2(s[2 * 33], s[3 * 33]); o.z = pk2(s[4 * 33], s[5 * 33]); o.w = pk2(s[6 * 33], s[7 * 33]);
        *(GAS v4u*)(WT + (size_t)(dst_row0 + n) * K + k0 + 8 * c) = o; }
    LDS_WAIT(); asm volatile("" ::: "memory");
}
__device__ __forceinline__ void rms_row_to_bf16(const float* xrow, const float* g, bf16* orow, int lane) {
    const GAS f32x4* xr = (const GAS f32x4*)xrow + lane; const GAS f32x4* gr = (const GAS f32x4*)g + lane;
    f32x4 v[8]; float s = 0.f;
#pragma unroll
    for (int j = 0; j < 8; ++j) { v[j] = xr[64 * j]; s += (v[j].x * v[j].x + v[j].y * v[j].y) + (v[j].z * v[j].z + v[j].w * v[j].w); }
    const float rstd = 1.f / sqrtf(wave_sum(s) * (1.f / DMODEL) + 1e-6f);
    GAS unsigned long long* o8 = (GAS unsigned long long*)orow + lane;
#pragma unroll
    for (int j = 0; j < 8; ++j) { const f32x4 gg = gr[64 * j];
        o8[64 * j] = (unsigned long long)pk2(v[j].x * rstd * gg.x, v[j].y * rstd * gg.y) | ((unsigned long long)pk2(v[j].z * rstd * gg.z, v[j].w * rstd * gg.w) << 32); }
}
__device__ __forceinline__ void cvt_item(const float* src, bf16* dst, size_t item, int lane) {
    const GAS f32x4* s = (const GAS f32x4*)(src + item * 512) + 2 * lane; const f32x4 a = s[0], b = s[1];
    v4u o; o.x = pk2(a.x, a.y); o.y = pk2(a.z, a.w); o.z = pk2(b.x, b.y); o.w = pk2(b.z, b.w);
    *((GAS v4u*)(dst + item * 512) + lane) = o;
}

__device__ __forceinline__ void conv_unit(const bf16* U, const float* cw, const float* cb, const float* lng, const float* lnb, bf16* MIX, int b, int t0, int tid) {
    const int c0 = 2 * tid;
    float w0[31], w1[31];
#pragma unroll
    for (int j = 0; j < 31; ++j) { const float2 w = *(const float2*)(cw + j * CONVW + c0); w0[j] = w.x; w1[j] = w.y; }
    const float2 bias = *(const float2*)(cb + c0);
    float a0[32], a1[32];
#pragma unroll
    for (int i = 0; i < 32; ++i) { a0[i] = bias.x; a1[i] = bias.y; }
    const bf16* Ub = U + (size_t)b * SEQL * CONVW + c0;
#pragma unroll
    for (int r = -30; r < 32; ++r) {
        const int t = t0 + r;
        if (t >= 0) {
            const unsigned uw = *(const unsigned*)(Ub + (size_t)t * CONVW); const float f0 = bflo(uw), f1 = bfhi(uw);
#pragma unroll
            for (int tau = (r > 0 ? r : 0); tau <= (r + 30 < 31 ? r + 30 : 31); ++tau) { a0[tau] += w0[r - tau + 30] * f0; a1[tau] += w1[r - tau + 30] * f1; }
        }
    }
    const float2 gg = *(const float2*)(lng + c0), bb = *(const float2*)(lnb + c0);
    bf16* Mo = MIX + ((size_t)b * SEQL + t0) * DMODEL + c0;
#pragma unroll
    for (int i = 0; i < 32; ++i) {
        const float s1 = wave_sum_u(a0[i] + a1[i]), s2 = wave_sum_u(a0[i] * a0[i] + a1[i] * a1[i]);
        const float mean = s1 * (1.f / 128.f), var = fmaxf(s2 * (1.f / 128.f) - mean * mean, 0.f), rs = 1.f / sqrtf(var + 1e-5f);
        const float y0 = (a0[i] - mean) * rs * gg.x + bb.x, y1 = (a1[i] - mean) * rs * gg.y + bb.y;
        const float o0 = y0 * __builtin_amdgcn_rcpf(1.f + __builtin_amdgcn_exp2f(-1.4426950408889634f * y0)), o1 = y1 * __builtin_amdgcn_rcpf(1.f + __builtin_amdgcn_exp2f(-1.4426950408889634f * y1));
        *(unsigned*)(Mo + (size_t)i * DMODEL) = pk2(o0, o1);
    }
}

__device__ __forceinline__ void combine_rows(const bf16* O0, const bf16* O1, const float* subg, float lam, bf16* MIX, int gw, int NGW, int lane) {
    const int e0 = (lane & 15) * 8;
    const f32x4 g0 = *(const f32x4*)(subg + e0), g1 = *(const f32x4*)(subg + e0 + 4);
    for (int row = gw; row < NTOK; row += NGW) {
#pragma unroll
        for (int half = 0; half < 2; ++half) {
            const int col = (half * 4 + (lane >> 4)) * 128 + e0;
            const v4u a = *(const GAS v4u*)(O0 + (size_t)row * 1024 + col), b = *(const GAS v4u*)(O1 + (size_t)row * 1024 + col);
            float d[8];
            d[0] = bflo(a.x) - lam * bflo(b.x); d[1] = bfhi(a.x) - lam * bfhi(b.x); d[2] = bflo(a.y) - lam * bflo(b.y); d[3] = bfhi(a.y) - lam * bfhi(b.y);
            d[4] = bflo(a.z) - lam * bflo(b.z); d[5] = bfhi(a.z) - lam * bfhi(b.z); d[6] = bflo(a.w) - lam * bflo(b.w); d[7] = bfhi(a.w) - lam * bfhi(b.w);
            float ss = 0.f;
#pragma unroll
            for (int i = 0; i < 8; ++i) ss += d[i] * d[i];
            ss += __shfl_xor(ss, 1); ss += __shfl_xor(ss, 2); ss += __shfl_xor(ss, 4); ss += __shfl_xor(ss, 8);
            const float rs = (1.f - LAM_INIT) / sqrtf(ss * (1.f / 128.f) + 1e-6f);
            v4u o; o.x = pk2(d[0] * rs * g0.x, d[1] * rs * g0.y); o.y = pk2(d[2] * rs * g0.z, d[3] * rs * g0.w); o.z = pk2(d[4] * rs * g1.x, d[5] * rs * g1.y); o.w = pk2(d[6] * rs * g1.z, d[7] * rs * g1.w);
            *(GAS v4u*)(MIX + (size_t)row * DMODEL + CONVW + col) = o;
        }
    }
}

#if MK_NAIVE_ATTN
__device__ __forceinline__ void attn_naive(const bf16* Q, const bf16* K, const bf16* V, bf16* O0, bf16* O1, LAS unsigned char* lds, int gw, int NGW, int wave, int lane) {
    LAS float* sc = (LAS float*)(lds + wave * 16384);
    for (int it = gw; it < NBATCH * 16 * 2 * SEQL; it += NGW) {
        const int q = it & (SEQL - 1), st = it >> 12, vh = st & 1, hq = (st >> 1) & 15, b = st >> 5, c = hq & 1, hv = (hq >> 1) * 2 + vh;
        const bf16* Qr = Q + ((size_t)b * SEQL + q) * 1024 + hq * 64;
        v4u qv[8];
#pragma unroll
        for (int i = 0; i < 8; ++i) qv[i] = *(const GAS v4u*)(Qr + 8 * i);
        float mx = -INFINITY;
        for (int j = lane; j <= q; j += 64) {
            const bf16* Kr = K + ((size_t)b * SEQL + j) * 1024 + hq * 64; float s = 0.f;
#pragma unroll
            for (int i = 0; i < 8; ++i) { const v4u kv = *(const GAS v4u*)(Kr + 8 * i);
                s = pg8::dot2bf(qv[i].x, kv.x, s); s = pg8::dot2bf(qv[i].y, kv.y, s); s = pg8::dot2bf(qv[i].z, kv.z, s); s = pg8::dot2bf(qv[i].w, kv.w, s); }
            sc[j] = s; mx = fmaxf(mx, s);
        }
#pragma unroll
        for (int o = 1; o < 64; o <<= 1) mx = fmaxf(mx, __shfl_xor(mx, o));
        float l = 0.f;
        for (int j = lane; j <= q; j += 64) { const float p = exp2f(sc[j] - mx); sc[j] = p; l += p; }
        l = wave_sum(l);
        LDS_WAIT(); asm volatile("" ::: "memory");
        const bf16* Vc = V + (size_t)b * SEQL * 1024 + hv * 64 + lane; float o = 0.f;
        for (int j = 0; j <= q; ++j) o += sc[j] * __builtin_bit_cast(float, (unsigned)Vc[(size_t)j * 1024] << 16);
        bf16* Od = (c ? O1 : O0) + ((size_t)b * SEQL + q) * 1024 + hv * 64 + lane;
        *Od = (bf16)f2bf(o / l);
        LDS_WAIT(); asm volatile("" ::: "memory");
    }
}
#endif

__device__ __forceinline__ void peer_phase(float* HO, const float* SALL, const bf16* UT, const bf16* VT, const float* g_peer, const float* g_final,
                                           LAS unsigned char* lds, int gw, int NGW, int wave, int lane) {
    LAS int* ids = (LAS int*)(lds + wave * 1024); LAS float* gts = (LAS float*)(lds + wave * 1024 + 512);
    for (int t = gw; t < NTOK; t += NGW) {
#pragma unroll 1
        for (int h = 0; h < 8; ++h) {
            const float* sp = SALL + (size_t)t * 2048 + h * 256;
            float a[2] = {sp[lane], sp[64 + lane]}, b[2] = {sp[128 + lane], sp[192 + lane]};
            float v1, v2; int i1, i2;
            wave_top16<2>(a, lane, v1, i1);
            wave_top16<2>(b, lane, v2, i2);
            float cd[4]; const float v2j = __shfl(v2, lane & 15);
#pragma unroll
            for (int q = 0; q < 4; ++q) cd[q] = __shfl(v1, (lane >> 4) + 4 * q) + v2j;
            float sc; int ci;
            wave_top16<4>(cd, lane, sc, ci);
            const int e1 = __shfl(i1, ci >> 4), e2 = __shfl(i2, ci & 15);
            const float mx = __shfl(sc, 0);
            const float e = lane < 16 ? __expf(sc - mx) : 0.f;
            const float sum = wave_sum_u(e);
            if (lane < 16) { ids[h * 16 + lane] = e1 * 128 + e2; gts[h * 16 + lane] = e / sum; }
        }
        float* hrow = HO + (size_t)t * DMODEL + lane * 8;
        unsigned xp[16];
        {
            f32x4 hv[8]; float ss = 0.f;
#pragma unroll
            for (int j = 0; j < 4; ++j) { hv[2 * j] = *(const f32x4*)(hrow + j * 512); hv[2 * j + 1] = *(const f32x4*)(hrow + j * 512 + 4); }
#pragma unroll
            for (int j = 0; j < 8; ++j) ss += (hv[j].x * hv[j].x + hv[j].y * hv[j].y) + (hv[j].z * hv[j].z + hv[j].w * hv[j].w);
            const float rs = 1.f / sqrtf(wave_sum(ss) * (1.f / DMODEL) + 1e-6f);
#pragma unroll
            for (int j = 0; j < 4; ++j) { const f32x4 ga = *(const f32x4*)(g_peer + j * 512 + lane * 8), gb = *(const f32x4*)(g_peer + j * 512 + lane * 8 + 4);
                xp[4 * j + 0] = pk2(hv[2 * j].x * rs * ga.x, hv[2 * j].y * rs * ga.y); xp[4 * j + 1] = pk2(hv[2 * j].z * rs * ga.z, hv[2 * j].w * rs * ga.w);
                xp[4 * j + 2] = pk2(hv[2 * j + 1].x * rs * gb.x, hv[2 * j + 1].y * rs * gb.y); xp[4 * j + 3] = pk2(hv[2 * j + 1].z * rs * gb.z, hv[2 * j + 1].w * rs * gb.w); }
        }
        LDS_WAIT(); asm volatile("" ::: "memory");
        float y[32];
#pragma unroll
        for (int i = 0; i < 32; ++i) y[i] = 0.f;
#pragma unroll 1
        for (int k0 = 0; k0 < 128; k0 += 4) {
            int id[4]; float gt[4];
#pragma unroll
            for (int e = 0; e < 4; ++e) { id[e] = __builtin_amdgcn_readfirstlane(ids[k0 + e]); gt[e] = __builtin_bit_cast(float, __builtin_amdgcn_readfirstlane(__builtin_bit_cast(int, gts[k0 + e]))); }
            v4u ur[4][4], vr[4][4];
#pragma unroll
            for (int e = 0; e < 4; ++e)
#pragma unroll
                for (int j = 0; j < 4; ++j) ur[e][j] = *(const GAS v4u*)(UT + (size_t)id[e] * DMODEL + j * 512 + lane * 8);
#pragma unroll
            for (int e = 0; e < 4; ++e)
#pragma unroll
                for (int j = 0; j < 4; ++j) vr[e][j] = *(const GAS v4u*)(VT + (size_t)id[e] * DMODEL + j * 512 + lane * 8);
            float w[4];
#pragma unroll
            for (int e = 0; e < 4; ++e) { float p0 = 0.f, p1 = 0.f;
#pragma unroll
                for (int j = 0; j < 4; ++j) { p0 = pg8::dot2bf(ur[e][j].x, xp[4 * j], p0); p1 = pg8::dot2bf(ur[e][j].y, xp[4 * j + 1], p1); p0 = pg8::dot2bf(ur[e][j].z, xp[4 * j + 2], p0); p1 = pg8::dot2bf(ur[e][j].w, xp[4 * j + 3], p1); }
                const float hk = wave_sum_u(p0 + p1);
                w[e] = gt[e] * 0.5f * hk * (1.f + erff(hk * 0.70710678118654752f)); }
#pragma unroll
            for (int e = 0; e < 4; ++e)
#pragma unroll
                for (int j = 0; j < 4; ++j) {
                    y[8 * j + 0] += w[e] * bflo(vr[e][j].x); y[8 * j + 1] += w[e] * bfhi(vr[e][j].x); y[8 * j + 2] += w[e] * bflo(vr[e][j].y); y[8 * j + 3] += w[e] * bfhi(vr[e][j].y);
                    y[8 * j + 4] += w[e] * bflo(vr[e][j].z); y[8 * j + 5] += w[e] * bfhi(vr[e][j].z); y[8 * j + 6] += w[e] * bflo(vr[e][j].w); y[8 * j + 7] += w[e] * bfhi(vr[e][j].w); }
        }
        {
            float ss = 0.f;
#pragma unroll
            for (int j = 0; j < 4; ++j) { const f32x4 ha = *(const f32x4*)(hrow + j * 512), hb = *(const f32x4*)(hrow + j * 512 + 4);
                y[8 * j + 0] += ha.x; y[8 * j + 1] += ha.y; y[8 * j + 2] += ha.z; y[8 * j + 3] += ha.w; y[8 * j + 4] += hb.x; y[8 * j + 5] += hb.y; y[8 * j + 6] += hb.z; y[8 * j + 7] += hb.w; }
#pragma unroll
            for (int i = 0; i < 32; ++i) ss += y[i] * y[i];
            const float rs = 1.f / sqrtf(wave_sum(ss) * (1.f / DMODEL) + 1e-6f);
#pragma unroll
            for (int j = 0; j < 4; ++j) { const f32x4 ga = *(const f32x4*)(g_final + j * 512 + lane * 8), gb = *(const f32x4*)(g_final + j * 512 + lane * 8 + 4);
                *(f32x4*)(hrow + j * 512) = (f32x4){y[8 * j] * rs * ga.x, y[8 * j + 1] * rs * ga.y, y[8 * j + 2] * rs * ga.z, y[8 * j + 3] * rs * ga.w};
                *(f32x4*)(hrow + j * 512 + 4) = (f32x4){y[8 * j + 4] * rs * gb.x, y[8 * j + 5] * rs * gb.y, y[8 * j + 6] * rs * gb.z, y[8 * j + 7] * rs * gb.w}; }
        }
    }
}

struct Args { const float* in[26]; float* out; unsigned char* ws; int ph_lo, ph_hi; };
constexpr int N_PHASES = 9;

#if MK_NAIVE_GEMM
#define RUN_GEMM(EPI, ALIGN, g, S, E) pg8::gemm_phase_naive<EPI, pg8::TileOrder>(ldsp, g, S, E)
#else
#define RUN_GEMM(EPI, ALIGN, g, S, E) pg8::gemm_phase<EPI, pg8::TileOrder, ALIGN, true>(ldsp, g, S, E)
#endif

__global__ void __launch_bounds__(NWAVES * 64, 2) mk_fwd(Args args) {
    extern __shared__ __attribute__((aligned(16))) unsigned char lds[];
    LAS unsigned char* ldsp = (LAS unsigned char*)lds;
    volatile LAS unsigned* MISC = (volatile LAS unsigned*)(ldsp + MISC_OFF);
    const int tid = threadIdx.x, lane = tid & 63, wave = __builtin_amdgcn_readfirstlane(tid >> 6);
    const int G = gridDim.x, bid = blockIdx.x;
    const int vcu = (G % 8 == 0) ? (bid % 8) * (G / 8) + bid / 8 : bid;
    const int gw = vcu * NWAVES + wave, NGW = G * NWAVES;
    unsigned char* ws = args.ws;
    gu32* ctl = (gu32*)(ws + WS_CTL);
    const float* x = args.in[0]; const float* mem = args.in[1]; const float* norm_mix_g = args.in[2]; const float* w_in = args.in[3];
    const float* conv_w = args.in[4]; const float* conv_b = args.in[5]; const float* conv_ln_g = args.in[6]; const float* conv_ln_b = args.in[7];
    const float* lq1 = args.in[8]; const float* lk1 = args.in[9]; const float* lq2 = args.in[10]; const float* lk2 = args.in[11]; const float* subln_g = args.in[12];
    const float* w_out = args.in[13]; const float* norm_cross_g = args.in[14]; const float* norm_mem_g = args.in[15];
    const float* w_cq = args.in[16]; const float* w_ckv = args.in[17]; const float* w_co = args.in[18]; const float* norm_peer_g = args.in[19]; const float* w_pq = args.in[20];
    const float* keys1 = args.in[21]; const float* keys2 = args.in[22]; const float* peer_u = args.in[23]; const float* peer_v = args.in[24]; const float* final_g = args.in[25];
    float* out = args.out;
    float* PART1 = (float*)(ws + WS_PART1); float* PART2 = (float*)(ws + WS_PART2);
    bf16* ABD = (bf16*)(ws + WS_ABD); bf16* W1T = (bf16*)(ws + WS_W1T); bf16* WOUTT = (bf16*)(ws + WS_WOUTT); bf16* WCQ = (bf16*)(ws + WS_WCQ); bf16* WCKVT = (bf16*)(ws + WS_WCKVT);
    bf16* WCOT = (bf16*)(ws + WS_WCOT); bf16* WPQ = (bf16*)(ws + WS_WPQ); bf16* MN = (bf16*)(ws + WS_MN); bf16* KV = (bf16*)(ws + WS_KV); bf16* WKT = (bf16*)(ws + WS_WKT);
    bf16* VWT = (bf16*)(ws + WS_VWT); bf16* WST = (bf16*)(ws + WS_WST); bf16* ACT = (bf16*)(ws + WS_ACT); bf16* UB = (bf16*)(ws + WS_U); bf16* QB = (bf16*)(ws + WS_Q);
    bf16* KB = (bf16*)(ws + WS_K); bf16* VB = (bf16*)(ws + WS_V); bf16* O0 = (bf16*)(ws + WS_O0); bf16* O1 = (bf16*)(ws + WS_O1); bf16* MIX = (bf16*)(ws + WS_MIX);
    bf16* PB = (bf16*)(ws + WS_P); float* SALL = (float*)(ws + WS_SALL); bf16* UTAB = (bf16*)(ws + WS_UTAB); bf16* VTAB = (bf16*)(ws + WS_VTAB);

    for (int u = tid; u < (LDS_BYTES - LDSCTL_OFF) / 4; u += NWAVES * 64) ((LAS unsigned*)(ldsp + LDSCTL_OFF))[u] = 0u;
    __syncthreads();
    const int lo = args.ph_lo, hi = args.ph_hi;
    const bool one_launch = (hi - lo) > 1;
    XcdBarrier bar; bar.bar = (unsigned*)(ctl + CW_BAR); bar.x = 0; bar.st = nullptr;
    if (one_launch) bar = xcd_barrier_post((unsigned*)(ctl + CW_BAR), MISC + 8);
#define IN(k) (lo <= (k) && (k) < hi)
#define SEAM(k) do { if (IN(k) && IN((k) + 1)) xcd_barrier(bar); } while (0)

    if (IN(0)) {
        LAS float* scr = (LAS float*)(ldsp + RING_OFF + wave * 16384);
        constexpr int I_IN = 32 * (INW / 32), I_OUT = 32 * (DMODEL / 32), I_CKV = 32 * (2 * DMODEL / 32), I_CO = I_OUT;
        for (int it = gw; it < I_IN + I_OUT + I_CKV + I_CO; it += NGW) {
            int r = it;
            if (r < I_IN) { const int nblk = INW / 32, kb = r / nblk, nb = r % nblk, n0 = 32 * nb;
                const int dst = (n0 < 2048) ? (((n0 & 1023) >> 7) * 256 + (n0 >> 10) * 128 + (n0 & 127)) : n0;
                p0_transpose_item(w_in, DMODEL, INW, W1T, 64 * kb, n0, dst, scr, lane); continue; } r -= I_IN;
            if (r < I_OUT) { const int nblk = DMODEL / 32; p0_transpose_item(w_out, DMODEL, DMODEL, WOUTT, 64 * (r / nblk), 32 * (r % nblk), 32 * (r % nblk), scr, lane); continue; } r -= I_OUT;
            if (r < I_CKV) { const int nblk = 2 * DMODEL / 32; p0_transpose_item(w_ckv, DMODEL, 2 * DMODEL, WCKVT, 64 * (r / nblk), 32 * (r % nblk), 32 * (r % nblk), scr, lane); continue; } r -= I_CKV;
            { const int nblk = DMODEL / 32; p0_transpose_item(w_co, DMODEL, DMODEL, WCOT, 64 * (r / nblk), 32 * (r % nblk), 32 * (r % nblk), scr, lane); }
        }
        for (int m = gw; m < NTOK + NMEM; m += NGW) {
            if (m < NTOK) rms_row_to_bf16(x + (size_t)m * DMODEL, norm_mix_g, ACT + (size_t)m * DMODEL, lane);
            else rms_row_to_bf16(mem + (size_t)(m - NTOK) * DMODEL, norm_mem_g, MN + (size_t)(m - NTOK) * DMODEL, lane);
        }
        constexpr int C_W = DMODEL * DMODEL / 512, C_T = NEXP * (DMODEL / 512);
        for (int it = gw; it < 2 * C_W + 2 * C_T; it += NGW) {
            int r = it;
            if (r < C_W) { cvt_item(w_cq, WCQ, r, lane); continue; } r -= C_W;
            if (r < C_W) { cvt_item(w_pq, WPQ, r, lane); continue; } r -= C_W;
            if (r < C_T) { cvt_item(peer_u, UTAB, r, lane); continue; } r -= C_T;
            cvt_item(peer_v, VTAB, r, lane);
        }
        for (int it = gw; it < 8 * 256 * 256 / 512; it += NGW) {
            const int e0 = it * 512 + lane * 8, h = e0 >> 16, m = (e0 >> 8) & 255, k = e0 & 255;
            v4u o = (v4u){0u, 0u, 0u, 0u};
            const float* src = nullptr;
            if (m < 128 && k < 128) src = keys1 + ((size_t)h * 128 + m) * 128 + k;
            else if (m >= 128 && k >= 128) src = keys2 + ((size_t)h * 128 + (m - 128)) * 128 + (k - 128);
            if (src) { const f32x4 a = *(const f32x4*)src, b = *(const f32x4*)(src + 4); o.x = pk2(a.x, a.y); o.y = pk2(a.z, a.w); o.z = pk2(b.x, b.y); o.w = pk2(b.z, b.w); }
            *(GAS v4u*)(ABD + e0) = o;
        }
    }
    SEAM(0);

    if (IN(1)) {
        { pg8::Gemm g{ACT, W1T, DMODEL, DMODEL, DMODEL, 1, 0, 0, 0, 0}; pg8::TileOrder S; S.init(NTOK / 256, INW / 256, 1, G, bid);
          pg8::EpiZ E{UB, QB, (long)((WS_K - WS_Q) / 2), C2Q}; RUN_GEMM(pg8::EpiZ, true, g, S, E); }
        { pg8::Gemm g{MN, WCKVT, DMODEL, DMODEL, DMODEL, 1, 0, 0, 0, 0}; pg8::TileOrder S; S.init(NMEM / 256, 2 * DMODEL / 256, 1, G, (bid + G - 128) % G);
          pg8::EpiBf16S E{KV, 2 * DMODEL, 1, 0, 0, nullptr, 1.f}; RUN_GEMM(pg8::EpiBf16S, true, g, S, E); }
    }
    SEAM(1);

    if (IN(2)) {
#if MK_NAIVE_ATTN
        attn_naive(QB, KB, VB, O0, O1, ldsp, gw, NGW, wave, lane);
#else
        for (int idx = vcu; idx < 256; idx += G) {
            const int st = idx >> 2, s = idx & 3, vh = st & 1, hq = (st >> 1) & 15, b = st >> 5, c = hq & 1, hv = (hq >> 1) * 2 + vh;
            attn_body::bf16* Oc = (attn_body::bf16*)(c ? O1 : O0);
#pragma unroll 1
            for (int i = 0; i < 4; ++i) { const int qb = (i == 0) ? 15 - s : (i == 1) ? s : (i == 2) ? 11 - s : 4 + s;
                attn_body::attn_unit<8>(b, hq, hv, qb, (const attn_body::bf16*)QB, (const attn_body::bf16*)KB, (const attn_body::bf16*)VB, Oc, (char*)lds); }
        }
#endif
        for (int u = vcu; u < NBATCH * (SEQL / 32); u += G) conv_unit(UB, conv_w, conv_b, conv_ln_g, conv_ln_b, MIX, u / (SEQL / 32), (u % (SEQL / 32)) * 32, tid);
    }
    SEAM(2);

    if (IN(3)) {
        const float l1 = wave_sum(lq1[lane] * lk1[lane]), l2 = wave_sum(lq2[lane] * lk2[lane]);
        const float lam = expf(l1) - expf(l2) + LAM_INIT;
        combine_rows(O0, O1, subln_g, lam, MIX, gw, NGW, lane);
        { pg8::Gemm g{KV, WCQ, 2 * DMODEL, DMODEL, 512, 4, (long)MEMLEN * 2 * DMODEL, 512, 0, 512}; pg8::TileOrder S; S.init(1, DMODEL / 256, 8, G, bid);
          pg8::EpiBf16S E{WKT, DMODEL, 4, (long)1024 * DMODEL, (long)256 * DMODEL, norm_cross_g, CROSS_SC}; RUN_GEMM(pg8::EpiBf16S, true, g, S, E); }
    }
    SEAM(3);

    if (IN(4)) {
        pg8::Gemm g{MIX, WOUTT, DMODEL, DMODEL, DMODEL, 1, 0, 0, 0, 0}; pg8::TileOrder S; S.init(NTOK / 256, DMODEL / 256, 1, G, bid);
        pg8::EpiRes E{x, out, ACT, PART1, 0}; RUN_GEMM(pg8::EpiRes, true, g, S, E);
    }
    SEAM(4);

    if (IN(5)) {
        { pg8::Gemm g{ACT, WKT, DMODEL, DMODEL, DMODEL, 1, (long)SEQL * DMODEL, 0, (long)1024 * DMODEL, 0}; pg8::TileOrder S; S.init(SEQL / 256, 4, NBATCH, G, bid < 128 ? bid : -1);
          pg8::EpiSoftmax E{PART1, PB, SEQL}; RUN_GEMM(pg8::EpiSoftmax, false, g, S, E); }
        { pg8::Gemm g{WCOT, KV + DMODEL, DMODEL, 2 * DMODEL, 512, 4, 0, 512, (long)MEMLEN * 2 * DMODEL, 512}; pg8::TileOrder S; S.init(DMODEL / 256, 1, 8, G, (bid >= 128 && bid < 192) ? bid - 128 : -1);
          pg8::EpiBf16S E{VWT, 1024, 4, (long)DMODEL * 1024, 256, nullptr, 1.f}; RUN_GEMM(pg8::EpiBf16S, true, g, S, E); }
        { pg8::Gemm g{ABD, WPQ, 256, DMODEL, 256, 1, 65536, 0, 256, 0}; pg8::TileOrder S; S.init(1, DMODEL / 256, 8, G, (bid >= 192 && bid < 256) ? bid - 192 : -1);
          pg8::EpiBf16S E{WST, DMODEL, 1, (long)256 * DMODEL, 0, norm_peer_g, 1.f}; RUN_GEMM(pg8::EpiBf16S, true, g, S, E); }
    }
    SEAM(5);

    if (IN(6)) {
        pg8::Gemm g{PB, VWT, 1024, 1024, 1024, 1, (long)SEQL * 1024, 0, (long)DMODEL * 1024, 0}; pg8::TileOrder S; S.init(SEQL / 256, DMODEL / 256, NBATCH, G, bid);
        pg8::EpiRes E{out, out, ACT, PART2, SEQL}; RUN_GEMM(pg8::EpiRes, true, g, S, E);
    }
    SEAM(6);

    if (IN(7)) {
        pg8::Gemm g{ACT, WST, DMODEL, DMODEL, DMODEL, 1, 0, 0, 0, 0}; pg8::TileOrder S; S.init(NTOK / 256, DMODEL / 256, 1, G, bid);
        pg8::EpiScore E{PART2, SALL}; RUN_GEMM(pg8::EpiScore, true, g, S, E);
    }
    SEAM(7);

    if (IN(8)) peer_phase(out, SALL, UTAB, VTAB, norm_peer_g, final_g, ldsp, gw, NGW, wave, lane);
#undef IN
#undef SEAM
}

extern "C" void kernel_launch(void* const* d_in, const int* in_sizes, int n_in, void* d_out, int out_size, void* d_ws, size_t ws_size, hipStream_t stream) {
    static int grid = 0;
    if (grid == 0) {
        if (n_in != 26 || in_sizes[0] != NTOK * DMODEL || out_size != NTOK * DMODEL || ws_size < WS_END) {
            fprintf(stderr, "kernel_launch: unexpected shapes (n_in %d, in0 %d, out %d, ws %zu); nothing launched\n", n_in, n_in > 0 ? in_sizes[0] : -1, out_size, ws_size); grid = -1; return; }
        int dev = 0, cus = 0, per_cu = 0;
        if (hipGetDevice(&dev) != hipSuccess || hipDeviceGetAttribute(&cus, hipDeviceAttributeMultiprocessorCount, dev) != hipSuccess) { fprintf(stderr, "kernel_launch: device query failed\n"); grid = -1; return; }
        if (hipFuncSetAttribute((const void*)mk_fwd, hipFuncAttributeMaxDynamicSharedMemorySize, LDS_BYTES) != hipSuccess) { fprintf(stderr, "kernel_launch: hipFuncSetAttribute failed\n"); grid = -1; return; }
        if (hipOccupancyMaxActiveBlocksPerMultiprocessor(&per_cu, (const void*)mk_fwd, NWAVES * 64, LDS_BYTES) != hipSuccess || per_cu < 1) {
            fprintf(stderr, "kernel_launch: occupancy query reports %d workgroups per CU; nothing launched\n", per_cu); (void)hipGetLastError(); grid = -1; return; }
        grid = cus;
        if (grid != 256) { fprintf(stderr, "kernel_launch: built for a 256-CU device, found %d CUs; nothing launched\n", cus); grid = -1; return; }
    }
    if (grid < 0) return;
    (void)hipMemsetAsync((char*)d_ws + WS_CTL, 0, CTL_ZERO_BYTES, stream);
    Args a{};
    for (int i = 0; i < 26; ++i) a.in[i] = (const float*)d_in[i];
    a.out = (float*)d_out; a.ws = (unsigned char*)d_ws;
#if MK_LAUNCH_PER_PHASE
    for (int p = 0; p < N_PHASES; ++p) { a.ph_lo = p; a.ph_hi = p + 1; hipLaunchKernelGGL(mk_fwd, dim3(grid), dim3(NWAVES * 64), LDS_BYTES, stream, a); }
#else
    a.ph_lo = 0; a.ph_hi = N_PHASES; hipLaunchKernelGGL(mk_fwd, dim3(grid), dim3(NWAVES * 64), LDS_BYTES, stream, a);
#endif
}
```

```cpp
#include <hip/hip_runtime.h>
#include <hip/hip_bf16.h>
#include <cstdio>
#include <cstdint>
#include <cmath>

#ifndef MK_LAUNCH_PER_PHASE
#define MK_LAUNCH_PER_PHASE 0
#endif
#ifndef MK_REPEAT_MASK
#define MK_REPEAT_MASK 0
#endif
#ifndef MK_ATTN128
#define MK_ATTN128 1
#endif
#ifndef MK_NAIVE_GEMM
#define MK_NAIVE_GEMM 0
#endif
#ifndef MK_NAIVE_ATTN
#define MK_NAIVE_ATTN 0
#endif

__device__ __forceinline__ int mk_lane() { int l = (int)__builtin_amdgcn_mbcnt_hi(~0u, __builtin_amdgcn_mbcnt_lo(~0u, 0u)); asm volatile("" : "+v"(l)); return l; }
__device__ __forceinline__ int mk_tid(int wave) { return wave * 64 + mk_lane(); }
namespace pg8 {
#define PG8_LAS __attribute__((address_space(3)))
typedef unsigned short bf16_t;
typedef short bf16x8 __attribute__((ext_vector_type(8)));
typedef float f32x4 __attribute__((ext_vector_type(4)));
typedef unsigned u32x4 __attribute__((ext_vector_type(4)));
typedef float f32x2_t __attribute__((ext_vector_type(2)));
typedef __bf16 bf16x2_t __attribute__((ext_vector_type(2)));
constexpr int BM = 256, BK = 64, HALF = 128, HTB = HALF * BK * 2  , STAGE_BYTES = 8 * HTB, NXCD = 8, WGM = 4;

__host__ __device__ __forceinline__ int lds_byte(int r, int c) { const int st = (r >> 4) * 2 + (c >> 5), rr = r & 15, cc = c & 31, ob = rr * 64 + cc * 2; return st * 1024 + (ob ^ (((ob >> 9) & 1) << 5)); }
__host__ __device__ __forceinline__ void stage_rc(int b, int& R, int& C) { const int st = b / 1024, sb = b % 1024, swz = sb ^ (((sb >> 9) & 1) << 5); R = (st >> 1) * 16 + swz / 64; C = (st & 1) * 32 + (swz % 64) / 2; }
__host__ __device__ __forceinline__ int perm32(int rho) { const int n = rho >> 4, i = rho & 15; return 8 * (i >> 2) + 4 * n + (i & 3); }

struct Unit { int pm, pn, z; };
struct Gemm { const bf16_t* A; const bf16_t* Bt; int lda, ldb, K, Z1; long sa0, sa1, sb0, sb1; };
__device__ __forceinline__ const char* a_tile(const Gemm& g, const Unit& u) { const int z0 = u.z / g.Z1, z1 = u.z % g.Z1; return (const char*)(g.A + z0 * g.sa0 + z1 * g.sa1 + (long)u.pm * BM * g.lda); }
__device__ __forceinline__ const char* b_tile(const Gemm& g, const Unit& u) { const int z0 = u.z / g.Z1, z1 = u.z % g.Z1; return (const char*)(g.Bt + z0 * g.sb0 + z1 * g.sb1 + (long)u.pn * BM * g.ldb); }

struct TileOrder {
    int nM, nN, per, nwg, G, c;
    __device__ __forceinline__ void init(int nM_, int nN_, int Z, int G_, int c_) { nM = nM_; nN = nN_; per = nM_ * nN_; nwg = per * Z; G = G_; c = c_; }
    __device__ __forceinline__ bool next(int i, Unit& u) const {
        if (c < 0) return false;
        const long L = (long)i * G + c; if (L >= nwg) return false;
        int wgid = (int)L; { const int q = nwg / NXCD, r = nwg % NXCD, xcd = wgid % NXCD, off = wgid / NXCD; wgid = (xcd < r ? xcd * (q + 1) : r * (q + 1) + (xcd - r) * q) + off; }
        u.z = wgid / per; const int w = wgid % per;
        const int nig = WGM * nN, gid = w / nig, fm = gid * WGM, gsz = (nM - fm) < WGM ? (nM - fm) : WGM;
        u.pm = fm + ((w % nig) % gsz); u.pn = (w % nig) / gsz; return true;
    }
    __device__ __forceinline__ void a_ready(const Unit&) const {}
    __device__ __forceinline__ void done(const Unit&) const {}
};

__device__ __forceinline__ unsigned pk2(float lo, float hi) { f32x2_t v = {lo, hi}; bf16x2_t b = __builtin_convertvector(v, bf16x2_t); return __builtin_bit_cast(unsigned, b); }
__device__ __forceinline__ u32x4 pk8(const f32x4& a, const f32x4& b) { u32x4 w; w.x = pk2(a[0], a[1]); w.y = pk2(a[2], a[3]); w.z = pk2(b[0], b[1]); w.w = pk2(b[2], b[3]); return w; }
__device__ __forceinline__ float dot2bf(unsigned a, unsigned b, float c) { return __builtin_amdgcn_fdot2_f32_bf16(__builtin_bit_cast(bf16x2_t, a), __builtin_bit_cast(bf16x2_t, b), c, false); }

__device__ __forceinline__ float rstd_from_parts(const float* part, int row) {
    const f32x4* p = (const f32x4*)(part + (size_t)row * 32); float s = 0.f;
#pragma unroll
    for (int i = 0; i < 8; ++i) { const f32x4 v = p[i]; s += (v[0] + v[1]) + (v[2] + v[3]); }
    return 1.0f / sqrtf(s * (1.0f / 2048.0f) + 1e-6f);
}


struct EpiZ {
    static constexpr bool PERM = true, AFTER_DRAIN = false;
    bf16_t *U, *Q; long qkv_stride; float qscale;
    __device__ __forceinline__ void operator()(const f32x4 (&acc)[2][2][4][2], const Unit& u, int wr, int wc, int fr, int fq) const {
        const int row0 = u.pm * BM + wr * 64 + fr;
        if (u.pn < 8) {
            const int col = 128 * u.pn + 32 * wc + 8 * fq;
#pragma unroll
            for (int ai = 0; ai < 2; ++ai)
#pragma unroll
                for (int m = 0; m < 4; ++m) {
                    f32x4 o[2];
#pragma unroll
                    for (int n = 0; n < 2; ++n)
#pragma unroll
                        for (int e = 0; e < 4; ++e) { const float a = acc[ai][0][m][n][e], g = acc[ai][1][m][n][e]; o[n][e] = a * __builtin_amdgcn_rcpf(1.0f + __builtin_amdgcn_exp2f(-1.4426950408889634f * g)); }
                    *(u32x4*)(U + (size_t)(row0 + ai * HALF + m * 16) * 1024 + col) = pk8(o[0], o[1]);
                }
        } else {
            const int t = (u.pn - 8) >> 2; bf16_t* base = Q + (long)t * qkv_stride; const float sc = (t == 0) ? qscale : 1.0f;
            const int colt = ((u.pn - 8) & 3) * BM + 32 * wc + 8 * fq;
#pragma unroll
            for (int ai = 0; ai < 2; ++ai)
#pragma unroll
                for (int m = 0; m < 4; ++m)
#pragma unroll
                    for (int bj = 0; bj < 2; ++bj) { const f32x4 v0 = acc[ai][bj][m][0] * sc, v1 = acc[ai][bj][m][1] * sc;
                        *(u32x4*)(base + (size_t)(row0 + ai * HALF + m * 16) * 1024 + colt + bj * HALF) = pk8(v0, v1); }
        }
    }
};
struct EpiBf16S {
    static constexpr bool PERM = true, AFTER_DRAIN = false;
    bf16_t* O; int ldc, Z1; long so0, so1; const float* colscale; float cs;
    __device__ __forceinline__ void operator()(const f32x4 (&acc)[2][2][4][2], const Unit& u, int wr, int wc, int fr, int fq) const {
        const int row0 = u.pm * BM + wr * 64 + fr, col0 = u.pn * BM + wc * 32 + 8 * fq;
        bf16_t* base = O + (u.z / Z1) * so0 + (u.z % Z1) * so1;
        f32x4 sv[2][2];
#pragma unroll
        for (int bj = 0; bj < 2; ++bj)
#pragma unroll
            for (int n = 0; n < 2; ++n) { sv[bj][n] = colscale ? *(const f32x4*)(colscale + col0 + bj * HALF + 4 * n) : (f32x4){1.f, 1.f, 1.f, 1.f}; sv[bj][n] = sv[bj][n] * cs; }
#pragma unroll
        for (int ai = 0; ai < 2; ++ai)
#pragma unroll
            for (int m = 0; m < 4; ++m)
#pragma unroll
                for (int bj = 0; bj < 2; ++bj) { const f32x4 v0 = acc[ai][bj][m][0] * sv[bj][0], v1 = acc[ai][bj][m][1] * sv[bj][1];
                    *(u32x4*)(base + (size_t)(row0 + ai * HALF + m * 16) * ldc + col0 + bj * HALF) = pk8(v0, v1); }
    }
};
template <bool RESF32> struct EpiRes {
    static constexpr bool PERM = true, AFTER_DRAIN = false;
    const float* resf; bf16_t* Hb; float* part; int rows_per_z;
    __device__ __forceinline__ void finish(const f32x4& r0, const f32x4& r1, const f32x4& a0, const f32x4& a1, size_t off, float& ss) const {
        const f32x4 h0 = r0 + a0, h1 = r1 + a1;
        *(u32x4*)(Hb + off) = pk8(h0, h1);
        ss += (h0[0] * h0[0] + h0[1] * h0[1]) + (h0[2] * h0[2] + h0[3] * h0[3]) + (h1[0] * h1[0] + h1[1] * h1[1]) + (h1[2] * h1[2] + h1[3] * h1[3]);
    }
    __device__ __forceinline__ void operator()(const f32x4 (&acc)[2][2][4][2], const Unit& u, int wr, int wc, int fr, int fq) const {
        const int row0 = u.z * rows_per_z + u.pm * BM + wr * 64 + fr, colw = u.pn * BM + wc * 32 + 8 * fq;
        if (!RESF32) {
            u32x4 rw[2][4][2];
#pragma unroll
            for (int ai = 0; ai < 2; ++ai)
#pragma unroll
                for (int m = 0; m < 4; ++m)
#pragma unroll
                    for (int bj = 0; bj < 2; ++bj) rw[ai][m][bj] = *(const u32x4*)(Hb + (size_t)(row0 + ai * HALF + m * 16) * 2048 + colw + bj * HALF);
#pragma unroll
            for (int ai = 0; ai < 2; ++ai)
#pragma unroll
                for (int m = 0; m < 4; ++m) { const int row = row0 + ai * HALF + m * 16; float ss = 0.f;
#pragma unroll
                    for (int bj = 0; bj < 2; ++bj) { const size_t off = (size_t)row * 2048 + colw + bj * HALF; const u32x4 w = rw[ai][m][bj];
                        const f32x4 r0 = (f32x4){__builtin_bit_cast(float, w.x << 16), __builtin_bit_cast(float, w.x & 0xffff0000u), __builtin_bit_cast(float, w.y << 16), __builtin_bit_cast(float, w.y & 0xffff0000u)};
                        const f32x4 r1 = (f32x4){__builtin_bit_cast(float, w.z << 16), __builtin_bit_cast(float, w.z & 0xffff0000u), __builtin_bit_cast(float, w.w << 16), __builtin_bit_cast(float, w.w & 0xffff0000u)};
                        finish(r0, r1, acc[ai][bj][m][0], acc[ai][bj][m][1], off, ss); }
                    ss += __shfl_xor(ss, 16); ss += __shfl_xor(ss, 32);
                    if (fq == 0) part[(size_t)row * 32 + u.pn * 4 + wc] = ss; }
        } else {
            f32x4 bA[4][2], bB[4][2];
#define ER_LOAD(BUF, G) _Pragma("unroll") for (int mm = 0; mm < 2; ++mm) _Pragma("unroll") for (int bj = 0; bj < 2; ++bj) { \
                const size_t off = (size_t)(row0 + ((G) >> 1) * HALF + (((G) & 1) * 2 + mm) * 16) * 2048 + colw + bj * HALF; \
                BUF[mm * 2 + bj][0] = __builtin_nontemporal_load((const f32x4*)(resf + off)); BUF[mm * 2 + bj][1] = __builtin_nontemporal_load((const f32x4*)(resf + off + 4)); }
#define ER_PROC(BUF, G) _Pragma("unroll") for (int mm = 0; mm < 2; ++mm) { const int ai = (G) >> 1, m = ((G) & 1) * 2 + mm, row = row0 + ai * HALF + m * 16; float ss = 0.f; \
                _Pragma("unroll") for (int bj = 0; bj < 2; ++bj) finish(BUF[mm * 2 + bj][0], BUF[mm * 2 + bj][1], acc[ai][bj][m][0], acc[ai][bj][m][1], (size_t)row * 2048 + colw + bj * HALF, ss); \
                ss += __shfl_xor(ss, 16); ss += __shfl_xor(ss, 32); \
                if (fq == 0) part[(size_t)row * 32 + u.pn * 4 + wc] = ss; }
            ER_LOAD(bA, 0); ER_LOAD(bB, 1);
            ER_PROC(bA, 0); ER_LOAD(bA, 2);
            ER_PROC(bB, 1); ER_LOAD(bB, 3);
            ER_PROC(bA, 2); ER_PROC(bB, 3);
#undef ER_LOAD
#undef ER_PROC
        }
    }
};
struct EpiScore {
    static constexpr bool PERM = true, AFTER_DRAIN = false;
    const PG8_LAS float* rstd; float* S;
    __device__ __forceinline__ void operator()(const f32x4 (&acc)[2][2][4][2], const Unit& u, int wr, int wc, int fr, int fq) const {
        const int row0 = u.pm * BM + wr * 64 + fr, colw = u.pn * BM + wc * 32 + 8 * fq;
#pragma unroll
        for (int ai = 0; ai < 2; ++ai)
#pragma unroll
            for (int m = 0; m < 4; ++m) { const int row = row0 + ai * HALF + m * 16; const float rs = rstd[ai * HALF + wr * 64 + m * 16 + fr];
#pragma unroll
                for (int bj = 0; bj < 2; ++bj) { const size_t off = (size_t)row * 2048 + colw + bj * HALF;
                    *(f32x4*)(S + off) = acc[ai][bj][m][0] * rs; *(f32x4*)(S + off + 4) = acc[ai][bj][m][1] * rs; } }
    }
};
struct EpiSoftmax {
    static constexpr bool PERM = true, AFTER_DRAIN = true;
    const PG8_LAS float* rstd; bf16_t* P; int rows_per_z;
    __device__ __forceinline__ void fused(f32x4 (&acc)[2][2][4][2], const Unit& u, int wr, int wc, int fr, int fq, PG8_LAS unsigned char* lds, int wid, int lane) const {
        PG8_LAS float* Pm = (PG8_LAS float*)lds; PG8_LAS float* Ps = (PG8_LAS float*)(lds + 4096);
        const int rl0 = wr * 64 + fr, grow0 = u.z * rows_per_z + u.pm * BM + rl0;
#pragma unroll
        for (int ai = 0; ai < 2; ++ai)
#pragma unroll
            for (int m = 0; m < 4; ++m) { const float rs = rstd[rl0 + ai * HALF + m * 16]; float mx = -INFINITY;
#pragma unroll
                for (int bj = 0; bj < 2; ++bj)
#pragma unroll
                    for (int n = 0; n < 2; ++n) { acc[ai][bj][m][n] = acc[ai][bj][m][n] * rs; const f32x4 v = acc[ai][bj][m][n]; mx = fmaxf(mx, fmaxf(fmaxf(v[0], v[1]), fmaxf(v[2], v[3]))); }
                mx = fmaxf(mx, __shfl_xor(mx, 16)); mx = fmaxf(mx, __shfl_xor(mx, 32));
                if (fq == 0) Pm[(rl0 + ai * HALF + m * 16) * 4 + wc] = mx; }
        asm volatile("s_waitcnt lgkmcnt(0)" ::: "memory"); __builtin_amdgcn_s_barrier(); asm volatile("" ::: "memory");
#pragma unroll
        for (int ai = 0; ai < 2; ++ai)
#pragma unroll
            for (int m = 0; m < 4; ++m) { const int rl = rl0 + ai * HALF + m * 16; const f32x4 q = *(const PG8_LAS f32x4*)(Pm + rl * 4);
                const float mx = fmaxf(fmaxf(q[0], q[1]), fmaxf(q[2], q[3])); float s = 0.f;
#pragma unroll
                for (int bj = 0; bj < 2; ++bj)
#pragma unroll
                    for (int n = 0; n < 2; ++n)
#pragma unroll
                        for (int e = 0; e < 4; ++e) { const float p = __builtin_amdgcn_exp2f(acc[ai][bj][m][n][e] - mx); acc[ai][bj][m][n][e] = p; s += p; }
                s += __shfl_xor(s, 16); s += __shfl_xor(s, 32);
                if (fq == 0) Ps[rl * 4 + wc] = s; }
        asm volatile("s_waitcnt lgkmcnt(0)" ::: "memory"); __builtin_amdgcn_s_barrier(); asm volatile("" ::: "memory");
#pragma unroll
        for (int ai = 0; ai < 2; ++ai)
#pragma unroll
            for (int m = 0; m < 4; ++m) { const int rl = rl0 + ai * HALF + m * 16; const f32x4 q = *(const PG8_LAS f32x4*)(Ps + rl * 4);
                const float inv = 1.0f / ((q[0] + q[1]) + (q[2] + q[3]));
#pragma unroll
                for (int bj = 0; bj < 2; ++bj) { const f32x4 v0 = acc[ai][bj][m][0] * inv, v1 = acc[ai][bj][m][1] * inv;
                    *(u32x4*)(P + (size_t)(grow0 + ai * HALF + m * 16) * 1024 + u.pn * BM + bj * HALF + wc * 32 + 8 * fq) = pk8(v0, v1); } }
        asm volatile("s_waitcnt lgkmcnt(0)" ::: "memory"); __builtin_amdgcn_s_barrier(); asm volatile("" ::: "memory");
    }
};

template <class Epi, class Sched>
__device__ __forceinline__ void gemm_phase_naive(PG8_LAS unsigned char* lds, const Gemm g, const Sched& S, const Epi& E, int wave_in) {
    const int tid = mk_tid(wave_in), wid = wave_in, lane = tid & 63, wr = wid >> 2, wc = wid & 3, fr = lane & 15, fq = lane >> 4;
    Unit cur;
    for (int ui = 0; S.next(ui, cur); ++ui) {
        f32x4 acc[2][2][4][2];
#pragma unroll
        for (int a = 0; a < 2; ++a)
#pragma unroll
            for (int b = 0; b < 2; ++b)
#pragma unroll
                for (int m = 0; m < 4; ++m)
#pragma unroll
                    for (int n = 0; n < 2; ++n) acc[a][b][m][n] = (f32x4){0.f, 0.f, 0.f, 0.f};
        const bf16_t* At = (const bf16_t*)a_tile(g, cur); const bf16_t* Bt = (const bf16_t*)b_tile(g, cur);
        for (int k = 0; k < g.K; k += 8) {
            u32x4 a[2][4];
#pragma unroll
            for (int ai = 0; ai < 2; ++ai)
#pragma unroll
                for (int m = 0; m < 4; ++m) a[ai][m] = *(const u32x4*)(At + (size_t)(ai * HALF + wr * 64 + m * 16 + fr) * g.lda + k);
#pragma unroll
            for (int bj = 0; bj < 2; ++bj)
#pragma unroll
                for (int n = 0; n < 2; ++n)
#pragma unroll
                    for (int e = 0; e < 4; ++e) {
                        const int col = bj * HALF + wc * 32 + (Epi::PERM ? (8 * fq + 4 * n + e) : (16 * n + 4 * fq + e));
                        const u32x4 b = *(const u32x4*)(Bt + (size_t)col * g.ldb + k);
#pragma unroll
                        for (int ai = 0; ai < 2; ++ai)
#pragma unroll
                            for (int m = 0; m < 4; ++m) { float s = acc[ai][bj][m][n][e]; s = dot2bf(a[ai][m].x, b.x, s); s = dot2bf(a[ai][m].y, b.y, s); s = dot2bf(a[ai][m].z, b.z, s); s = dot2bf(a[ai][m].w, b.w, s); acc[ai][bj][m][n][e] = s; }
                    }
        }
        if constexpr (!Epi::AFTER_DRAIN) { E(acc, cur, wr, wc, fr, fq); }
        else { __syncthreads(); E.fused(acc, cur, wr, wc, fr, fq, lds, wid, lane); __syncthreads(); }
    }
}

template <class Epi, class Sched, bool ALIGN_EPI = false, bool SP2 = false>
__device__ __forceinline__ void gemm_phase(PG8_LAS unsigned char* lds, const Gemm g, const Sched& S, const Epi& E, int wave_in) {
    const int tid = mk_tid(wave_in), wid = wave_in, lane = tid & 63, wr = wid >> 2, wc = wid & 3, fr = lane & 15, fq = lane >> 4;
    const int K = g.K, nt = K / BK;
    unsigned voffA[2], voffB[2];
#pragma unroll
    for (int i = 0; i < 2; ++i) { int R, C; stage_rc(tid * 16 + i * 8192, R, C); const int Rb = Epi::PERM ? ((R & ~31) + perm32(R & 31)) : R;
        voffA[i] = (unsigned)(R * g.lda + C) * 2u; voffB[i] = (unsigned)(Rb * g.ldb + C) * 2u; }
    const size_t kstep = (size_t)(BK * 2);
    const size_t hstepA = (size_t)HALF * g.lda * 2, hstepB = (size_t)HALF * g.ldb * 2;
    const unsigned ldsw = (unsigned)wid * 1024u;
    const int aoff = lds_byte(wr * 64 + fr, fq * 8), boff = lds_byte(wc * 32 + fr, fq * 8);
#define PG8_SA(b, h) (((b) * 2 + (h)) * HTB)
#define PG8_SB(b, h) ((4 + (b) * 2 + (h)) * HTB)
#define PG8_STAGE(bufoff, gbase, voff) do { _Pragma("unroll") for (int _i = 0; _i < 2; ++_i) \
        __builtin_amdgcn_global_load_lds((const unsigned*)((const char*)(gbase) + (voff)[_i]), (PG8_LAS unsigned*)(lds + (bufoff) + ldsw + _i * 8192), 16, 0, 0); } while (0)
#define PG8_LDA(dst, b, h) do { _Pragma("unroll") for (int m = 0; m < 4; ++m) _Pragma("unroll") for (int k = 0; k < 2; ++k) dst[m][k] = *(const PG8_LAS bf16x8*)(lds + PG8_SA(b, h) + aoff + m * 2048 + k * 1024); } while (0)
#define PG8_LDB(dst, b, h) do { _Pragma("unroll") for (int n = 0; n < 2; ++n) _Pragma("unroll") for (int k = 0; k < 2; ++k) dst[n][k] = *(const PG8_LAS bf16x8*)(lds + PG8_SB(b, h) + boff + n * 2048 + k * 1024); } while (0)
#define PG8_MMA(ai, bj, At, Bt) do { __builtin_amdgcn_s_setprio(1); _Pragma("unroll") for (int m = 0; m < 4; ++m) _Pragma("unroll") for (int n = 0; n < 2; ++n) _Pragma("unroll") for (int k = 0; k < 2; ++k) \
        acc[ai][bj][m][n] = __builtin_amdgcn_mfma_f32_16x16x32_bf16(Bt[n][k], At[m][k], acc[ai][bj][m][n], 0, 0, 0); __builtin_amdgcn_s_setprio(0); } while (0)
#define PG8_WAIT_V(n) asm volatile("s_waitcnt vmcnt(" #n ")" ::: "memory")
#define PG8_WAIT_L(n) asm volatile("s_waitcnt lgkmcnt(" #n ")" ::: "memory")
#define PG8_BAR __builtin_amdgcn_s_barrier()
#define PG8_SCHED __builtin_amdgcn_sched_barrier(0)
    Unit cur, nxt; int ui = 0;
    if (!S.next(0, cur)) return;
    f32x4 acc[2][2][4][2];
#pragma unroll
    for (int a = 0; a < 2; ++a)
#pragma unroll
        for (int b = 0; b < 2; ++b)
#pragma unroll
            for (int m = 0; m < 4; ++m)
#pragma unroll
                for (int n = 0; n < 2; ++n) acc[a][b][m][n] = (f32x4){0.f, 0.f, 0.f, 0.f};
    bf16x8 At[4][2], B0[2][2], B1[2][2];
    const char* cA = a_tile(g, cur); const char* cB = b_tile(g, cur);
    S.a_ready(cur);
    if constexpr (SP2) {
        PG8_STAGE(PG8_SB(0, 0), cB, voffB); PG8_STAGE(PG8_SB(0, 1), cB + hstepB, voffB); PG8_STAGE(PG8_SA(0, 0), cA, voffA); PG8_STAGE(PG8_SA(0, 1), cA + hstepA, voffA);
        if (wr == 1) PG8_BAR;
        PG8_WAIT_V(2); PG8_BAR;
        PG8_STAGE(PG8_SB(1, 0), cB + kstep, voffB); PG8_STAGE(PG8_SA(1, 0), cA + kstep, voffA); PG8_STAGE(PG8_SB(1, 1), cB + hstepB + kstep, voffB);
        PG8_WAIT_V(6); PG8_BAR;
    } else {
        PG8_STAGE(PG8_SB(0, 0), cB, voffB); PG8_STAGE(PG8_SA(0, 0), cA, voffA); PG8_STAGE(PG8_SB(0, 1), cB + hstepB, voffB); PG8_STAGE(PG8_SA(0, 1), cA + hstepA, voffA);
        if (wr == 1) PG8_BAR;
        PG8_WAIT_V(4); PG8_BAR;
        PG8_STAGE(PG8_SB(1, 0), cB + kstep, voffB); PG8_STAGE(PG8_SA(1, 0), cA + kstep, voffA); PG8_STAGE(PG8_SB(1, 1), cB + hstepB + kstep, voffB);
        PG8_WAIT_V(6); PG8_BAR;
    }
    for (;;) {
        const bool has_next = S.next(ui + 1, nxt);
        const char* nA = has_next ? a_tile(g, nxt) : cA; const char* nB = has_next ? b_tile(g, nxt) : cB;
        for (int t = 0; t < nt; t += 2) {
            const bool last = (t == nt - 2);
            const char* a1 = cA + (size_t)(t + 1) * kstep;
            const char* a2 = last ? nA : cA + (size_t)(t + 2) * kstep; const char* b2 = last ? nB : cB + (size_t)(t + 2) * kstep;
            const char* a3 = a2 + kstep; const char* b3 = b2 + kstep;
            if (last && has_next) S.a_ready(nxt);
            if constexpr (SP2) {
            PG8_LDB(B0, 0, 0); PG8_LDB(B1, 0, 1); PG8_SCHED; PG8_LDA(At, 0, 0); PG8_STAGE(PG8_SA(1, 1), a1 + hstepA, voffA);
            PG8_WAIT_V(8); PG8_WAIT_L(0); PG8_BAR; PG8_MMA(0, 0, At, B0); PG8_MMA(0, 1, At, B1); PG8_BAR; PG8_SCHED;
            PG8_LDA(At, 0, 1); PG8_STAGE(PG8_SB(0, 0), b2, voffB); PG8_STAGE(PG8_SB(0, 1), b2 + hstepB, voffB); PG8_STAGE(PG8_SA(0, 0), a2, voffA);
            PG8_WAIT_V(8); PG8_WAIT_L(0); PG8_BAR; PG8_MMA(1, 0, At, B0); PG8_MMA(1, 1, At, B1); PG8_BAR; PG8_SCHED;
            PG8_LDB(B0, 1, 0); PG8_LDB(B1, 1, 1); PG8_SCHED; PG8_LDA(At, 1, 0); PG8_STAGE(PG8_SA(0, 1), a2 + hstepA, voffA);
            PG8_WAIT_V(8); PG8_WAIT_L(0); PG8_BAR; PG8_MMA(0, 0, At, B0); PG8_MMA(0, 1, At, B1); PG8_BAR; PG8_SCHED;
            PG8_LDA(At, 1, 1); PG8_STAGE(PG8_SB(1, 0), b3, voffB); PG8_STAGE(PG8_SB(1, 1), b3 + hstepB, voffB); PG8_STAGE(PG8_SA(1, 0), a3, voffA);
            PG8_WAIT_V(8); PG8_WAIT_L(0); PG8_BAR; PG8_MMA(1, 0, At, B0); PG8_MMA(1, 1, At, B1); PG8_BAR; PG8_SCHED;
            } else {
            PG8_LDB(B0, 0, 0); PG8_SCHED; PG8_LDA(At, 0, 0); PG8_STAGE(PG8_SA(1, 1), a1 + hstepA, voffA);
            PG8_WAIT_L(8); PG8_BAR; PG8_WAIT_L(0); PG8_MMA(0, 0, At, B0); PG8_BAR; PG8_SCHED;
            PG8_LDB(B1, 0, 1); PG8_STAGE(PG8_SB(0, 0), b2, voffB);
            PG8_BAR; PG8_WAIT_L(0); PG8_MMA(0, 1, At, B1); PG8_BAR;
            PG8_LDA(At, 0, 1); PG8_STAGE(PG8_SA(0, 0), a2, voffA);
            PG8_BAR; PG8_WAIT_L(0); PG8_MMA(1, 0, At, B0); PG8_BAR; PG8_SCHED;
            PG8_STAGE(PG8_SB(0, 1), b2 + hstepB, voffB);
            PG8_WAIT_V(6); PG8_BAR; PG8_MMA(1, 1, At, B1); PG8_BAR;
            PG8_LDB(B0, 1, 0); PG8_SCHED; PG8_LDA(At, 1, 0); PG8_STAGE(PG8_SA(0, 1), a2 + hstepA, voffA);
            PG8_WAIT_L(8); PG8_BAR; PG8_WAIT_L(0); PG8_MMA(0, 0, At, B0); PG8_BAR; PG8_SCHED;
            PG8_LDB(B1, 1, 1); PG8_STAGE(PG8_SB(1, 0), b3, voffB);
            PG8_BAR; PG8_WAIT_L(0); PG8_MMA(0, 1, At, B1); PG8_BAR;
            PG8_LDA(At, 1, 1); PG8_STAGE(PG8_SA(1, 0), a3, voffA);
            PG8_BAR; PG8_WAIT_L(0); PG8_MMA(1, 0, At, B0); PG8_BAR; PG8_SCHED;
            PG8_STAGE(PG8_SB(1, 1), b3 + hstepB, voffB);
            PG8_WAIT_V(6); PG8_BAR; PG8_MMA(1, 1, At, B1); PG8_BAR;
            }
        }
        if constexpr (ALIGN_EPI) { if (wr == 0) PG8_BAR; }
        if constexpr (!Epi::AFTER_DRAIN) { E(acc, cur, wr, wc, fr, fq); S.done(cur); }
        if (!has_next) break;
#pragma unroll
        for (int a = 0; a < 2; ++a)
#pragma unroll
            for (int b = 0; b < 2; ++b)
#pragma unroll
                for (int m = 0; m < 4; ++m)
#pragma unroll
                    for (int n = 0; n < 2; ++n) acc[a][b][m][n] = (f32x4){0.f, 0.f, 0.f, 0.f};
        cur = nxt; cA = nA; cB = nB; ++ui;
        if constexpr (ALIGN_EPI) { if (wr == 1) PG8_BAR; }
    }
    PG8_WAIT_V(0);
    if constexpr (!ALIGN_EPI) { if (wr == 0) PG8_BAR; }
    PG8_BAR;
    if constexpr (Epi::AFTER_DRAIN) { E.fused(acc, cur, wr, wc, fr, fq, lds, wid, lane); S.done(cur); }
#undef PG8_SA
#undef PG8_SB
#undef PG8_STAGE
#undef PG8_LDA
#undef PG8_LDB
#undef PG8_MMA
#undef PG8_WAIT_V
#undef PG8_WAIT_L
#undef PG8_BAR
#undef PG8_SCHED
}
}
namespace attn_body {
using bf16=__hip_bfloat16;
using bf16x8=__attribute__((ext_vector_type(8)))short;
using s16x4=__attribute__((ext_vector_type(4)))short;
using f32x16=__attribute__((ext_vector_type(16)))float;
using u32x4=__attribute__((ext_vector_type(4)))unsigned;
constexpr int BATCH=2,NHEAD=16,SEQ=4096,D=64,DM=NHEAD*D;
constexpr int NW=8,QBLK=32,QB=QBLK*NW,KVBLK=64,NQB=SEQ/QB;
constexpr int ATTN_PITCH=DM, ATTN_UNIT_ROWS=QB;
__device__ __forceinline__ int crow(int r,int hi){return (r&3)+8*(r>>2)+4*hi;}
#define SBAR() __builtin_amdgcn_sched_barrier(0)
__device__ __forceinline__ void cmask(f32x16&p0,f32x16&p1,int jb,int qrel,int hi){
  const float NEG=-INFINITY; int kb=64*jb+4*hi;
  #pragma unroll
  for(int r=0;r<16;++r){int kv=kb+(r&3)+8*(r>>2); if(kv>qrel)p0[r]=NEG; if(kv+32>qrel)p1[r]=NEG;}
}

constexpr int NSLOT=3, SLOTB=8192;
constexpr int LDS_K=0, LDS_V=NSLOT*SLOTB, LDS_WS=2*NSLOT*SLOTB, LDS_OST=LDS_WS+NW*64*4, LDS_BYTES=LDS_OST+NW*4096;
constexpr float C2=0.125f*1.4426950408889634f;
__device__ __forceinline__ void glds16(const void*gsrc,unsigned lds_dst){unsigned keep;
  asm volatile("s_mov_b32 %0, m0\n\ts_mov_b32 m0, %2\n\ts_nop 0\n\tglobal_load_lds_dwordx4 %1, off\n\ts_mov_b32 m0, %0":"=&s"(keep):"v"(gsrc),"s"(lds_dst):"memory");}
__device__ __forceinline__ float max3f(float a,float b,float c){float r;asm("v_max3_f32 %0, %1, %2, %3":"=v"(r):"v"(a),"v"(b),"v"(c));return r;}
__device__ __forceinline__ float max2f(float a,float b){float r;asm("v_max_f32_e32 %0, %1, %2":"=v"(r):"v"(a),"v"(b));return r;}
__device__ __forceinline__ float fadd_s(float a,float b){float r;asm("v_add_f32_e32 %0, %1, %2":"=v"(r):"v"(a),"v"(b));return r;}
__device__ __forceinline__ float fsub_s(float a,float b){float r;asm("v_sub_f32_e32 %0, %1, %2":"=v"(r):"v"(a),"v"(b));return r;}
typedef float f32x2_t __attribute__((ext_vector_type(2))); typedef __bf16 bf16x2_t __attribute__((ext_vector_type(2)));
__device__ __forceinline__ unsigned cvtpk_s(float lo,float hi){f32x2_t v={lo,hi};bf16x2_t b=__builtin_convertvector(v,bf16x2_t);return __builtin_bit_cast(unsigned,b);}
#define WAIT_BAR(N) asm volatile("s_waitcnt vmcnt(" #N ") lgkmcnt(0)\n\ts_barrier":::"memory")

__device__ __forceinline__ void qkt(f32x16&p0,f32x16&p1,const char*Kslot,const bf16x8*qr,const f32x16&negm,int r32,int hi){
  const char*kb=Kslot+hi*1024+r32*16;
  #pragma unroll
  for(int d0=0;d0<4;++d0){
    const bf16x8 b0=*reinterpret_cast<const bf16x8*>(kb+d0*2048);
    const bf16x8 b1=*reinterpret_cast<const bf16x8*>(kb+d0*2048+512);
    if(d0==0){p0=__builtin_amdgcn_mfma_f32_32x32x16_bf16(b0,qr[0],negm,0,0,0);p1=__builtin_amdgcn_mfma_f32_32x32x16_bf16(b1,qr[0],negm,0,0,0);}
    else{p0=__builtin_amdgcn_mfma_f32_32x32x16_bf16(b0,qr[d0],p0,0,0,0);p1=__builtin_amdgcn_mfma_f32_32x32x16_bf16(b1,qr[d0],p1,0,0,0);}}
}
typedef __attribute__((address_space(3))) const char* lds_cptr;
typedef short v4i16_t __attribute__((ext_vector_type(4)));
__device__ __forceinline__ void kload8(bf16x8*kf,lds_cptr kp){
  kf[0]=*(const __attribute__((address_space(3))) bf16x8*)(kp);      kf[1]=*(const __attribute__((address_space(3))) bf16x8*)(kp+512);
  kf[2]=*(const __attribute__((address_space(3))) bf16x8*)(kp+2048); kf[3]=*(const __attribute__((address_space(3))) bf16x8*)(kp+2560);
  kf[4]=*(const __attribute__((address_space(3))) bf16x8*)(kp+4096); kf[5]=*(const __attribute__((address_space(3))) bf16x8*)(kp+4608);
  kf[6]=*(const __attribute__((address_space(3))) bf16x8*)(kp+6144); kf[7]=*(const __attribute__((address_space(3))) bf16x8*)(kp+6656);
}
__device__ __forceinline__ void kload2(bf16x8*kf,lds_cptr kp,int j){ kf[2*j]=*(const __attribute__((address_space(3))) bf16x8*)(kp+j*2048); kf[2*j+1]=*(const __attribute__((address_space(3))) bf16x8*)(kp+j*2048+512); }
__device__ __forceinline__ s16x4 vtr(lds_cptr p){ return __builtin_bit_cast(s16x4,__builtin_amdgcn_ds_read_tr16_b64_v4i16((__attribute__((address_space(3))) v4i16_t*)p)); }
__device__ __forceinline__ float rowmax(const f32x16&p0,const f32x16&p1){
  float a=max3f(p0[0],p0[1],p1[0]),b=max3f(p0[2],p0[3],p1[1]);a=max3f(a,p1[2],p1[3]);
  #pragma unroll
  for(int r=4;r<16;r+=4){a=max3f(a,p0[r],p0[r+1]);b=max3f(b,p0[r+2],p0[r+3]);a=max3f(a,p1[r],p1[r+1]);b=max3f(b,p1[r+2],p1[r+3]);}
  const float m=max2f(a,b);
  auto rr=__builtin_amdgcn_permlane32_swap(__float_as_uint(m),__float_as_uint(m),false,false);
  return max2f(__uint_as_float(rr[0]),__uint_as_float(rr[1]));
}
__device__ __forceinline__ void pv(f32x16*o,int vb,bf16x8 pa0,bf16x8 pa1,bf16x8 pa2,bf16x8 pa3){
  #pragma unroll
  for(int d0=0;d0<2;++d0){s16x4 lo[4],hi[4];
    #pragma unroll
    for(int ks=0;ks<4;++ks){
      asm volatile("ds_read_b64_tr_b16 %0,%1 offset:%c2":"=&v"(lo[ks]):"v"(vb),"i"(d0*4096+ks*1024):"memory");
      asm volatile("ds_read_b64_tr_b16 %0,%1 offset:%c2":"=&v"(hi[ks]):"v"(vb),"i"(d0*4096+ks*1024+512):"memory");}
    asm volatile("s_waitcnt lgkmcnt(0)":::"memory");SBAR();
    #define PK(k) (bf16x8){lo[k][0],lo[k][1],lo[k][2],lo[k][3],hi[k][0],hi[k][1],hi[k][2],hi[k][3]}
    o[d0]=__builtin_amdgcn_mfma_f32_32x32x16_bf16(pa0,PK(0),o[d0],0,0,0);
    o[d0]=__builtin_amdgcn_mfma_f32_32x32x16_bf16(pa1,PK(1),o[d0],0,0,0);
    o[d0]=__builtin_amdgcn_mfma_f32_32x32x16_bf16(pa2,PK(2),o[d0],0,0,0);
    o[d0]=__builtin_amdgcn_mfma_f32_32x32x16_bf16(pa3,PK(3),o[d0],0,0,0);
    #undef PK
  }
}

#ifndef ATTN_STORE16
#define ATTN_STORE16(p,v) (*(u32x4*)(p)=(v))
#endif
template<int THRL> __device__ __forceinline__ void attn_unit(int b,int hq,int hv,int qb,const bf16*Q,const bf16*__restrict__ K,const bf16*__restrict__ V,bf16*O,char*shm,int wave_in){
  int tid_=mk_tid(wave_in); asm volatile("":"+v"(tid_)); const int tid=tid_,lane=tid&63,r32=lane&31,hi=lane>>5; const int wid=wave_in;
  const long rowbase=(long)b*SEQ; const int q0=qb*QB;
  const bf16*Qw=Q+(rowbase+q0+wid*QBLK)*DM+hq*D;
  const bf16*Kh=K+rowbase*DM+hq*D,*Vh=V+rowbase*DM+hv*D;
  const unsigned lds0=(unsigned)(uintptr_t)shm;
  float*wsf=(float*)(shm+LDS_WS)+wid*64;
  const bf16*ksrc=Kh+(long)lane*DM+wid*8;
  const bf16*vsrc=Vh+(long)(16*(wid&3)+(lane>>2))*DM+(wid>>2)*32+(lane&3)*8;
  const unsigned kdst=lds0+LDS_K+wid*1024, vdst=lds0+LDS_V+wid*1024;
  #define DMA_K(t,slot) glds16(ksrc+(long)(t)*KVBLK*DM,(unsigned)__builtin_amdgcn_readfirstlane(kdst+(slot)))
  #define DMA_V(t,slot) glds16(vsrc+(long)(t)*KVBLK*DM,(unsigned)__builtin_amdgcn_readfirstlane(vdst+(slot)))
  const int vb0=(int)(lds0+LDS_V)+((lane>>4)&1)*32+(lane&3)*8+(4*hi+((lane&15)>>2))*64;
  const char*Kbase=shm+LDS_K; bf16x8 kf[8];
  const lds_cptr shm3=(lds_cptr)shm; const lds_cptr kp0=shm3+LDS_K+hi*1024+r32*16; const lds_cptr vp0=shm3+LDS_V+((lane>>4)&1)*32+(lane&3)*8+(4*hi+((lane&15)>>2))*64;
  const int NT=(q0+QB)/KVBLK;
  DMA_K(0,0);DMA_V(0,0);DMA_K(1,SLOTB);
  bf16x8 qr[4];
  #pragma unroll
  for(int d0=0;d0<4;++d0)qr[d0]=*reinterpret_cast<const bf16x8*>(&Qw[(long)r32*DM+d0*16+hi*8]);
  float zz_=0.f; asm volatile("":"+v"(zz_)); float mhat=0.f,l_reg=0.f;f32x16 o[2],negm;
  #pragma unroll
  for(int r=0;r<16;++r){o[0][r]=zz_;o[1][r]=zz_;negm[r]=zz_;}
  asm volatile("":"+v"(negm));
  const int qrel=wid*QBLK+r32;
  #define CMASK(P0,P1,t) do{int jb_=(t)-(NT-4); if(jb_>=0)cmask(P0,P1,jb_,qrel,hi);}while(0)
  bool resc=false;
  #define START(P0,P1) do{ const float rm=rowmax(P0,P1); resc=false; \
    { const float dl=rm; mhat=fadd_s(mhat,dl); \
      _Pragma("unroll") for(int r=0;r<16;++r){P0[r]=fsub_s(P0[r],dl);P1[r]=fsub_s(P1[r],dl);} \
      _Pragma("unroll") for(int r=0;r<16;++r)negm[r]=-mhat; asm volatile("":"+v"(negm)); } \
    _Pragma("unroll") for(int r=0;r<16;++r)P0[r]=__builtin_amdgcn_exp2f(P0[r]); }while(0)
  #define RESC() do{ if(resc){ asm volatile("s_waitcnt lgkmcnt(0)":::"memory"); \
      _Pragma("unroll") for(int d_=0;d_<2;++d_) _Pragma("unroll") for(int r=0;r<16;++r)o[d_][r]*=wsf[crow(r,hi)]; } }while(0)
  f32x16 pA0,pA1,pB0,pB1;
  int sl_prev=0,sl_cur=0,sl_next=SLOTB;
  #define ROT() do{sl_prev=sl_cur;sl_cur=sl_next;sl_next=(sl_next==(NSLOT-1)*SLOTB)?0:sl_next+SLOTB;}while(0)
  DMA_K(2,2*SLOTB);
  WAIT_BAR(3);
  qkt(pA0,pA1,Kbase,qr,negm,r32,hi);asm volatile("s_nop 15\n\ts_nop 7":"+v"(pA0),"+v"(pA1));CMASK(pA0,pA1,0);
  START(pA0,pA1);
  _Pragma("unroll") for(int r=0;r<16;++r)pA1[r]=__builtin_amdgcn_exp2f(pA1[r]);
  WAIT_BAR(0);
  DMA_K(3,0);DMA_V(1,SLOTB);
  ROT();
  kload8(kf,kp0+sl_cur);
  WAIT_BAR(2);
  s16x4 vlo[8],vhi[8]; u32x4 pw0,pw1,pw2,pw3;
  #define PKW(P,B) cvtpk_s(P[B],P[B+1])
  #define PAF(k) __builtin_bit_cast(bf16x8,pw##k)
  #define VFR(i) (bf16x8){vlo[i][0],vlo[i][1],vlo[i][2],vlo[i][3],vhi[i][0],vhi[i][1],vhi[i][2],vhi[i][3]}
  #define PIN(x) asm volatile("":"+v"(x))
  #define MX3(a,b,c) __builtin_fmaxf(__builtin_fmaxf((a),(b)),(c))
  #define GAPA(MF,A0,A1,A2,A3,W0,W1,PW) do{ MF; sacc+=A0; sacc+=A1; sacc+=A2; sacc+=A3; PIN(sacc); W0; W1; PIN(PW); SBAR(); }while(0)
  #define EX(v) __builtin_amdgcn_exp2f(v)
  #define GAPB(MF,X,B) do{ MF; X[B]=EX(X[B]); X[B+1]=EX(X[B+1]); X[B+2]=EX(X[B+2]); X[B+3]=EX(X[B+3]); PIN(X); SBAR(); }while(0)
  #define VRD(i) do{ vlo[i]=vtr(vp_+(((i)>>2)*4096+((i)&3)*1024)); vhi[i]=vtr(vp_+(((i)>>2)*4096+((i)&3)*1024+512)); }while(0)
  #define KRD(G,j) do{ if(G){ kload2(kf,kp0+sl_next,j); SBAR(); } }while(0)
  #define STEP(C0,C1,P0,P1,t,GK,GV,GL) do{ SBAR(); \
    const lds_cptr vp_=vp0+sl_prev; \
    VRD(0); SBAR(); float sacc=(P0[0]+P0[1]); \
    GAPA(C0=__builtin_amdgcn_mfma_f32_32x32x16_bf16(kf[0],qr[0],negm,0,0,0), P0[2],P0[3],P0[4],P0[5],     pw0[0]=PKW(P0,0), pw0[1]=PKW(P0,2), pw0); \
    VRD(4); SBAR(); GAPA(C1=__builtin_amdgcn_mfma_f32_32x32x16_bf16(kf[1],qr[0],negm,0,0,0), P0[6],P0[7],P0[8],P0[9],     pw0[2]=PKW(P0,4), pw0[3]=PKW(P0,6), pw0); \
    VRD(1); SBAR(); GAPA(C0=__builtin_amdgcn_mfma_f32_32x32x16_bf16(kf[2],qr[1],C0,0,0,0),   P0[10],P0[11],P0[12],P0[13], pw1[0]=PKW(P0,8), pw1[1]=PKW(P0,10), pw1); \
    VRD(5); SBAR(); GAPA(C1=__builtin_amdgcn_mfma_f32_32x32x16_bf16(kf[3],qr[1],C1,0,0,0),   P0[14],P0[15],P1[0],P1[1],   pw1[2]=PKW(P0,12),pw1[3]=PKW(P0,14), pw1); \
    VRD(2); SBAR(); GAPA(C0=__builtin_amdgcn_mfma_f32_32x32x16_bf16(kf[4],qr[2],C0,0,0,0),   P1[2],P1[3],P1[4],P1[5],     pw2[0]=PKW(P1,0), pw2[1]=PKW(P1,2), pw2); \
    VRD(6); SBAR(); GAPA(C1=__builtin_amdgcn_mfma_f32_32x32x16_bf16(kf[5],qr[2],C1,0,0,0),   P1[6],P1[7],P1[8],P1[9],     pw2[2]=PKW(P1,4), pw2[3]=PKW(P1,6), pw2); \
    VRD(3); SBAR(); GAPA(C0=__builtin_amdgcn_mfma_f32_32x32x16_bf16(kf[6],qr[3],C0,0,0,0),   P1[10],P1[11],P1[12],P1[13], pw3[0]=PKW(P1,8), pw3[1]=PKW(P1,10), pw3); \
    VRD(7); SBAR(); GAPA(C1=__builtin_amdgcn_mfma_f32_32x32x16_bf16(kf[7],qr[3],C1,0,0,0),   P1[14],P1[15],0.f,0.f,       pw3[2]=PKW(P1,12),pw3[3]=PKW(P1,14), pw3); \
    l_reg+=sacc; \
    if(GK){DMA_K((t)+3,sl_cur);} if(GV){DMA_V((t)+1,sl_next);} \
    CMASK(C0,C1,t); \
    { float a=MX3(C0[0],C0[1],C1[0]),b=MX3(C0[2],C0[3],C1[1]); a=MX3(a,C1[2],C1[3]); \
      _Pragma("unroll") for(int r=4;r<16;r+=4){a=MX3(a,C0[r],C0[r+1]);b=MX3(b,C0[r+2],C0[r+3]);a=MX3(a,C1[r],C1[r+1]);b=MX3(b,C1[r+2],C1[r+3]);} \
      float rm=__builtin_fmaxf(a,b); { auto rr=__builtin_amdgcn_permlane32_swap(__float_as_uint(rm),__float_as_uint(rm),false,false); rm=__builtin_fmaxf(__uint_as_float(rr[0]),__uint_as_float(rr[1])); } \
      resc=false; \
      if(__builtin_expect(__any(rm>(float)THRL),0)){ const float dl=__builtin_fmaxf(rm,0.f); mhat+=dl; \
        _Pragma("unroll") for(int r=0;r<16;++r){C0[r]-=dl;C1[r]-=dl;} \
        _Pragma("unroll") for(int r=0;r<16;++r)negm[r]=-mhat; asm volatile("":"+v"(negm)); \
        const float f=__builtin_amdgcn_exp2f(-dl); l_reg*=f; if(hi==0)wsf[r32]=f; resc=true; } } \
    SBAR(); \
    GAPB(o[0]=__builtin_amdgcn_mfma_f32_32x32x16_bf16(PAF(0),VFR(0),o[0],0,0,0), C0,0); \
    GAPB(o[1]=__builtin_amdgcn_mfma_f32_32x32x16_bf16(PAF(0),VFR(4),o[1],0,0,0), C0,4); \
    KRD(GL,0); GAPB(o[0]=__builtin_amdgcn_mfma_f32_32x32x16_bf16(PAF(1),VFR(1),o[0],0,0,0), C0,8); \
    KRD(GL,1); GAPB(o[1]=__builtin_amdgcn_mfma_f32_32x32x16_bf16(PAF(1),VFR(5),o[1],0,0,0), C0,12); \
    KRD(GL,2); GAPB(o[0]=__builtin_amdgcn_mfma_f32_32x32x16_bf16(PAF(2),VFR(2),o[0],0,0,0), C1,0); \
    KRD(GL,3); GAPB(o[1]=__builtin_amdgcn_mfma_f32_32x32x16_bf16(PAF(2),VFR(6),o[1],0,0,0), C1,4); \
    GAPB(o[0]=__builtin_amdgcn_mfma_f32_32x32x16_bf16(PAF(3),VFR(3),o[0],0,0,0), C1,8); \
    GAPB(o[1]=__builtin_amdgcn_mfma_f32_32x32x16_bf16(PAF(3),VFR(7),o[1],0,0,0), C1,12); \
    }while(0)
  int t=1;
  #undef CMASK
  #define CMASK(P0,P1,t) do{}while(0)
  for(;t+5<NT;t+=2){
    STEP(pB0,pB1,pA0,pA1,t,true,true,true);     WAIT_BAR(2); RESC(); ROT();
    STEP(pA0,pA1,pB0,pB1,t+1,true,true,true);   WAIT_BAR(2); RESC(); ROT();
  }
  #undef CMASK
  #define CMASK(P0,P1,t) do{int jb_=(t)-(NT-4); if(jb_>=0)cmask(P0,P1,jb_,qrel,hi);}while(0)
  #define ENDW(tt) do{ if((tt)+3<NT){WAIT_BAR(2);} else if((tt)+2<NT){WAIT_BAR(1);} else {WAIT_BAR(0);} }while(0)
  for(;t+1<NT;t+=2){
    STEP(pB0,pB1,pA0,pA1,t,(t+3<NT),(t+1<NT),(t+1<NT));       ENDW(t);   RESC(); ROT();
    STEP(pA0,pA1,pB0,pB1,t+1,(t+4<NT),(t+2<NT),(t+2<NT));     ENDW(t+1); RESC(); ROT();
  }
  STEP(pB0,pB1,pA0,pA1,NT-1,false,false,false); RESC();
  { float sacc=pB0[0]+pB0[1]; _Pragma("unroll") for(int r=2;r<16;++r)sacc+=pB0[r]; _Pragma("unroll") for(int r=0;r<16;++r)sacc+=pB1[r]; l_reg+=sacc;
    pw0=(u32x4){PKW(pB0,0),PKW(pB0,2),PKW(pB0,4),PKW(pB0,6)};pw1=(u32x4){PKW(pB0,8),PKW(pB0,10),PKW(pB0,12),PKW(pB0,14)};pw2=(u32x4){PKW(pB1,0),PKW(pB1,2),PKW(pB1,4),PKW(pB1,6)};pw3=(u32x4){PKW(pB1,8),PKW(pB1,10),PKW(pB1,12),PKW(pB1,14)};
    SBAR(); pv(o,vb0+sl_cur,PAF(0),PAF(1),PAF(2),PAF(3)); }
  #undef PKW
  #undef PAF
  #undef VFR
  #undef PIN
  #undef MX3
  #undef GAPA
  #undef GAPB
  #undef EX
  #undef VRD
  #undef KRD
  #undef STEP
  #undef ENDW
  {auto rr=__builtin_amdgcn_permlane32_swap(__float_as_uint(l_reg),__float_as_uint(l_reg),false,false);l_reg=__uint_as_float(rr[0])+__uint_as_float(rr[1]);}
  if(hi==0)wsf[32+r32]=l_reg;asm volatile("s_waitcnt lgkmcnt(0)":::"memory");
  float rli[16];
  #pragma unroll
  for(int r=0;r<16;++r)rli[r]=__builtin_amdgcn_rcpf(wsf[32+crow(r,hi)]);
  bf16*Ow=O+(rowbase+q0+wid*QBLK)*DM+hv*D;
  { bf16*stg=(bf16*)(shm+LDS_OST)+wid*2048;
    #pragma unroll
    for(int r=0;r<16;++r){const int orow=crow(r,hi);
      #pragma unroll
      for(int d0=0;d0<2;++d0)stg[orow*64+d0*32+r32]=__float2bfloat16(o[d0][r]*rli[r]);}
    asm volatile("s_waitcnt lgkmcnt(0)":::"memory");
    #pragma unroll
    for(int i=0;i<4;++i){const int row=i*8+(lane>>3),ch=lane&7; const u32x4 v=*(const u32x4*)(stg+row*64+ch*8); ATTN_STORE16(Ow+(long)row*DM+ch*8,v);} }
  asm volatile("s_waitcnt lgkmcnt(0)\n\ts_barrier":::"memory");
  #undef DMA_K
  #undef DMA_V
  #undef CMASK
  #undef START
  #undef RESC
  #undef ROT
}
constexpr int ATTN_LDS_BYTES=LDS_BYTES;
#undef SBAR
#undef WAIT_BAR
}
namespace attn128 {
using namespace attn_body;
#define SBAR() __builtin_amdgcn_sched_barrier(0)
#define WAIT_BAR(N) asm volatile("s_waitcnt vmcnt(" #N ") lgkmcnt(0)\n\ts_barrier":::"memory")
constexpr int L_K=0, L_V=3*8192, L_WS=L_V+3*16384, L_OST=0, L_BYTES=L_WS+NW*64*4;
__device__ __forceinline__ void pv4(f32x16*o,int vb,bf16x8 pa0,bf16x8 pa1,bf16x8 pa2,bf16x8 pa3){
  #pragma unroll
  for(int d0=0;d0<4;++d0){s16x4 lo[4],hi[4];
    #pragma unroll
    for(int ks=0;ks<4;++ks){
      asm volatile("ds_read_b64_tr_b16 %0,%1 offset:%c2":"=&v"(lo[ks]):"v"(vb),"i"(d0*4096+ks*1024):"memory");
      asm volatile("ds_read_b64_tr_b16 %0,%1 offset:%c2":"=&v"(hi[ks]):"v"(vb),"i"(d0*4096+ks*1024+512):"memory");}
    asm volatile("s_waitcnt lgkmcnt(0)":::"memory");SBAR();
    #define PK(k) (bf16x8){lo[k][0],lo[k][1],lo[k][2],lo[k][3],hi[k][0],hi[k][1],hi[k][2],hi[k][3]}
    o[d0]=__builtin_amdgcn_mfma_f32_32x32x16_bf16(pa0,PK(0),o[d0],0,0,0);
    o[d0]=__builtin_amdgcn_mfma_f32_32x32x16_bf16(pa1,PK(1),o[d0],0,0,0);
    o[d0]=__builtin_amdgcn_mfma_f32_32x32x16_bf16(pa2,PK(2),o[d0],0,0,0);
    o[d0]=__builtin_amdgcn_mfma_f32_32x32x16_bf16(pa3,PK(3),o[d0],0,0,0);
    #undef PK
  }
}
template<int THRL> __device__ __forceinline__ void attn_unit128(int b,int hq,int hv,int qb,const bf16*Q,const bf16*__restrict__ K,const bf16*__restrict__ V,bf16*O,char*shm,int wave_in,int cmode,unsigned*flg,bf16*MIXo,float lam,const float*subg,unsigned slow){
  int tid_=mk_tid(wave_in); asm volatile("":"+v"(tid_)); const int tid=tid_,lane=tid&63,r32=lane&31,hi=lane>>5; const int wid=wave_in;
  if(wid>=4)__builtin_amdgcn_s_setprio(1);
  const long rowbase=(long)b*SEQ; const int q0=qb*QB;
  const bf16*Qw=Q+(rowbase+q0+wid*QBLK)*DM+hq*D;
  const bf16*Kh=K+rowbase*DM+hq*D,*Vh=V+rowbase*DM+hv*128;
  const unsigned lds0=(unsigned)(uintptr_t)shm;
  float*wsf=(float*)(shm+L_WS)+wid*64;
  const bf16*ksrc=Kh+(long)lane*DM+wid*8;
  const bf16*vsrc=Vh+(long)(16*(wid&3)+(lane>>2))*DM+(wid>>2)*32+(lane&3)*8;
  const unsigned kdst=lds0+L_K+wid*1024, vdst=lds0+L_V+wid*1024;
  #define DMA_K(t,slot) glds16(ksrc+(long)(t)*KVBLK*DM,(unsigned)__builtin_amdgcn_readfirstlane(kdst+(slot)))
  #define DMA_V(t,slot) do{ glds16(vsrc+(long)(t)*KVBLK*DM,(unsigned)__builtin_amdgcn_readfirstlane(vdst+2*(slot))); glds16(vsrc+(long)(t)*KVBLK*DM+64,(unsigned)__builtin_amdgcn_readfirstlane(vdst+2*(slot)+8192)); }while(0)
  const int vb0=(int)(lds0+L_V)+((lane>>4)&1)*32+(lane&3)*8+(4*hi+((lane&15)>>2))*64;
  const char*Kbase=shm+L_K; bf16x8 kf[8];
  const lds_cptr shm3=(lds_cptr)shm; const lds_cptr kp0=shm3+L_K+hi*1024+r32*16; const lds_cptr vp0=shm3+L_V+((lane>>4)&1)*32+(lane&3)*8+(4*hi+((lane&15)>>2))*64;
  const int NT=(q0+QB)/KVBLK;
  DMA_K(0,0);DMA_V(0,0);DMA_K(1,SLOTB);
  bf16x8 qr[4];
  #pragma unroll
  for(int d0=0;d0<4;++d0)qr[d0]=*reinterpret_cast<const bf16x8*>(&Qw[(long)r32*DM+d0*16+hi*8]);
  float zz_=0.f; asm volatile("":"+v"(zz_)); float mhat=0.f,l_reg=0.f;f32x16 o[4],negm;
  #pragma unroll
  for(int r=0;r<16;++r){o[0][r]=zz_;o[1][r]=zz_;o[2][r]=zz_;o[3][r]=zz_;negm[r]=zz_;}
  asm volatile("":"+v"(negm));
  const int qrel=wid*QBLK+r32;
  #define CMASK(P0,P1,t) do{int jb_=(t)-(NT-4); if(jb_>=0)cmask(P0,P1,jb_,qrel,hi);}while(0)
  bool resc=false;
  #define START(P0,P1) do{ const float rm=rowmax(P0,P1); resc=false; \
    { const float dl=rm; mhat=fadd_s(mhat,dl); \
      _Pragma("unroll") for(int r=0;r<16;++r){P0[r]=fsub_s(P0[r],dl);P1[r]=fsub_s(P1[r],dl);} \
      _Pragma("unroll") for(int r=0;r<16;++r)negm[r]=-mhat; asm volatile("":"+v"(negm)); } \
    _Pragma("unroll") for(int r=0;r<16;++r)P0[r]=__builtin_amdgcn_exp2f(P0[r]); }while(0)
  #define RESC() do{ if(resc){ asm volatile("s_waitcnt lgkmcnt(0)":::"memory"); \
      _Pragma("unroll") for(int d_=0;d_<4;++d_) _Pragma("unroll") for(int r=0;r<16;++r)o[d_][r]*=wsf[crow(r,hi)]; } }while(0)
  f32x16 pA0,pA1,pB0,pB1;
  int sl_prev=0,sl_cur=0,sl_next=SLOTB;
  #define ROT() do{sl_prev=sl_cur;sl_cur=sl_next;sl_next=(sl_next==(NSLOT-1)*SLOTB)?0:sl_next+SLOTB;}while(0)
  DMA_K(2,2*SLOTB);
  WAIT_BAR(4);
  qkt(pA0,pA1,Kbase,qr,negm,r32,hi);asm volatile("s_nop 15\n\ts_nop 7":"+v"(pA0),"+v"(pA1));CMASK(pA0,pA1,0);
  START(pA0,pA1);
  _Pragma("unroll") for(int r=0;r<16;++r)pA1[r]=__builtin_amdgcn_exp2f(pA1[r]);
  WAIT_BAR(0);
  DMA_K(3,0);DMA_V(1,SLOTB);
  ROT();
  kload8(kf,kp0+sl_cur);
  WAIT_BAR(3);
  s16x4 vlo[8],vhi[8]; u32x4 pw0,pw1,pw2,pw3;
  #define PKW(P,B) cvtpk_s(P[B],P[B+1])
  #define PAF(k) __builtin_bit_cast(bf16x8,pw##k)
  #define VFR(i) (bf16x8){vlo[i][0],vlo[i][1],vlo[i][2],vlo[i][3],vhi[i][0],vhi[i][1],vhi[i][2],vhi[i][3]}
  #define PIN(x) asm volatile("":"+v"(x))
  #define MX3(a,b,c) __builtin_fmaxf(__builtin_fmaxf((a),(b)),(c))
  #define GAPA(MF,A0,A1,A2,A3,W0,W1,PW) do{ MF; sacc+=A0; sacc+=A1; sacc+=A2; sacc+=A3; PIN(sacc); W0; W1; PIN(PW); SBAR(); }while(0)
  #define EX(v) __builtin_amdgcn_exp2f(v)
  #define GAPB(MF,X,B) do{ MF; X[B]=EX(X[B]); X[B+1]=EX(X[B+1]); X[B+2]=EX(X[B+2]); X[B+3]=EX(X[B+3]); PIN(X); SBAR(); }while(0)
  #define VRD(i) do{ vlo[i]=vtr(vp_+(((i)>>2)*4096+((i)&3)*1024)); vhi[i]=vtr(vp_+(((i)>>2)*4096+((i)&3)*1024+512)); }while(0)
  #define VRD2(i) do{ vlo[i]=vtr(vp_+((((i)+8)>>2)*4096+((i)&3)*1024)); vhi[i]=vtr(vp_+((((i)+8)>>2)*4096+((i)&3)*1024+512)); }while(0)
  #define GAPB2(MF,X,B) do{ MF; X[B]=EX(X[B]); X[B+1]=EX(X[B+1]); PIN(X); SBAR(); }while(0)
  #define KRD(G,j) do{ if(G){ kload2(kf,kp0+sl_next,j); SBAR(); } }while(0)
  #define STEP(C0,C1,P0,P1,t,GK,GV,GL) do{ SBAR(); \
    const lds_cptr vp_=vp0+2*sl_prev; \
    VRD(0); SBAR(); float sacc=(P0[0]+P0[1]); \
    GAPA(C0=__builtin_amdgcn_mfma_f32_32x32x16_bf16(kf[0],qr[0],negm,0,0,0), P0[2],P0[3],P0[4],P0[5],     pw0[0]=PKW(P0,0), pw0[1]=PKW(P0,2), pw0); \
    VRD(4); SBAR(); GAPA(C1=__builtin_amdgcn_mfma_f32_32x32x16_bf16(kf[1],qr[0],negm,0,0,0), P0[6],P0[7],P0[8],P0[9],     pw0[2]=PKW(P0,4), pw0[3]=PKW(P0,6), pw0); \
    VRD(1); SBAR(); GAPA(C0=__builtin_amdgcn_mfma_f32_32x32x16_bf16(kf[2],qr[1],C0,0,0,0),   P0[10],P0[11],P0[12],P0[13], pw1[0]=PKW(P0,8), pw1[1]=PKW(P0,10), pw1); \
    VRD(5); SBAR(); GAPA(C1=__builtin_amdgcn_mfma_f32_32x32x16_bf16(kf[3],qr[1],C1,0,0,0),   P0[14],P0[15],P1[0],P1[1],   pw1[2]=PKW(P0,12),pw1[3]=PKW(P0,14), pw1); \
    VRD(2); SBAR(); GAPA(C0=__builtin_amdgcn_mfma_f32_32x32x16_bf16(kf[4],qr[2],C0,0,0,0),   P1[2],P1[3],P1[4],P1[5],     pw2[0]=PKW(P1,0), pw2[1]=PKW(P1,2), pw2); \
    VRD(6); SBAR(); GAPA(C1=__builtin_amdgcn_mfma_f32_32x32x16_bf16(kf[5],qr[2],C1,0,0,0),   P1[6],P1[7],P1[8],P1[9],     pw2[2]=PKW(P1,4), pw2[3]=PKW(P1,6), pw2); \
    VRD(3); SBAR(); GAPA(C0=__builtin_amdgcn_mfma_f32_32x32x16_bf16(kf[6],qr[3],C0,0,0,0),   P1[10],P1[11],P1[12],P1[13], pw3[0]=PKW(P1,8), pw3[1]=PKW(P1,10), pw3); \
    VRD(7); SBAR(); GAPA(C1=__builtin_amdgcn_mfma_f32_32x32x16_bf16(kf[7],qr[3],C1,0,0,0),   P1[14],P1[15],0.f,0.f,       pw3[2]=PKW(P1,12),pw3[3]=PKW(P1,14), pw3); \
    l_reg+=sacc; \
    if(GK){DMA_K((t)+3,sl_cur);} if(GV){DMA_V((t)+1,sl_next);} \
    CMASK(C0,C1,t); \
    { float a=MX3(C0[0],C0[1],C1[0]),b=MX3(C0[2],C0[3],C1[1]); a=MX3(a,C1[2],C1[3]); \
      _Pragma("unroll") for(int r=4;r<16;r+=4){a=MX3(a,C0[r],C0[r+1]);b=MX3(b,C0[r+2],C0[r+3]);a=MX3(a,C1[r],C1[r+1]);b=MX3(b,C1[r+2],C1[r+3]);} \
      float rm=__builtin_fmaxf(a,b); { auto rr=__builtin_amdgcn_permlane32_swap(__float_as_uint(rm),__float_as_uint(rm),false,false); rm=__builtin_fmaxf(__uint_as_float(rr[0]),__uint_as_float(rr[1])); } \
      resc=false; \
      if(__builtin_expect(__any(rm>(float)THRL),0)){ const float dl=__builtin_fmaxf(rm,0.f); mhat+=dl; \
        _Pragma("unroll") for(int r=0;r<16;++r){C0[r]-=dl;C1[r]-=dl;} \
        _Pragma("unroll") for(int r=0;r<16;++r)negm[r]=-mhat; asm volatile("":"+v"(negm)); \
        const float f=__builtin_amdgcn_exp2f(-dl); l_reg*=f; if(hi==0)wsf[r32]=f; resc=true; } } \
    SBAR(); \
    GAPB2(o[0]=__builtin_amdgcn_mfma_f32_32x32x16_bf16(PAF(0),VFR(0),o[0],0,0,0), C0,0);  VRD2(0); SBAR(); \
    GAPB2(o[1]=__builtin_amdgcn_mfma_f32_32x32x16_bf16(PAF(0),VFR(4),o[1],0,0,0), C0,2);  VRD2(4); SBAR(); \
    GAPB2(o[0]=__builtin_amdgcn_mfma_f32_32x32x16_bf16(PAF(1),VFR(1),o[0],0,0,0), C0,4);  VRD2(1); SBAR(); \
    GAPB2(o[1]=__builtin_amdgcn_mfma_f32_32x32x16_bf16(PAF(1),VFR(5),o[1],0,0,0), C0,6);  VRD2(5); SBAR(); \
    GAPB2(o[0]=__builtin_amdgcn_mfma_f32_32x32x16_bf16(PAF(2),VFR(2),o[0],0,0,0), C0,8);  VRD2(2); SBAR(); \
    GAPB2(o[1]=__builtin_amdgcn_mfma_f32_32x32x16_bf16(PAF(2),VFR(6),o[1],0,0,0), C0,10); VRD2(6); SBAR(); \
    GAPB2(o[0]=__builtin_amdgcn_mfma_f32_32x32x16_bf16(PAF(3),VFR(3),o[0],0,0,0), C0,12); VRD2(3); SBAR(); \
    GAPB2(o[1]=__builtin_amdgcn_mfma_f32_32x32x16_bf16(PAF(3),VFR(7),o[1],0,0,0), C0,14); VRD2(7); SBAR(); \
    GAPB2(o[2]=__builtin_amdgcn_mfma_f32_32x32x16_bf16(PAF(0),VFR(0),o[2],0,0,0), C1,0); \
    GAPB2(o[3]=__builtin_amdgcn_mfma_f32_32x32x16_bf16(PAF(0),VFR(4),o[3],0,0,0), C1,2); \
    KRD(GL,0); GAPB2(o[2]=__builtin_amdgcn_mfma_f32_32x32x16_bf16(PAF(1),VFR(1),o[2],0,0,0), C1,4); \
    KRD(GL,1); GAPB2(o[3]=__builtin_amdgcn_mfma_f32_32x32x16_bf16(PAF(1),VFR(5),o[3],0,0,0), C1,6); \
    KRD(GL,2); GAPB2(o[2]=__builtin_amdgcn_mfma_f32_32x32x16_bf16(PAF(2),VFR(2),o[2],0,0,0), C1,8); \
    KRD(GL,3); GAPB2(o[3]=__builtin_amdgcn_mfma_f32_32x32x16_bf16(PAF(2),VFR(6),o[3],0,0,0), C1,10); \
    GAPB2(o[2]=__builtin_amdgcn_mfma_f32_32x32x16_bf16(PAF(3),VFR(3),o[2],0,0,0), C1,12); \
    GAPB2(o[3]=__builtin_amdgcn_mfma_f32_32x32x16_bf16(PAF(3),VFR(7),o[3],0,0,0), C1,14); \
    }while(0)
  int t=1;
  #undef CMASK
  #define CMASK(P0,P1,t) do{}while(0)
  for(;t+5<NT;t+=2){
    STEP(pB0,pB1,pA0,pA1,t,true,true,true);     WAIT_BAR(3); RESC(); ROT();
    STEP(pA0,pA1,pB0,pB1,t+1,true,true,true);   WAIT_BAR(3); RESC(); ROT();
  }
  #undef CMASK
  #define CMASK(P0,P1,t) do{int jb_=(t)-(NT-4); if(jb_>=0)cmask(P0,P1,jb_,qrel,hi);}while(0)
  #define ENDW(tt) do{ if((tt)+3<NT){WAIT_BAR(3);} else if((tt)+2<NT){WAIT_BAR(2);} else {WAIT_BAR(0);} }while(0)
  for(;t+1<NT;t+=2){
    STEP(pB0,pB1,pA0,pA1,t,(t+3<NT),(t+1<NT),(t+1<NT));       ENDW(t);   RESC(); ROT();
    STEP(pA0,pA1,pB0,pB1,t+1,(t+4<NT),(t+2<NT),(t+2<NT));     ENDW(t+1); RESC(); ROT();
  }
  STEP(pB0,pB1,pA0,pA1,NT-1,false,false,false); RESC();
  { float sacc=pB0[0]+pB0[1]; _Pragma("unroll") for(int r=2;r<16;++r)sacc+=pB0[r]; _Pragma("unroll") for(int r=0;r<16;++r)sacc+=pB1[r]; l_reg+=sacc;
    pw0=(u32x4){PKW(pB0,0),PKW(pB0,2),PKW(pB0,4),PKW(pB0,6)};pw1=(u32x4){PKW(pB0,8),PKW(pB0,10),PKW(pB0,12),PKW(pB0,14)};pw2=(u32x4){PKW(pB1,0),PKW(pB1,2),PKW(pB1,4),PKW(pB1,6)};pw3=(u32x4){PKW(pB1,8),PKW(pB1,10),PKW(pB1,12),PKW(pB1,14)};
    SBAR(); pv4(o,vb0+2*sl_cur,PAF(0),PAF(1),PAF(2),PAF(3)); }
  #undef PKW
  #undef PAF
  #undef VFR
  #undef PIN
  #undef MX3
  #undef GAPA
  #undef GAPB
  #undef GAPB2
  #undef VRD2
  #undef EX
  #undef VRD
  #undef KRD
  #undef STEP
  #undef ENDW
  {auto rr=__builtin_amdgcn_permlane32_swap(__float_as_uint(l_reg),__float_as_uint(l_reg),false,false);l_reg=__uint_as_float(rr[0])+__uint_as_float(rr[1]);}
  if(hi==0)wsf[32+r32]=l_reg;asm volatile("s_waitcnt lgkmcnt(0)":::"memory");
  float rli[16];
  #pragma unroll
  for(int r=0;r<16;++r)rli[r]=__builtin_amdgcn_rcpf(wsf[32+crow(r,hi)]);
  bf16*Ow=O+(rowbase+q0+wid*QBLK)*DM+hv*128;
  asm volatile("s_waitcnt lgkmcnt(0)\n\ts_barrier":::"memory");
  { bf16*stg=(bf16*)(shm+L_OST)+wid*4096;
    #pragma unroll
    for(int r=0;r<16;++r){const int orow=crow(r,hi);
      #pragma unroll
      for(int d0=0;d0<4;++d0)stg[orow*128+d0*32+r32]=__float2bfloat16(o[d0][r]*rli[r]);}
    asm volatile("s_waitcnt lgkmcnt(0)":::"memory");
    if(cmode!=1){
      #pragma unroll
      for(int i=0;i<8;++i){const int row=i*4+(lane>>4),ch=lane&15; const u32x4 v=*(const u32x4*)(stg+row*128+ch*8); ATTN_STORE16(Ow+(long)row*DM+ch*8,v);}
    } else {
      while(__hip_atomic_load(flg,__ATOMIC_RELAXED,__HIP_MEMORY_SCOPE_AGENT)==0u)__builtin_amdgcn_s_sleep(1);
      if(slow)__builtin_amdgcn_fence(__ATOMIC_ACQUIRE,"agent");
      asm volatile("":::"memory");
      const int ch=lane&15; const float*gp=subg+ch*8; const float g0=gp[0],g1=gp[1],g2=gp[2],g3=gp[3],g4=gp[4],g5=gp[5],g6=gp[6],g7=gp[7];
      u32x4 a0[8];
      #pragma unroll
      for(int i=0;i<8;++i){const int row=i*4+(lane>>4); const bf16*ap=Ow+(long)row*DM+ch*8; asm volatile("global_load_dwordx4 %0, %1, off sc0 sc1":"=v"(a0[i]):"v"(ap):"memory");}
      asm volatile("s_waitcnt vmcnt(0)":::"memory");
      #pragma unroll
      for(int i=0;i<8;++i){const int row=i*4+(lane>>4); const u32x4 b=*(const u32x4*)(stg+row*128+ch*8); const u32x4 a=a0[i]; float d[8];
        #define LO_(w) __builtin_bit_cast(float,(w)<<16)
        #define HI_(w) __builtin_bit_cast(float,(w)&0xffff0000u)
        d[0]=LO_(a[0])-lam*LO_(b[0]); d[1]=HI_(a[0])-lam*HI_(b[0]); d[2]=LO_(a[1])-lam*LO_(b[1]); d[3]=HI_(a[1])-lam*HI_(b[1]);
        d[4]=LO_(a[2])-lam*LO_(b[2]); d[5]=HI_(a[2])-lam*HI_(b[2]); d[6]=LO_(a[3])-lam*LO_(b[3]); d[7]=HI_(a[3])-lam*HI_(b[3]);
        #undef LO_
        #undef HI_
        float ss=(d[0]*d[0]+d[1]*d[1])+(d[2]*d[2]+d[3]*d[3])+(d[4]*d[4]+d[5]*d[5])+(d[6]*d[6]+d[7]*d[7]);
        ss+=__builtin_bit_cast(float,__builtin_amdgcn_update_dpp(0,__builtin_bit_cast(int,ss),0xB1,0xF,0xF,false)); ss+=__builtin_bit_cast(float,__builtin_amdgcn_update_dpp(0,__builtin_bit_cast(int,ss),0x4E,0xF,0xF,false));
        ss+=__builtin_bit_cast(float,__builtin_amdgcn_update_dpp(0,__builtin_bit_cast(int,ss),0x124,0xF,0xF,false)); ss+=__builtin_bit_cast(float,__builtin_amdgcn_update_dpp(0,__builtin_bit_cast(int,ss),0x128,0xF,0xF,false));
        const float rs=0.8f*__builtin_amdgcn_rsqf(ss*(1.f/128.f)+1e-6f);
        u32x4 o4; o4[0]=cvtpk_s(d[0]*rs*g0,d[1]*rs*g1); o4[1]=cvtpk_s(d[2]*rs*g2,d[3]*rs*g3); o4[2]=cvtpk_s(d[4]*rs*g4,d[5]*rs*g5); o4[3]=cvtpk_s(d[6]*rs*g6,d[7]*rs*g7);
        *(u32x4*)(MIXo+((rowbase+q0+wid*QBLK+row)*2048L+1024+hv*128+ch*8))=o4; }
    } }
  asm volatile("s_waitcnt vmcnt(0) lgkmcnt(0)\n\ts_barrier":::"memory");
  if(cmode==0&&tid==0){ if(slow)__builtin_amdgcn_fence(__ATOMIC_RELEASE,"agent"); __hip_atomic_store(flg,1u,__ATOMIC_RELAXED,__HIP_MEMORY_SCOPE_AGENT); }
  __builtin_amdgcn_s_setprio(0);
  #undef DMA_K
  #undef DMA_V
  #undef CMASK
  #undef START
  #undef RESC
  #undef ROT
}
#undef SBAR
#undef WAIT_BAR
}
#define GAS __attribute__((address_space(1)))
#define LAS __attribute__((address_space(3)))
typedef unsigned short bf16;
typedef unsigned v4u __attribute__((ext_vector_type(4)));
typedef float f32x4 __attribute__((ext_vector_type(4)));
typedef short bf16x8 __attribute__((ext_vector_type(8)));
typedef GAS unsigned gu32;
typedef GAS unsigned long long gu64;
#define RLX_AGENT __ATOMIC_RELAXED, __HIP_MEMORY_SCOPE_AGENT
#define LDS_WAIT() asm volatile("s_waitcnt lgkmcnt(0)" ::: "memory")
#define VM_WAIT() asm volatile("s_waitcnt vmcnt(0)" ::: "memory")
__device__ __forceinline__ unsigned long long rt() { return __builtin_amdgcn_s_memrealtime(); }
__device__ __forceinline__ unsigned f2bf(float f) { unsigned u = __builtin_bit_cast(unsigned, f); return (u + 0x7fffu + ((u >> 16) & 1u)) >> 16; }
__device__ __forceinline__ unsigned pk2(float lo, float hi) { return f2bf(lo) | (f2bf(hi) << 16); }

#define XB_TMO      128
#define XB_XCNT(j)  (256  + 64 * (j))
#define XB_XSUB(j)  (1280 + 64 * (j))
#define XB_XGEN(j)  (2304 + 64 * (j))
#define XB_TOP      3328
#define XB_TOPGEN   3392
#define XCD_BAR_WORDS 3456
#define XB_SPIN_CAP (1u << 18)

__device__ __forceinline__ unsigned xb_ld(unsigned* p)              { return __hip_atomic_load(p, __ATOMIC_RELAXED, __HIP_MEMORY_SCOPE_AGENT); }
__device__ __forceinline__ unsigned xb_add(unsigned* p, unsigned v) { return __hip_atomic_fetch_add(p, v, __ATOMIC_RELAXED, __HIP_MEMORY_SCOPE_AGENT); }
__device__ __forceinline__ unsigned xb_xcc_id() { return (unsigned)__builtin_amdgcn_s_getreg((3 << 11) | 20) & 0xFu; }
#define XB_SPIN(cond, bar) do { unsigned _sp = 0; while (cond) { __builtin_amdgcn_s_sleep(1); \
    if ((++_sp & 255u) == 0u) { if (xb_ld(&(bar)[XB_TMO])) break; if (_sp > XB_SPIN_CAP) { atomicAdd(&(bar)[XB_TMO], 1u); break; } } } } while (0)

struct XcdBarrier {
    unsigned* bar; unsigned x;
    volatile LAS unsigned* st;
};

__device__ __forceinline__ XcdBarrier xcd_barrier_post(unsigned* bar, volatile LAS unsigned* st, int wave_in) {
    XcdBarrier b; b.bar = bar; b.x = xb_xcc_id(); b.st = st;
    if (wave_in == 0 && mk_lane() == 0) (void)xb_add(&bar[XB_XCNT(b.x)], 1u);
    return b;
}
__device__ __forceinline__ void xcd_barrier_complete(unsigned* bar, unsigned x, unsigned& nloc, unsigned& nx) {
    const unsigned G = gridDim.x * gridDim.y * gridDim.z;
    unsigned sum, cnt, mine, sp = 0u;
    for (;;) {
        sum = 0u; cnt = 0u; mine = 0u;
#pragma unroll
        for (unsigned j = 0; j < 16; ++j) { const unsigned c = xb_ld(&bar[XB_XCNT(j)]); sum += c; cnt += (c > 0u) ? 1u : 0u; mine = (j == x) ? c : mine; }
        if (sum == G) break;
        __builtin_amdgcn_s_sleep(1);
        if ((++sp & 255u) == 0u) { if (xb_ld(&bar[XB_TMO])) break; if (sp > XB_SPIN_CAP) { atomicAdd(&bar[XB_TMO], 1u); break; } }
    }
    nloc = mine > 0u ? mine : 1u; nx = cnt > 0u ? cnt : 1u;
}

__device__ __forceinline__ void xcd_barrier(const XcdBarrier& b, int wave_in) {
    asm volatile("s_waitcnt vmcnt(0)" ::: "memory");
    __syncthreads();
    if (wave_in == 0 && mk_lane() == 0) {
        unsigned* bar = b.bar;
        __builtin_amdgcn_s_waitcnt(0);
        unsigned nloc = b.st[0], nx = b.st[1];
        if (nloc == 0u) { xcd_barrier_complete(bar, b.x, nloc, nx); b.st[0] = nloc; b.st[1] = nx; }
        const unsigned old = xb_add(&bar[XB_XSUB(b.x)], 1u);
        const unsigned gen = old / nloc;
        if (old + 1u == (gen + 1u) * nloc) {
            __builtin_amdgcn_fence(__ATOMIC_RELEASE, "agent");
            asm volatile("s_waitcnt vmcnt(0)" ::: "memory");
            const unsigned og = xb_add(&bar[XB_TOP], 1u);
            const unsigned tg = og / nx;
            if (og + 1u == (tg + 1u) * nx) xb_add(&bar[XB_TOPGEN], 1u);
            else XB_SPIN(xb_ld(&bar[XB_TOPGEN]) == tg, bar);
            __builtin_amdgcn_fence(__ATOMIC_ACQUIRE, "agent");
            xb_add(&bar[XB_XGEN(b.x)], 1u);
            asm volatile("s_waitcnt vmcnt(0)" ::: "memory");
        } else {
            XB_SPIN(xb_ld(&bar[XB_XGEN(b.x)]) == gen, bar);
            __builtin_amdgcn_fence(__ATOMIC_ACQUIRE, "agent");
            asm volatile("s_waitcnt vmcnt(0)" ::: "memory");
        }
    }
    __syncthreads();
}

constexpr int NWAVES = 8;
constexpr int DMODEL = 2048, NBATCH = 2, SEQL = 4096, NTOK = NBATCH * SEQL, MEMLEN = 256, NMEM = NBATCH * MEMLEN;
constexpr int CONVW = 1024, INW = 5120, NEXP = 16384;
constexpr float C2Q = 0.125f * 1.4426950408889634f;
constexpr float CROSS_SC = 0.044194173824159216f * 1.4426950408889634f;
constexpr float LAM_INIT = 0.2f;
constexpr float USCALE = 256.f, VSCALE = 16.f;

constexpr size_t MiB = 1u << 20;
constexpr size_t WS_CTL = 0, CTL_ZERO_BYTES = 64 * 1024;
constexpr size_t WS_PART1 = 1 * MiB, WS_PART2 = 2 * MiB;
constexpr size_t WS_ABD = 3 * MiB;
constexpr size_t WS_W1T = 4 * MiB;
constexpr size_t WS_WOUTT = 24 * MiB;
constexpr size_t WS_WCQ = 32 * MiB;
constexpr size_t WS_WCKVT = 40 * MiB;
constexpr size_t WS_WCOT = 56 * MiB;
constexpr size_t WS_WPQ = 64 * MiB;
constexpr size_t WS_MN = 72 * MiB;
constexpr size_t WS_KV = 74 * MiB;
constexpr size_t WS_WKT = 78 * MiB;
constexpr size_t WS_VWT = 86 * MiB;
constexpr size_t WS_WST = 94 * MiB;
constexpr size_t WS_ACT = 104 * MiB;
constexpr size_t WS_U = 136 * MiB, WS_Q = 152 * MiB, WS_K = 168 * MiB, WS_V = 184 * MiB;
constexpr size_t WS_O0 = 200 * MiB, WS_O1 = 216 * MiB;
constexpr size_t WS_MIX = 232 * MiB;
constexpr size_t WS_P = 264 * MiB;
constexpr size_t WS_SALL = 280 * MiB;
constexpr size_t WS_UTAB = 352 * MiB, WS_VTAB = 416 * MiB;
constexpr size_t WS_END = 480 * MiB;
constexpr int CW_BAR = 4096, CW_LOC = 8192, CW_LAB = 9216, CW_FLAG = 9280, CW_OFL = 10240;

constexpr int RING_OFF = 0, RING_BYTES = 131072;
constexpr int LDSCTL_OFF = RING_BYTES, MISC_OFF = LDSCTL_OFF + 320, RSTD_OFF = LDSCTL_OFF + 1024;
constexpr int LDS_BYTES = 147456;

template <int CTRL, int RM> __device__ __forceinline__ float dpp_mov(float old, float src) {
    return __builtin_bit_cast(float, __builtin_amdgcn_update_dpp(__builtin_bit_cast(int, old), __builtin_bit_cast(int, src), CTRL, RM, 0xF, false)); }
__device__ __forceinline__ float rdlane63(float v) { return __builtin_bit_cast(float, __builtin_amdgcn_readlane(__builtin_bit_cast(int, v), 63)); }
__device__ __forceinline__ float wave_max_u(float v) {
    v = fmaxf(v, dpp_mov<0xB1, 0xF>(v, v)); v = fmaxf(v, dpp_mov<0x4E, 0xF>(v, v)); v = fmaxf(v, dpp_mov<0x141, 0xF>(v, v)); v = fmaxf(v, dpp_mov<0x140, 0xF>(v, v));
    v = fmaxf(v, dpp_mov<0x142, 0xA>(v, v)); v = fmaxf(v, dpp_mov<0x143, 0xC>(v, v)); return rdlane63(v); }
__device__ __forceinline__ float wave_sum_u(float v) {
    v += dpp_mov<0xB1, 0xF>(0.f, v); v += dpp_mov<0x4E, 0xF>(0.f, v); v += dpp_mov<0x141, 0xF>(0.f, v); v += dpp_mov<0x140, 0xF>(0.f, v);
    v += dpp_mov<0x142, 0xA>(0.f, v); v += dpp_mov<0x143, 0xC>(0.f, v); return rdlane63(v); }
__device__ __forceinline__ float wave_sum(float v) {
#pragma unroll
    for (int o = 1; o < 64; o <<= 1) v += __shfl_xor(v, o);
    return v;
}
__device__ __forceinline__ float bflo(unsigned w) { return __builtin_bit_cast(float, w << 16); }
__device__ __forceinline__ float bfhi(unsigned w) { return __builtin_bit_cast(float, w & 0xffff0000u); }

template <int NV> __device__ __forceinline__ void wave_top16(float (&a)[NV], int lane, float& outv, int& outi) {
    outv = 0.f; outi = 0;
#pragma unroll
    for (int r = 0; r < 16; ++r) {
        float m = a[0];
#pragma unroll
        for (int q = 1; q < NV; ++q) m = fmaxf(m, a[q]);
        m = wave_max_u(m);
        int idx = -1;
#pragma unroll
        for (int q = 0; q < NV; ++q) { if (idx < 0) { const unsigned long long bl = __ballot(a[q] == m); if (bl) idx = q * 64 + (int)__builtin_ctzll(bl); } }
#pragma unroll
        for (int q = 0; q < NV; ++q) if (idx == q * 64 + lane) a[q] = -INFINITY;
        if (lane == r) { outv = m; outi = idx; }
    }
}

__device__ __forceinline__ void p0_transpose_item(const float* W, int K, int N, bf16* WT, int k0, int n0, int dst_row0, LAS float* scr, int lane) {
    f32x4 ld[8];
#pragma unroll
    for (int i = 0; i < 8; ++i) ld[i] = __builtin_nontemporal_load((const GAS f32x4*)(W + (size_t)(k0 + 8 * i + (lane >> 3)) * N + n0 + 4 * (lane & 7)));
#pragma unroll
    for (int i = 0; i < 8; ++i) { LAS float* d = scr + (8 * i + (lane >> 3)) * 33 + 4 * (lane & 7); d[0] = ld[i].x; d[1] = ld[i].y; d[2] = ld[i].z; d[3] = ld[i].w; }
    LDS_WAIT(); asm volatile("" ::: "memory");
    const int c = lane & 7;
#pragma unroll
    for (int j = 0; j < 4; ++j) { const int n = (lane >> 3) + 8 * j; const LAS float* s = scr + (8 * c) * 33 + n;
        v4u o; o.x = pk2(s[0 * 33], s[1 * 33]); o.y = pk2(s[2 * 33], s[3 * 33]); o.z = pk2(s[4 * 33], s[5 * 33]); o.w = pk2(s[6 * 33], s[7 * 33]);
        *(GAS v4u*)(WT + (size_t)(dst_row0 + n) * K + k0 + 8 * c) = o; }
    LDS_WAIT(); asm volatile("" ::: "memory");
}
__device__ __forceinline__ void rms_row_to_bf16(const float* xrow, const float* g, bf16* orow, int lane) {
    const GAS f32x4* xr = (const GAS f32x4*)xrow + lane; const GAS f32x4* gr = (const GAS f32x4*)g + lane;
    f32x4 v[8]; float s = 0.f;
#pragma unroll
    for (int j = 0; j < 8; ++j) v[j] = __builtin_nontemporal_load(xr + 64 * j);
    f32x4 gv[8];
#pragma unroll
    for (int j = 0; j < 8; ++j) gv[j] = gr[64 * j];
#pragma unroll
    for (int j = 0; j < 8; ++j) s += (v[j].x * v[j].x + v[j].y * v[j].y) + (v[j].z * v[j].z + v[j].w * v[j].w);
    const float rstd = 1.f / sqrtf(wave_sum(s) * (1.f / DMODEL) + 1e-6f);
    GAS unsigned long long* o8 = (GAS unsigned long long*)orow + lane;
#pragma unroll
    for (int j = 0; j < 8; ++j) { const f32x4 gg = gv[j];
        o8[64 * j] = (unsigned long long)pk2(v[j].x * rstd * gg.x, v[j].y * rstd * gg.y) | ((unsigned long long)pk2(v[j].z * rstd * gg.z, v[j].w * rstd * gg.w) << 32); }
}
__device__ __forceinline__ void cvt_item4(const float* src, bf16* dst, size_t item, size_t stride, size_t nitems, int lane) {
    f32x4 a[4], b[4];
#pragma unroll
    for (int q = 0; q < 4; ++q) { const size_t it = item + q * stride; if (it < nitems) { const GAS f32x4* s = (const GAS f32x4*)(src + it * 512) + 2 * lane; a[q] = __builtin_nontemporal_load(s); b[q] = __builtin_nontemporal_load(s + 1); } }
#pragma unroll
    for (int q = 0; q < 4; ++q) { const size_t it = item + q * stride; if (it < nitems) { v4u o; o.x = pk2(a[q].x, a[q].y); o.y = pk2(a[q].z, a[q].w); o.z = pk2(b[q].x, b[q].y); o.w = pk2(b[q].z, b[q].w);
        *((GAS v4u*)(dst + it * 512) + lane) = o; } }
}
template <bool ALLFLY = false> __device__ __forceinline__ void cvt8_item4(const float* src, unsigned char* dst, size_t item, size_t stride, size_t nitems, float scale, int lane) {
    f32x4 v[4][4];
    if (ALLFLY) {
#pragma unroll
        for (int q = 0; q < 4; ++q) { size_t it = item + q * stride; it = (it < nitems) ? it : item; const GAS f32x4* s = (const GAS f32x4*)(src + it * 1024) + lane;
#pragma unroll
            for (int i = 0; i < 4; ++i) v[q][i] = __builtin_nontemporal_load(s + 64 * i); }
        asm volatile("" ::: "memory");
    } else {
#pragma unroll
    for (int q = 0; q < 4; ++q) { const size_t it = item + q * stride; if (it < nitems) { const GAS f32x4* s = (const GAS f32x4*)(src + it * 1024) + lane;
#pragma unroll
        for (int i = 0; i < 4; ++i) v[q][i] = __builtin_nontemporal_load(s + 64 * i); } }
    }
#pragma unroll
    for (int q = 0; q < 4; ++q) { const size_t it = item + q * stride; if (it < nitems) { GAS unsigned* d = (GAS unsigned*)(dst + it * 1024) + lane;
#pragma unroll
        for (int i = 0; i < 4; ++i) { const f32x4 s4 = v[q][i] * scale;
            const float a = fminf(fmaxf(s4.x, -448.f), 448.f), b = fminf(fmaxf(s4.y, -448.f), 448.f), e = fminf(fmaxf(s4.z, -448.f), 448.f), f = fminf(fmaxf(s4.w, -448.f), 448.f);
            int w = __builtin_amdgcn_cvt_pk_fp8_f32(a, b, 0, false); w = __builtin_amdgcn_cvt_pk_fp8_f32(e, f, w, true); d[64 * i] = (unsigned)w; } } }
}

typedef float f32x2 __attribute__((ext_vector_type(2)));
__device__ __forceinline__ float rows_sum(float v) {
    const auto a = __builtin_amdgcn_permlane16_swap(__builtin_bit_cast(unsigned, v), __builtin_bit_cast(unsigned, v), false, false);
    const float s = __builtin_bit_cast(float, (unsigned)a[0]) + __builtin_bit_cast(float, (unsigned)a[1]);
    const auto b = __builtin_amdgcn_permlane32_swap(__builtin_bit_cast(unsigned, s), __builtin_bit_cast(unsigned, s), false, false);
    return __builtin_bit_cast(float, (unsigned)b[0]) + __builtin_bit_cast(float, (unsigned)b[1]);
}
__device__ __forceinline__ void conv_unit(const bf16* U, const float* cw, const float* cb, const float* lng, const float* lnb, bf16* MIX, int b, int t0, int tid_arg) {
    int tid = tid_arg; asm volatile("" : "+v"(tid));
    const int c0 = 2 * tid;
    const bf16* Ub = U + (size_t)b * SEQL * CONVW + c0;
    unsigned ua[16], ub[16];
#define CV_LOAD(BUF, BASE) _Pragma("unroll") for (int q = 0; q < 16; ++q) if ((BASE) + q < 62) { const int t = t0 + (BASE) + q - 30; BUF[q] = *(const unsigned*)(Ub + (size_t)(t < 0 ? 0 : t) * CONVW); }
#define CV_COMP(BUF, BASE) _Pragma("unroll") for (int q = 0; q < 16; ++q) if ((BASE) + q < 62) { const int r = (BASE) + q - 30; \
        const unsigned uq = (t0 + r < 0) ? 0u : BUF[q]; const f32x2 f = (f32x2){bflo(uq), bfhi(uq)}; \
        _Pragma("unroll") for (int tau = (r > 0 ? r : 0); tau <= (r + 30 < 31 ? r + 30 : 31); ++tau) a[tau] += w[r - tau + 30] * f; \
        _Pragma("unroll") for (int tau = (r > 0 ? r : 0); tau <= (r + 30 < 31 ? r + 30 : 31); ++tau) asm volatile("" : "+v"(a[tau])); }
    CV_LOAD(ua, 0); CV_LOAD(ub, 16);
    f32x2 w[31];
#pragma unroll
    for (int j = 0; j < 31; ++j) { const float2 ww = *(const float2*)(cw + j * CONVW + c0); w[j] = (f32x2){ww.x, ww.y}; }
    const float2 bias = *(const float2*)(cb + c0);
    f32x2 a[32];
#pragma unroll
    for (int i = 0; i < 32; ++i) a[i] = (f32x2){bias.x, bias.y};
    __builtin_amdgcn_sched_barrier(0);
    CV_COMP(ua, 0);  __builtin_amdgcn_sched_barrier(0); CV_LOAD(ua, 32); __builtin_amdgcn_sched_barrier(0);
    CV_COMP(ub, 16); __builtin_amdgcn_sched_barrier(0); CV_LOAD(ub, 48); __builtin_amdgcn_sched_barrier(0);
    CV_COMP(ua, 32); __builtin_amdgcn_sched_barrier(0);
    CV_COMP(ub, 48); __builtin_amdgcn_sched_barrier(0);
#undef CV_LOAD
#undef CV_COMP
    const bool odd = tid & 1, b1 = tid & 2;
    float q[16];
    {
        float r1[32];
#pragma unroll
        for (int k = 0; k < 16; ++k) {
            const float p0 = a[2 * k].x + a[2 * k].y, p1 = a[2 * k + 1].x + a[2 * k + 1].y;
            const float keep = odd ? p1 : p0, send = odd ? p0 : p1; r1[k] = keep + dpp_mov<0xB1, 0xF>(0.f, send);
        }
#pragma unroll
        for (int k = 0; k < 16; ++k) {
            const float p0 = a[2 * k].x * a[2 * k].x + a[2 * k].y * a[2 * k].y, p1 = a[2 * k + 1].x * a[2 * k + 1].x + a[2 * k + 1].y * a[2 * k + 1].y;
            const float keep = odd ? p1 : p0, send = odd ? p0 : p1; r1[16 + k] = keep + dpp_mov<0xB1, 0xF>(0.f, send);
        }
#pragma unroll
        for (int m = 0; m < 16; ++m) {
            const float keep = b1 ? r1[2 * m + 1] : r1[2 * m], send = b1 ? r1[2 * m] : r1[2 * m + 1]; float t = keep + dpp_mov<0x4E, 0xF>(0.f, send);
            t += dpp_mov<0x124, 0xF>(0.f, t); t += dpp_mov<0x128, 0xF>(0.f, t); q[m] = rows_sum(t);
        }
    }
    float mean8[8], rs8[8];
#pragma unroll
    for (int m = 0; m < 8; ++m) { const float mean = q[m] * (1.f / 128.f), var = fmaxf(q[8 + m] * (1.f / 128.f) - mean * mean, 0.f); mean8[m] = mean; rs8[m] = __builtin_amdgcn_rsqf(var + 1e-5f); }
    const float2 gg = *(const float2*)(lng + c0), bb = *(const float2*)(lnb + c0);
    bf16* Mo = MIX + ((size_t)b * SEQL + t0) * DMODEL + c0;
#pragma unroll
    for (int i = 0; i < 32; ++i) {
        const float mean = __builtin_bit_cast(float, __builtin_amdgcn_readlane(__builtin_bit_cast(int, mean8[i >> 2]), i & 3)), rs = __builtin_bit_cast(float, __builtin_amdgcn_readlane(__builtin_bit_cast(int, rs8[i >> 2]), i & 3));
        const float y0 = (a[i].x - mean) * rs * gg.x + bb.x, y1 = (a[i].y - mean) * rs * gg.y + bb.y;
        const float o0 = y0 * __builtin_amdgcn_rcpf(1.f + __builtin_amdgcn_exp2f(-1.4426950408889634f * y0)), o1 = y1 * __builtin_amdgcn_rcpf(1.f + __builtin_amdgcn_exp2f(-1.4426950408889634f * y1));
        *(unsigned*)(Mo + (size_t)i * DMODEL) = pk2(o0, o1);
    }
}

__device__ __forceinline__ void combine_rows(const bf16* O0, const bf16* O1, const float* subg, float lam, bf16* MIX, int gw, int NGW, int lane) {
    const int e0 = (lane & 15) * 8;
    const f32x4 g0 = *(const f32x4*)(subg + e0), g1 = *(const f32x4*)(subg + e0 + 4);
    for (int rr = 0; rr < NTOK / NGW; rr += 4) { const int row0 = gw * (NTOK / NGW) + rr;
        v4u xa[8], xb[8];
#pragma unroll
        for (int u = 0; u < 8; ++u) { const int row = row0 + (u >> 1), col = ((u & 1) * 4 + (lane >> 4)) * 128 + e0;
            xa[u] = __builtin_nontemporal_load((const GAS v4u*)(O0 + (size_t)row * 1024 + col)); xb[u] = __builtin_nontemporal_load((const GAS v4u*)(O1 + (size_t)row * 1024 + col)); }
#pragma unroll
        for (int u = 0; u < 8; ++u) { const int row = row0 + (u >> 1), col = ((u & 1) * 4 + (lane >> 4)) * 128 + e0;
            const v4u a = xa[u], b = xb[u];
            float d[8];
            d[0] = bflo(a.x) - lam * bflo(b.x); d[1] = bfhi(a.x) - lam * bfhi(b.x); d[2] = bflo(a.y) - lam * bflo(b.y); d[3] = bfhi(a.y) - lam * bfhi(b.y);
            d[4] = bflo(a.z) - lam * bflo(b.z); d[5] = bfhi(a.z) - lam * bfhi(b.z); d[6] = bflo(a.w) - lam * bflo(b.w); d[7] = bfhi(a.w) - lam * bfhi(b.w);
            float ss = 0.f;
#pragma unroll
            for (int i = 0; i < 8; ++i) ss += d[i] * d[i];
            ss += dpp_mov<0xB1, 0xF>(0.f, ss); ss += dpp_mov<0x4E, 0xF>(0.f, ss); ss += dpp_mov<0x124, 0xF>(0.f, ss); ss += dpp_mov<0x128, 0xF>(0.f, ss);
            const float rs = (1.f - LAM_INIT) * __builtin_amdgcn_rsqf(ss * (1.f / 128.f) + 1e-6f);
            v4u o; o.x = pk2(d[0] * rs * g0.x, d[1] * rs * g0.y); o.y = pk2(d[2] * rs * g0.z, d[3] * rs * g0.w); o.z = pk2(d[4] * rs * g1.x, d[5] * rs * g1.y); o.w = pk2(d[6] * rs * g1.z, d[7] * rs * g1.w);
            *(GAS v4u*)(MIX + (size_t)row * DMODEL + CONVW + col) = o;
        }
    }
}

#if MK_NAIVE_ATTN
__device__ __forceinline__ void attn_naive(const bf16* Q, const bf16* K, const bf16* V, bf16* O0, bf16* O1, LAS unsigned char* lds, int gw, int NGW, int wave, int lane) {
    LAS float* sc = (LAS float*)(lds + wave * 16384);
    for (int it = gw; it < NBATCH * 16 * 2 * SEQL; it += NGW) {
        const int q = it & (SEQL - 1), st = it >> 12, vh = st & 1, hq = (st >> 1) & 15, b = st >> 5, c = hq & 1, hv = (hq >> 1) * 2 + vh;
        const bf16* Qr = Q + ((size_t)b * SEQL + q) * 1024 + hq * 64;
        v4u qv[8];
#pragma unroll
        for (int i = 0; i < 8; ++i) qv[i] = *(const GAS v4u*)(Qr + 8 * i);
        float mx = -INFINITY;
        for (int j = lane; j <= q; j += 64) {
            const bf16* Kr = K + ((size_t)b * SEQL + j) * 1024 + hq * 64; float s = 0.f;
#pragma unroll
            for (int i = 0; i < 8; ++i) { const v4u kv = *(const GAS v4u*)(Kr + 8 * i);
                s = pg8::dot2bf(qv[i].x, kv.x, s); s = pg8::dot2bf(qv[i].y, kv.y, s); s = pg8::dot2bf(qv[i].z, kv.z, s); s = pg8::dot2bf(qv[i].w, kv.w, s); }
            sc[j] = s; mx = fmaxf(mx, s);
        }
#pragma unroll
        for (int o = 1; o < 64; o <<= 1) mx = fmaxf(mx, __shfl_xor(mx, o));
        float l = 0.f;
        for (int j = lane; j <= q; j += 64) { const float p = exp2f(sc[j] - mx); sc[j] = p; l += p; }
        l = wave_sum(l);
        LDS_WAIT(); asm volatile("" ::: "memory");
        const bf16* Vc = V + (size_t)b * SEQL * 1024 + hv * 64 + lane; float o = 0.f;
        for (int j = 0; j <= q; ++j) o += sc[j] * __builtin_bit_cast(float, (unsigned)Vc[(size_t)j * 1024] << 16);
        bf16* Od = (c ? O1 : O0) + ((size_t)b * SEQL + q) * 1024 + hv * 64 + lane;
        *Od = (bf16)f2bf(o / l);
        LDS_WAIT(); asm volatile("" ::: "memory");
    }
}
#endif

__device__ __forceinline__ float gelu1(float v) {
    const float av = __builtin_fabsf(v), t = __builtin_amdgcn_rcpf(av * 0.2316418882f + 1.0f);
    float q = t * 0.5307027145f + (-0.7265760135f); q = q * t + 0.7107068705f; q = q * t + (-0.142248368f); q = q * t + 0.127414796f; q = q * t;
    const float e = __builtin_amdgcn_exp2f((v * v) * (-0.72134752044f));
    const float m = v * (q * e);
    return v < 0.f ? m : v - m;
}
__device__ __forceinline__ f32x2 gelu2(f32x2 v) { return (f32x2){gelu1(v.x), gelu1(v.y)}; }
__device__ __forceinline__ void load16bf(const bf16* p, f32x2 (&o)[8]) {
    const v4u a = *(const GAS v4u*)p, b = *(const GAS v4u*)(p + 8);
    o[0] = (f32x2){bflo(a.x), bfhi(a.x)}; o[1] = (f32x2){bflo(a.y), bfhi(a.y)}; o[2] = (f32x2){bflo(a.z), bfhi(a.z)}; o[3] = (f32x2){bflo(a.w), bfhi(a.w)};
    o[4] = (f32x2){bflo(b.x), bfhi(b.x)}; o[5] = (f32x2){bflo(b.y), bfhi(b.y)}; o[6] = (f32x2){bflo(b.z), bfhi(b.z)}; o[7] = (f32x2){bflo(b.w), bfhi(b.w)};
}
struct HSet { v4u r[8]; };
__device__ __forceinline__ int set_index(int k, int lane) { return ((lane & 7) >> 1) * 128 + 2 * k + (lane & 1); }
__device__ __forceinline__ void hset_load(HSet& S, const unsigned char* TAB, const LAS int* sid, int k, int lane, int lane_off) {
    const int kv = sid[set_index(k, lane)];
#pragma unroll
    for (int e = 0; e < 8; ++e) S.r[e] = *(const GAS v4u*)(TAB + (size_t)__builtin_amdgcn_readlane(kv, e) * DMODEL + lane_off);
}
__device__ __forceinline__ float dot_h(const v4u& q, const f32x2 (&xf)[8]) {
    f32x2 p = __builtin_amdgcn_cvt_pk_f32_fp8((int)q.x, false) * xf[0], p2 = __builtin_amdgcn_cvt_pk_f32_fp8((int)q.x, true) * xf[1];
    p += __builtin_amdgcn_cvt_pk_f32_fp8((int)q.y, false) * xf[2]; p2 += __builtin_amdgcn_cvt_pk_f32_fp8((int)q.y, true) * xf[3];
    p += __builtin_amdgcn_cvt_pk_f32_fp8((int)q.z, false) * xf[4]; p2 += __builtin_amdgcn_cvt_pk_f32_fp8((int)q.z, true) * xf[5];
    p += __builtin_amdgcn_cvt_pk_f32_fp8((int)q.w, false) * xf[6]; p2 += __builtin_amdgcn_cvt_pk_f32_fp8((int)q.w, true) * xf[7];
    p += p2; return p.x + p.y;
}
__device__ __forceinline__ void acc_h(const v4u& q, f32x2 (&y)[8], float w) {
    y[0] += __builtin_amdgcn_cvt_pk_f32_fp8((int)q.x, false) * w; y[1] += __builtin_amdgcn_cvt_pk_f32_fp8((int)q.x, true) * w;
    y[2] += __builtin_amdgcn_cvt_pk_f32_fp8((int)q.y, false) * w; y[3] += __builtin_amdgcn_cvt_pk_f32_fp8((int)q.y, true) * w;
    y[4] += __builtin_amdgcn_cvt_pk_f32_fp8((int)q.z, false) * w; y[5] += __builtin_amdgcn_cvt_pk_f32_fp8((int)q.z, true) * w;
    y[6] += __builtin_amdgcn_cvt_pk_f32_fp8((int)q.w, false) * w; y[7] += __builtin_amdgcn_cvt_pk_f32_fp8((int)q.w, true) * w;
}
template <int HALF> __device__ __forceinline__ void hset_u(HSet& S, const f32x2 (&xf)[4][8], LAS float* sgt, LAS float* hpart, int k, int lane, const unsigned char* TAB, const LAS int* sid, int kn, int lane_off) {
    float pt[8];
    const int kvn = sid[set_index(kn < 0 ? k : kn, lane)];
#pragma unroll
    for (int e = 0; e < 4; ++e) pt[e] = dot_h(S.r[e], xf[e >> 1]);
    if (kn >= 0) {
#pragma unroll
        for (int e = 0; e < 4; ++e) S.r[e] = *(const GAS v4u*)(TAB + (size_t)__builtin_amdgcn_readlane(kvn, e) * DMODEL + lane_off); }
#pragma unroll
    for (int e = 4; e < 8; ++e) pt[e] = dot_h(S.r[e], xf[e >> 1]);
    if (kn >= 0) {
#pragma unroll
        for (int e = 4; e < 8; ++e) S.r[e] = *(const GAS v4u*)(TAB + (size_t)__builtin_amdgcn_readlane(kvn, e) * DMODEL + lane_off); }
    const bool odd = lane & 1, b1 = lane & 2;
    float q[4];
#pragma unroll
    for (int i = 0; i < 4; ++i) { const float keep = odd ? pt[4 + i] : pt[i], send = odd ? pt[i] : pt[4 + i]; q[i] = keep + dpp_mov<0xB1, 0xF>(0.f, send); }
    float r[2];
#pragma unroll
    for (int i = 0; i < 2; ++i) { const float keep = b1 ? q[2 + i] : q[i], send = b1 ? q[i] : q[2 + i]; r[i] = keep + dpp_mov<0x4E, 0xF>(0.f, send); }
#pragma unroll
    for (int i = 0; i < 2; ++i) { r[i] += dpp_mov<0x124, 0xF>(0.f, r[i]); r[i] += dpp_mov<0x128, 0xF>(0.f, r[i]); r[i] = rows_sum(r[i]); }
    const int idx = ((odd ? 2 : 0) + (b1 ? 1 : 0)) * 128 + 2 * k;
    if (HALF == 0) { if (lane < 4) { hpart[idx] = r[0]; hpart[idx + 1] = r[1]; } }
    else {
        const f32x2 hk = (f32x2){r[0] + hpart[idx], r[1] + hpart[idx + 1]} * (1.f / USCALE);
        const f32x2 g2 = gelu2(hk);
        if (lane < 4) { sgt[idx] = sgt[idx] * g2.x * (1.f / VSCALE); sgt[idx + 1] = sgt[idx + 1] * g2.y * (1.f / VSCALE); }
    }
}
__device__ __forceinline__ void hset_v(HSet& S, f32x2 (&y)[4][8], const LAS float* sgt, int k, int lane, const unsigned char* TAB, const LAS int* sid, int kn, int lane_off) {
    const float wv = sgt[set_index(k, lane)]; const int kvn = sid[set_index(kn < 0 ? k : kn, lane)];
#pragma unroll
    for (int e = 0; e < 4; ++e) acc_h(S.r[e], y[e >> 1], __builtin_bit_cast(float, __builtin_amdgcn_readlane(__builtin_bit_cast(int, wv), e)));
    if (kn >= 0) {
#pragma unroll
        for (int e = 0; e < 4; ++e) S.r[e] = *(const GAS v4u*)(TAB + (size_t)__builtin_amdgcn_readlane(kvn, e) * DMODEL + lane_off); }
#pragma unroll
    for (int e = 4; e < 8; ++e) acc_h(S.r[e], y[e >> 1], __builtin_bit_cast(float, __builtin_amdgcn_readlane(__builtin_bit_cast(int, wv), e)));
    if (kn >= 0) {
#pragma unroll
        for (int e = 4; e < 8; ++e) S.r[e] = *(const GAS v4u*)(TAB + (size_t)__builtin_amdgcn_readlane(kvn, e) * DMODEL + lane_off); }
}
#define RING3(LOAD, COMP) do { HSet A_, B_, C_; LOAD(A_, 0); LOAD(B_, 1); LOAD(C_, 2); \
    _Pragma("unroll 1") for (int k = 0; k < 63; k += 3) { COMP(A_, k, k + 3); COMP(B_, k + 1, (k + 4 < 64) ? k + 4 : -1); COMP(C_, k + 2, (k + 5 < 64) ? k + 5 : -1); } \
    COMP(A_, 63, -1); } while (0)
#define RING3S(LOAD, COMP) do { HSet A_, B_, C_; LOAD(A_, 0); LOAD(B_, 1); \
    _Pragma("unroll 1") for (int k = 0; k < 63; k += 3) { LOAD(C_, k + 2); COMP(A_, k, -1); LOAD(A_, k + 3); COMP(B_, k + 1, -1); if (k + 4 < 64) LOAD(B_, k + 4); COMP(C_, k + 2, -1); } \
    COMP(A_, 63, -1); } while (0)
template <int HALF> __device__ __forceinline__ void peer_u_pass(const bf16* HI, const unsigned char* UT, const float* g_peer, const float (&rs)[4], int t0,
                                                                 const LAS int* sid, LAS float* sgt, LAS float* hpart) {
    int lane = (int)__builtin_amdgcn_mbcnt_hi(~0u, __builtin_amdgcn_mbcnt_lo(~0u, 0u)); asm volatile("" : "+v"(lane));
    f32x2 xf[4][8];
#pragma unroll
    for (int j = 0; j < 4; ++j) {
        const int t = (t0 + j < NTOK) ? t0 + j : t0; load16bf(HI + (size_t)t * DMODEL + HALF * 1024 + lane * 16, xf[j]);
#pragma unroll
        for (int i = 0; i < 4; ++i) { const f32x4 g = *(const f32x4*)(g_peer + HALF * 1024 + lane * 16 + 4 * i);
            xf[j][2 * i] = xf[j][2 * i] * (f32x2){rs[j] * g.x, rs[j] * g.y}; xf[j][2 * i + 1] = xf[j][2 * i + 1] * (f32x2){rs[j] * g.z, rs[j] * g.w}; }
    }
    const int lane_off = HALF * 1024 + lane * 16;
#define PU_LOAD(S, k) hset_load(S, UT, sid, k, lane, lane_off)
#define PU_COMP(S, k, kn) hset_u<HALF>(S, xf, sgt, hpart, k, lane, UT, sid, kn, lane_off)
    RING3S(PU_LOAD, PU_COMP);
#undef PU_LOAD
#undef PU_COMP
}
template <int HALF> __device__ __forceinline__ void peer_v_pass(const bf16* HI, float* HO, const unsigned char* VT, const float* g_final, float (&ss)[4], int t0, const LAS int* sid, const LAS float* sgt, LAS unsigned char* stash) {
    int lane = (int)__builtin_amdgcn_mbcnt_hi(~0u, __builtin_amdgcn_mbcnt_lo(~0u, 0u)); asm volatile("" : "+v"(lane));
    f32x2 y[4][8];
#pragma unroll
    for (int j = 0; j < 4; ++j)
#pragma unroll
        for (int i = 0; i < 8; ++i) y[j][i] = (f32x2){0.f, 0.f};
    const int lane_off = HALF * 1024 + lane * 16;
#define PV_LOAD(S, k) hset_load(S, VT, sid, k, lane, lane_off)
#define PV_COMP(S, k, kn) hset_v(S, y, sgt, k, lane, VT, sid, kn, lane_off)
    RING3S(PV_LOAD, PV_COMP);
#undef PV_LOAD
#undef PV_COMP
#pragma unroll
    for (int j = 0; j < 4; ++j) {
        const int t = t0 + j;
        if (t < NTOK) {
            f32x2 hh[8]; load16bf(HI + (size_t)t * DMODEL + lane_off, hh); float s = 0.f;
#pragma unroll
            for (int i = 0; i < 8; ++i) { y[j][i] += hh[i]; s += y[j][i].x * y[j][i].x + y[j][i].y * y[j][i].y; }
            ss[j] += wave_sum_u(s);
            LAS v4u* st = (LAS v4u*)(stash + j * 2048 + lane * 32);
            if (HALF == 0) {
                st[0] = (v4u){pk2(y[j][0].x, y[j][0].y), pk2(y[j][1].x, y[j][1].y), pk2(y[j][2].x, y[j][2].y), pk2(y[j][3].x, y[j][3].y)};
                st[1] = (v4u){pk2(y[j][4].x, y[j][4].y), pk2(y[j][5].x, y[j][5].y), pk2(y[j][6].x, y[j][6].y), pk2(y[j][7].x, y[j][7].y)};
            } else {
                const float r3 = 1.f / sqrtf(ss[j] * (1.f / DMODEL) + 1e-6f); float* orow = HO + (size_t)t * DMODEL + lane * 16;
#pragma unroll
                for (int i = 0; i < 4; ++i) { const f32x4 g = *(const f32x4*)(g_final + 1024 + lane * 16 + 4 * i);
                    *(f32x4*)(orow + 1024 + 4 * i) = (f32x4){y[j][2 * i].x * r3 * g.x, y[j][2 * i].y * r3 * g.y, y[j][2 * i + 1].x * r3 * g.z, y[j][2 * i + 1].y * r3 * g.w}; }
                const v4u a = st[0], bq = st[1];
                const f32x4 l0 = (f32x4){bflo(a.x), bfhi(a.x), bflo(a.y), bfhi(a.y)}, l1 = (f32x4){bflo(a.z), bfhi(a.z), bflo(a.w), bfhi(a.w)};
                const f32x4 l2 = (f32x4){bflo(bq.x), bfhi(bq.x), bflo(bq.y), bfhi(bq.y)}, l3 = (f32x4){bflo(bq.z), bfhi(bq.z), bflo(bq.w), bfhi(bq.w)};
                const f32x4 g0 = *(const f32x4*)(g_final + lane * 16), g1 = *(const f32x4*)(g_final + lane * 16 + 4), g2 = *(const f32x4*)(g_final + lane * 16 + 8), g3 = *(const f32x4*)(g_final + lane * 16 + 12);
                *(f32x4*)(orow) = l0 * g0 * r3; *(f32x4*)(orow + 4) = l1 * g1 * r3; *(f32x4*)(orow + 8) = l2 * g2 * r3; *(f32x4*)(orow + 12) = l3 * g3 * r3;
            }
        }
    }
}
#ifndef MK_PEER_Q
#define MK_PEER_Q 1
#endif
__device__ __forceinline__ float half_rows_sum(float v) {
    const auto a = __builtin_amdgcn_permlane16_swap(__builtin_bit_cast(unsigned, v), __builtin_bit_cast(unsigned, v), false, false);
    return __builtin_bit_cast(float, (unsigned)a[0]) + __builtin_bit_cast(float, (unsigned)a[1]);
}
__device__ __forceinline__ void qset_load(HSet& S, const unsigned char* TAB, const LAS int* sid, int k, int hi, unsigned lane_off) {
#pragma unroll
    for (int e = 0; e < 8; ++e) { const unsigned id = (unsigned)sid[(e >> 1) * 128 + 4 * k + 2 * (e & 1) + hi]; S.r[e] = *(const GAS v4u*)(TAB + ((id << 11) + lane_off)); }
}
template <int Q> __device__ __forceinline__ void qset_u(const HSet& S, const f32x2 (&xf)[4][8], LAS float* sgt, LAS float* hpart, int k, int lane) {
    float pt[8];
#pragma unroll
    for (int e = 0; e < 8; ++e) pt[e] = dot_h(S.r[e], xf[e >> 1]);
    const bool odd = lane & 1, b1 = lane & 2;
    float q[4];
#pragma unroll
    for (int i = 0; i < 4; ++i) { const float keep = odd ? pt[4 + i] : pt[i], send = odd ? pt[i] : pt[4 + i]; q[i] = keep + dpp_mov<0xB1, 0xF>(0.f, send); }
    float r[2];
#pragma unroll
    for (int i = 0; i < 2; ++i) { const float keep = b1 ? q[2 + i] : q[i], send = b1 ? q[i] : q[2 + i]; r[i] = keep + dpp_mov<0x4E, 0xF>(0.f, send); }
#pragma unroll
    for (int i = 0; i < 2; ++i) { r[i] += dpp_mov<0x124, 0xF>(0.f, r[i]); r[i] += dpp_mov<0x128, 0xF>(0.f, r[i]); r[i] = half_rows_sum(r[i]); }
    const int idx = ((odd ? 2 : 0) + (b1 ? 1 : 0)) * 128 + 4 * k + (lane >> 5);
    const bool wr = (lane & 31) < 4;
    if (Q == 0) { if (wr) { hpart[idx] = r[0]; hpart[idx + 2] = r[1]; } }
    else if (Q < 3) { if (wr) { hpart[idx] += r[0]; hpart[idx + 2] += r[1]; } }
    else {
        const f32x2 hk = (f32x2){r[0] + hpart[idx], r[1] + hpart[idx + 2]} * (1.f / USCALE);
        const f32x2 g2 = gelu2(hk);
        if (wr) { sgt[idx] = sgt[idx] * g2.x * (1.f / VSCALE); sgt[idx + 2] = sgt[idx + 2] * g2.y * (1.f / VSCALE); }
    }
}
__device__ __forceinline__ void qset_v(const HSet& S, f32x2 (&y)[4][8], const LAS float* sgt, int k, int hi) {
#pragma unroll
    for (int e = 0; e < 8; ++e) acc_h(S.r[e], y[e >> 1], sgt[(e >> 1) * 128 + 4 * k + 2 * (e & 1) + hi]);
}
#define RINGQ(LOAD, COMP) do { HSet A_, B_, C_; LOAD(A_, 0); LOAD(B_, 1); RSBQ_; \
    _Pragma("unroll 1") for (int k = 0; k < 30; k += 3) { LOAD(C_, k + 2); RSBQ_; COMP(A_, k); RSBQ_; LOAD(A_, k + 3); RSBQ_; COMP(B_, k + 1); RSBQ_; LOAD(B_, k + 4); RSBQ_; COMP(C_, k + 2); RSBQ_; } \
    COMP(A_, 30); RSBQ_; COMP(B_, 31); } while (0)
#define RSBQ_ __builtin_amdgcn_sched_barrier(0)
template <int Q> __device__ __forceinline__ void peer_u_pass_q(const bf16* HI, const unsigned char* UT, const float* g_peer, const float (&rs)[4], int t0,
                                                               const LAS int* sid, LAS float* sgt, LAS float* hpart) {
    int lane = (int)__builtin_amdgcn_mbcnt_hi(~0u, __builtin_amdgcn_mbcnt_lo(~0u, 0u)); asm volatile("" : "+v"(lane));
    const int hi = lane >> 5, col0 = Q * 512 + (lane & 31) * 16;
    f32x2 xf[4][8];
#pragma unroll
    for (int j = 0; j < 4; ++j) {
        const int t = (t0 + j < NTOK) ? t0 + j : t0; load16bf(HI + (size_t)t * DMODEL + col0, xf[j]);
#pragma unroll
        for (int i = 0; i < 4; ++i) { const f32x4 g = *(const f32x4*)(g_peer + col0 + 4 * i);
            xf[j][2 * i] = xf[j][2 * i] * (f32x2){rs[j] * g.x, rs[j] * g.y}; xf[j][2 * i + 1] = xf[j][2 * i + 1] * (f32x2){rs[j] * g.z, rs[j] * g.w}; }
    }
    const unsigned lane_off = (unsigned)col0;
#define PUQ_LOAD(S, k) qset_load(S, UT, sid, k, hi, lane_off)
#define PUQ_COMP(S, k) qset_u<Q>(S, xf, sgt, hpart, k, lane)
    RINGQ(PUQ_LOAD, PUQ_COMP);
#undef PUQ_LOAD
#undef PUQ_COMP
}
template <int Q> __device__ __forceinline__ void peer_v_pass_q(const bf16* HI, float* HO, const unsigned char* VT, const float* g_final, float (&ss)[4], int t0, const LAS int* sid, const LAS float* sgt, LAS unsigned char* stash) {
    int lane = (int)__builtin_amdgcn_mbcnt_hi(~0u, __builtin_amdgcn_mbcnt_lo(~0u, 0u)); asm volatile("" : "+v"(lane));
    const int hi = lane >> 5, l32 = lane & 31, col0 = Q * 512 + l32 * 16;
    f32x2 y[4][8];
#pragma unroll
    for (int j = 0; j < 4; ++j)
#pragma unroll
        for (int i = 0; i < 8; ++i) y[j][i] = (f32x2){0.f, 0.f};
    const unsigned lane_off = (unsigned)col0;
#define PVQ_LOAD(S, k) qset_load(S, VT, sid, k, hi, lane_off)
#define PVQ_COMP(S, k) qset_v(S, y, sgt, k, hi)
    RINGQ(PVQ_LOAD, PVQ_COMP);
#undef PVQ_LOAD
#undef PVQ_COMP
#pragma unroll
    for (int j = 0; j < 4; ++j)
#pragma unroll
        for (int i = 0; i < 8; ++i) {
            const float yx = y[j][i].x, yy = y[j][i].y;
            const unsigned ux = __builtin_bit_cast(unsigned, yx), uy = __builtin_bit_cast(unsigned, yy);
            const auto ax = __builtin_amdgcn_permlane32_swap(ux, ux, false, false);
            const auto ay = __builtin_amdgcn_permlane32_swap(uy, uy, false, false);
            y[j][i] = (f32x2){__builtin_bit_cast(float, (unsigned)ax[0]) + __builtin_bit_cast(float, (unsigned)ax[1]), __builtin_bit_cast(float, (unsigned)ay[0]) + __builtin_bit_cast(float, (unsigned)ay[1])}; }
    v4u hw[4][2];
#pragma unroll
    for (int j = 0; j < 4; ++j) { const int t = (t0 + j < NTOK) ? t0 + j : t0; const bf16* p = HI + (size_t)t * DMODEL + col0; hw[j][0] = *(const GAS v4u*)p; hw[j][1] = *(const GAS v4u*)(p + 8); }
    f32x4 gf[4][4];
    if (Q == 3) {
#pragma unroll
        for (int qq = 0; qq < 4; ++qq)
#pragma unroll
            for (int i = 0; i < 4; ++i) gf[qq][i] = *(const f32x4*)(g_final + qq * 512 + l32 * 16 + 4 * i);
    }
#pragma unroll
    for (int j = 0; j < 4; ++j) {
        const int t = t0 + j; const bool act = (hi == (j >> 1)) && (t < NTOK);
        f32x2 hh[8]; float s = 0.f;
        { const v4u a = hw[j][0], bq = hw[j][1];
          hh[0] = (f32x2){bflo(a.x), bfhi(a.x)}; hh[1] = (f32x2){bflo(a.y), bfhi(a.y)}; hh[2] = (f32x2){bflo(a.z), bfhi(a.z)}; hh[3] = (f32x2){bflo(a.w), bfhi(a.w)};
          hh[4] = (f32x2){bflo(bq.x), bfhi(bq.x)}; hh[5] = (f32x2){bflo(bq.y), bfhi(bq.y)}; hh[6] = (f32x2){bflo(bq.z), bfhi(bq.z)}; hh[7] = (f32x2){bflo(bq.w), bfhi(bq.w)}; }
#pragma unroll
        for (int i = 0; i < 8; ++i) { y[j][i] += hh[i]; s += y[j][i].x * y[j][i].x + y[j][i].y * y[j][i].y; }
        ss[j] += wave_sum_u(act ? s : 0.f);
        if (act) {
            if (Q < 3) {
                LAS v4u* st = (LAS v4u*)(stash + (j * 3 + Q) * 1024 + l32 * 32);
                st[0] = (v4u){pk2(y[j][0].x, y[j][0].y), pk2(y[j][1].x, y[j][1].y), pk2(y[j][2].x, y[j][2].y), pk2(y[j][3].x, y[j][3].y)};
                st[1] = (v4u){pk2(y[j][4].x, y[j][4].y), pk2(y[j][5].x, y[j][5].y), pk2(y[j][6].x, y[j][6].y), pk2(y[j][7].x, y[j][7].y)};
            } else {
                const float r3 = 1.f / sqrtf(ss[j] * (1.f / DMODEL) + 1e-6f); float* orow = HO + (size_t)t * DMODEL + l32 * 16;
#pragma unroll
                for (int i = 0; i < 4; ++i) { const f32x4 g = gf[3][i];
                    *(f32x4*)(orow + 1536 + 4 * i) = (f32x4){y[j][2 * i].x * r3 * g.x, y[j][2 * i].y * r3 * g.y, y[j][2 * i + 1].x * r3 * g.z, y[j][2 * i + 1].y * r3 * g.w}; }
#pragma unroll
                for (int qq = 0; qq < 3; ++qq) { const LAS v4u* st = (const LAS v4u*)(stash + (j * 3 + qq) * 1024 + l32 * 32); const v4u a = st[0], bq = st[1];
                    const f32x4 l0 = (f32x4){bflo(a.x), bfhi(a.x), bflo(a.y), bfhi(a.y)}, l1 = (f32x4){bflo(a.z), bfhi(a.z), bflo(a.w), bfhi(a.w)};
                    const f32x4 l2 = (f32x4){bflo(bq.x), bfhi(bq.x), bflo(bq.y), bfhi(bq.y)}, l3 = (f32x4){bflo(bq.z), bfhi(bq.z), bflo(bq.w), bfhi(bq.w)};
                    float* oq = orow + qq * 512;
                    *(f32x4*)(oq) = l0 * gf[qq][0] * r3; *(f32x4*)(oq + 4) = l1 * gf[qq][1] * r3; *(f32x4*)(oq + 8) = l2 * gf[qq][2] * r3; *(f32x4*)(oq + 12) = l3 * gf[qq][3] * r3; }
            }
        }
    }
}
__device__ __forceinline__ void top16_insert(float (&tv)[16], int (&ti)[16], float x, int px) {
    bool c_hi = x > tv[15];
#pragma unroll
    for (int r = 15; r >= 1; --r) { const bool c_lo = x > tv[r - 1]; ti[r] = c_lo ? ti[r - 1] : (c_hi ? px : ti[r]); tv[r] = __builtin_amdgcn_fmed3f(tv[r - 1], tv[r], x); c_hi = c_lo; }
    ti[0] = c_hi ? px : ti[0]; tv[0] = fmaxf(tv[0], x);
}
__device__ __forceinline__ void route_stage2(const float (&tv)[16], const int (&ti)[16], bool half, bool valid, int (&oid)[8], float (&ogt)[8]) {
    float av[16], bv[16]; int ai[16], bi[16];
#pragma unroll
    for (int r = 0; r < 16; ++r) {
        const float pv = dpp_mov<0xB1, 0xF>(tv[r], tv[r]); const int pi = __builtin_amdgcn_update_dpp(ti[r], ti[r], 0xB1, 0xF, 0xF, false);
        av[r] = half ? pv : tv[r]; bv[r] = half ? tv[r] : pv; ai[r] = half ? pi : ti[r]; bi[r] = half ? ti[r] : pi;
    }
    float cv[16]; int ci[16];
    {
        const float a0 = half ? av[1] : av[0]; const int i0 = (half ? ai[1] : ai[0]) << 7;
#pragma unroll
        for (int r = 0; r < 16; ++r) { const float s0 = a0 + bv[r]; cv[r] = (r >= 8 && half) ? -INFINITY : s0; ci[r] = i0 | bi[r]; }
    }
#define CAND(IA, JA, IB, JB) do { const float aS = half ? av[IB] : av[IA], bS = half ? bv[JB] : bv[JA]; const int aI = half ? ai[IB] : ai[IA], bI = half ? bi[JB] : bi[JA]; \
        top16_insert(cv, ci, aS + bS, (aI << 7) | bI); } while (0)
    CAND(2, 0, 3, 0); CAND(2, 1, 3, 1); CAND(2, 2, 3, 2); CAND(2, 3, 3, 3); CAND(2, 4, 7, 0); CAND(4, 0, 7, 1); CAND(4, 1, 9, 0); CAND(4, 2, 10, 0);
    CAND(5, 0, 11, 0); CAND(5, 1, 12, 0); CAND(6, 0, 13, 0); CAND(6, 1, 14, 0); CAND(8, 0, 15, 0);
#undef CAND
    float mv[16]; int mi[16];
#pragma unroll
    for (int r = 0; r < 16; ++r) {
        const float pv = dpp_mov<0xB1, 0xF>(cv[15 - r], cv[15 - r]); const int pi = __builtin_amdgcn_update_dpp(ci[15 - r], ci[15 - r], 0xB1, 0xF, 0xF, false);
        const bool own = cv[r] >= pv; mv[r] = own ? cv[r] : pv; mi[r] = own ? ci[r] : pi;
    }
    const float mx = fmaxf(mv[0], mv[15]);
    float ev[16];
#pragma unroll
    for (int r = 0; r < 16; ++r) ev[r] = __expf(mv[r] - mx);
    const float es = (((ev[0] + ev[15]) + (ev[7] + ev[8])) + ((ev[1] + ev[14]) + (ev[6] + ev[9]))) + (((ev[2] + ev[13]) + (ev[5] + ev[10])) + ((ev[3] + ev[12]) + (ev[4] + ev[11])));
    const float inv = valid ? 1.f / es : 0.f;
#pragma unroll
    for (int r = 0; r < 8; ++r) { oid[r] = mi[r]; ogt[r] = ev[r] * inv; }
}
__device__ __forceinline__ void route4(const float* SALL, int t0, LAS int* ids, LAS float* gts, int lane) {
    const int j = lane >> 4, tj = (t0 + j < NTOK) ? t0 + j : t0;
    const float* sp = SALL + (size_t)tj * 2048 + (lane & 15) * 128;
    float tk[16];
#pragma unroll
    for (int r = 0; r < 16; ++r) tk[r] = -INFINITY;
#pragma unroll 1
    for (int mo = 0; mo < 4; ++mo) {
        f32x4 ln[8];
#pragma unroll
        for (int q = 0; q < 8; ++q) ln[q] = *(const f32x4*)(sp + 32 * mo + 4 * q);
#pragma unroll
        for (int q = 0; q < 8; ++q)
#pragma unroll
            for (int e = 0; e < 4; ++e) {
                const int idx = 32 * mo + 4 * q + e; const float xe = ln[q][e]; const unsigned xb = __builtin_bit_cast(unsigned, xe);
                const float key = __builtin_bit_cast(float, (xb & ~127u) | (unsigned)((xb >> 31) ? idx : 127 - idx));
#pragma unroll
                for (int r = 15; r >= 1; --r) tk[r] = __builtin_amdgcn_fmed3f(tk[r - 1], tk[r], key);
                tk[0] = fmaxf(tk[0], key);
            }
    }
    float tv[16]; int ti[16];
#pragma unroll
    for (int r = 0; r < 16; ++r) { const unsigned kb = __builtin_bit_cast(unsigned, tk[r]); const int lo = (int)(kb & 127u); ti[r] = (kb >> 31) ? lo : 127 - lo; tv[r] = sp[ti[r]]; }
    int oid[8]; float ogt[8];
    route_stage2(tv, ti, lane & 1, t0 + j < NTOK, oid, ogt);
    {
        const int o = j * 128 + ((lane >> 1) & 7) * 16 + ((lane & 1) ? 8 : 0);
#pragma unroll
        for (int r = 0; r < 8; ++r) { ids[o + r] = oid[r]; gts[o + r] = ogt[r]; }
    }
}

#ifndef MK_ROUTE_FUSED
#define MK_ROUTE_FUSED 1
#endif
struct EpiRoute {
    static constexpr bool PERM = true, AFTER_DRAIN = true;
    const LAS float* rstd; int* PID; float* PGT;
    __device__ __forceinline__ void operator()(const pg8::f32x4 (&)[2][2][4][2], const pg8::Unit&, int, int, int, int) const {}
    __device__ __forceinline__ void fused(pg8::f32x4 (&acc)[2][2][4][2], const pg8::Unit& u, int wr, int wc, int fr, int fq, LAS unsigned char* lds, int wid, int lane_arg) const {
        LAS float* S = (LAS float*)lds;
        int lane = lane_arg; asm volatile("" : "+v"(lane));
        const int tl = (lane >> 1) & 15, hf = lane & 1, sub = lane >> 5, swz = tl * 4;
        const LAS float* base = S + (wid * 16 + tl) * 256;
        float fv[16]; int fi[16];
#pragma unroll
        for (int r = 0; r < 16; ++r) { fv[r] = 0.f; fi[r] = 0; }
#pragma unroll
        for (int pass = 0; pass < 2; ++pass) {
#pragma unroll
            for (int m = 0; m < 4; ++m) { const int tau = wr * 64 + m * 16 + fr; const float rs = rstd[pass * 128 + tau]; LAS float* d = S + tau * 256;
#pragma unroll
                for (int bj = 0; bj < 2; ++bj) { const int c0 = bj * 128 + wc * 32 + fq * 8;
                    *(LAS pg8::f32x4*)(d + (c0 ^ (fr * 4))) = acc[pass][bj][m][0] * rs; *(LAS pg8::f32x4*)(d + ((c0 + 4) ^ (fr * 4))) = acc[pass][bj][m][1] * rs; } }
            asm volatile("s_waitcnt lgkmcnt(0)" ::: "memory"); __builtin_amdgcn_s_barrier(); asm volatile("" ::: "memory");
            float tk[16];
#pragma unroll
            for (int r = 0; r < 16; ++r) tk[r] = -INFINITY;
#pragma unroll
            for (int i = 0; i < 16; ++i) { const pg8::f32x4 v = *(const LAS pg8::f32x4*)(base + ((hf * 128 + sub * 64 + 4 * i) ^ swz));
#pragma unroll
                for (int e = 0; e < 4; ++e) { const int k = 4 * i + e; const float xe = v[e]; const unsigned xb = __builtin_bit_cast(unsigned, xe);
                    const float key = __builtin_bit_cast(float, (xb & ~127u) | (unsigned)((xb >> 31) ? k : 127 - k));
#pragma unroll
                    for (int r = 15; r >= 1; --r) tk[r] = __builtin_amdgcn_fmed3f(tk[r - 1], tk[r], key);
                    tk[0] = fmaxf(tk[0], key); } }
            const unsigned x6 = sub ? 64u : 0u;
#pragma unroll
            for (int r = 0; r < 16; ++r) tk[r] = __builtin_bit_cast(float, __builtin_bit_cast(unsigned, tk[r]) ^ x6);
            float mk[16];
#pragma unroll
            for (int r = 0; r < 16; ++r) { const unsigned w = __builtin_bit_cast(unsigned, tk[15 - r]); const auto sw = __builtin_amdgcn_permlane32_swap(w, w, false, false);
                const float pr = __builtin_bit_cast(float, sub ? (unsigned)sw[0] : (unsigned)sw[1]); mk[r] = fmaxf(tk[r], pr); }
#pragma unroll
            for (int d = 8; d >= 1; d >>= 1)
#pragma unroll
                for (int i = 0; i < 16; ++i) if ((i & d) == 0) { const float hi = fmaxf(mk[i], mk[i + d]), lo = fminf(mk[i], mk[i + d]); mk[i] = hi; mk[i + d] = lo; }
#pragma unroll
            for (int r = 0; r < 16; ++r) { const unsigned kb = __builtin_bit_cast(unsigned, mk[r]); const int lo = (int)(kb & 127u), idx = (kb >> 31) ? lo : 127 - lo;
                const float val = base[(hf * 128 + idx) ^ swz];
                fv[r] = (sub == pass) ? val : fv[r]; fi[r] = (sub == pass) ? idx : fi[r]; }
            asm volatile("s_waitcnt lgkmcnt(0)" ::: "memory"); __builtin_amdgcn_s_barrier(); asm volatile("" ::: "memory");
        }
        int oid[8]; float ogt[8];
        route_stage2(fv, fi, hf, true, oid, ogt);
        const size_t o = (size_t)(u.pm * 256 + sub * 128 + wid * 16 + tl) * 128 + u.pn * 16 + (hf ? 8 : 0);
        *(GAS v4u*)(PID + o) = (v4u){(unsigned)oid[0], (unsigned)oid[1], (unsigned)oid[2], (unsigned)oid[3]}; *(GAS v4u*)(PID + o + 4) = (v4u){(unsigned)oid[4], (unsigned)oid[5], (unsigned)oid[6], (unsigned)oid[7]};
        *(GAS f32x4*)(PGT + o) = (f32x4){ogt[0], ogt[1], ogt[2], ogt[3]}; *(GAS f32x4*)(PGT + o + 4) = (f32x4){ogt[4], ogt[5], ogt[6], ogt[7]};
    }
};
__device__ __forceinline__ void peer_phase(const bf16* HI, float* HO, const float* SALL, const unsigned char* UT, const unsigned char* VT, const float* g_peer, const float* g_final,
                                           LAS unsigned char* lds, int gw, int NGW, int wave, int lane_arg) {
    LAS unsigned char* wl = lds + wave * 16384;
    LAS int* sid = (LAS int*)wl; LAS float* sgt = (LAS float*)(wl + 2048); LAS float* hpart = (LAS float*)(wl + 4096);
    LAS unsigned* cnt = (LAS unsigned*)(wl + 6144); LAS unsigned* bbase = cnt + 128;
    const int rot = 16 * (int)(blockIdx.x & 7);
    for (int t0 = gw * 4; t0 < NTOK; t0 += NGW * 4) {
        int lane = (int)__builtin_amdgcn_mbcnt_hi(~0u, __builtin_amdgcn_mbcnt_lo(~0u, 0u)); asm volatile("" : "+v"(lane));
#if MK_ROUTE_FUSED
        {
            const int* PIDr = (const int*)SALL; const float* PGTr = SALL + (size_t)NTOK * 128;
#pragma unroll
            for (int j = 0; j < 4; ++j) { const int t = (t0 + j < NTOK) ? t0 + j : t0;
#pragma unroll
                for (int i = 0; i < 2; ++i) { sid[j * 128 + 64 * i + lane] = PIDr[(size_t)t * 128 + 64 * i + lane]; sgt[j * 128 + 64 * i + lane] = (t0 + j < NTOK) ? PGTr[(size_t)t * 128 + 64 * i + lane] : 0.f; } }
        }
#else
        route4(SALL, t0, sid, sgt, lane);
#endif
        LDS_WAIT(); asm volatile("" ::: "memory");
#pragma unroll 1
        for (int j = 0; j < 4; ++j) {
            LAS int* ids = sid + j * 128; LAS float* gts = sgt + j * 128;
            cnt[lane] = 0u; cnt[64 + lane] = 0u;
            asm volatile("" ::: "memory");
            int key[2]; float gt[2]; unsigned slot[2];
#pragma unroll
            for (int i = 0; i < 2; ++i) { key[i] = ids[lane + 64 * i]; gt[i] = gts[lane + 64 * i]; }
#pragma unroll
            for (int i = 0; i < 2; ++i) slot[i] = __hip_atomic_fetch_add(cnt + (((key[i] >> 7) - rot) & 127), 1u, __ATOMIC_RELAXED, __HIP_MEMORY_SCOPE_WORKGROUP);
            asm volatile("" ::: "memory");
            const unsigned c0 = cnt[2 * lane], c1 = cnt[2 * lane + 1]; unsigned s = c0 + c1;
            int ln = lane; asm volatile("" : "+v"(ln));
#pragma unroll
            for (int d = 1; d < 64; d <<= 1) { const unsigned tt = (unsigned)__builtin_amdgcn_ds_bpermute(((ln >= d) ? ln - d : ln) * 4, (int)s); if (ln >= d) s += tt; }
            bbase[2 * lane] = s - c0 - c1; bbase[2 * lane + 1] = s - c1;
            asm volatile("" ::: "memory");
#pragma unroll
            for (int i = 0; i < 2; ++i) { const unsigned pos = bbase[((key[i] >> 7) - rot) & 127] + slot[i]; ids[pos] = key[i]; gts[pos] = gt[i]; }
            LDS_WAIT(); asm volatile("" ::: "memory");
        }
        float rs[4];
#pragma unroll
        for (int j = 0; j < 4; ++j) {
            const int t = (t0 + j < NTOK) ? t0 + j : t0; float ss = 0.f;
#pragma unroll
            for (int i = 0; i < 2; ++i) { f32x2 hh[8]; load16bf(HI + (size_t)t * DMODEL + i * 1024 + lane * 16, hh);
#pragma unroll
                for (int k = 0; k < 8; ++k) ss += hh[k].x * hh[k].x + hh[k].y * hh[k].y; }
            rs[j] = 1.f / sqrtf(wave_sum_u(ss) * (1.f / DMODEL) + 1e-6f);
        }
        __builtin_amdgcn_s_barrier();
#if MK_PEER_Q
#define PQ_SYNC() do { LDS_WAIT(); asm volatile("" ::: "memory"); __builtin_amdgcn_s_barrier(); } while (0)
        peer_u_pass_q<0>(HI, UT, g_peer, rs, t0, sid, sgt, hpart); PQ_SYNC();
        peer_u_pass_q<1>(HI, UT, g_peer, rs, t0, sid, sgt, hpart); PQ_SYNC();
        peer_u_pass_q<2>(HI, UT, g_peer, rs, t0, sid, sgt, hpart); PQ_SYNC();
        peer_u_pass_q<3>(HI, UT, g_peer, rs, t0, sid, sgt, hpart); PQ_SYNC();
        float ss3[4] = {0.f, 0.f, 0.f, 0.f};
        peer_v_pass_q<0>(HI, HO, VT, g_final, ss3, t0, sid, sgt, wl + 4096); PQ_SYNC();
        peer_v_pass_q<1>(HI, HO, VT, g_final, ss3, t0, sid, sgt, wl + 4096); PQ_SYNC();
        peer_v_pass_q<2>(HI, HO, VT, g_final, ss3, t0, sid, sgt, wl + 4096); PQ_SYNC();
        peer_v_pass_q<3>(HI, HO, VT, g_final, ss3, t0, sid, sgt, wl + 4096);
        LDS_WAIT(); asm volatile("" ::: "memory");
#undef PQ_SYNC
#else
        peer_u_pass<0>(HI, UT, g_peer, rs, t0, sid, sgt, hpart);
        LDS_WAIT(); asm volatile("" ::: "memory"); __builtin_amdgcn_s_barrier();
        peer_u_pass<1>(HI, UT, g_peer, rs, t0, sid, sgt, hpart);
        LDS_WAIT(); asm volatile("" ::: "memory"); __builtin_amdgcn_s_barrier();
        float ss3[4] = {0.f, 0.f, 0.f, 0.f};
        peer_v_pass<0>(HI, HO, VT, g_final, ss3, t0, sid, sgt, wl + 8192);
        LDS_WAIT(); asm volatile("" ::: "memory"); __builtin_amdgcn_s_barrier();
        peer_v_pass<1>(HI, HO, VT, g_final, ss3, t0, sid, sgt, wl + 8192);
        LDS_WAIT(); asm volatile("" ::: "memory");
#endif
    }
}

__device__ __forceinline__ void tile_rstd(const float* part, int row0, LAS float* tab, int tid) {
    const int r = tid >> 1, hf = tid & 1; const f32x4* p = (const f32x4*)(part + (size_t)(row0 + r) * 32 + hf * 16); float s = 0.f;
#pragma unroll
    for (int i = 0; i < 4; ++i) { const f32x4 v = p[i]; s += (v[0] + v[1]) + (v[2] + v[3]); }
    s += __shfl_xor(s, 1);
    if (hf == 0) tab[r] = 1.0f / sqrtf(s * (1.0f / 2048.0f) + 1e-6f);
    __syncthreads();
}

__device__ __forceinline__ void xcc_local_barrier(unsigned* bar, unsigned* cnt, unsigned target, int wave_in) {
    asm volatile("s_waitcnt vmcnt(0)" ::: "memory");
    __syncthreads();
    if (wave_in == 0 && mk_lane() == 0) {
        __builtin_amdgcn_s_waitcnt(0);
        (void)xb_add(cnt, 1u);
        XB_SPIN(xb_ld(cnt) < target, bar);
        __builtin_amdgcn_fence(__ATOMIC_ACQUIRE, "agent");
        asm volatile("s_waitcnt vmcnt(0)" ::: "memory");
    }
    __syncthreads();
}

struct Args { const float* in[26]; float* out; unsigned char* ws; int ph_lo, ph_hi; };
constexpr int N_PHASES = 9;
constexpr int C_T = NEXP * (DMODEL / 1024);

#if MK_NAIVE_GEMM
#define RUN_GEMM(EPI, ALIGN, g, S, E) pg8::gemm_phase_naive<EPI, pg8::TileOrder>(ldsp, g, S, E, wave)
#else
#define RUN_GEMM(EPI, ALIGN, g, S, E) pg8::gemm_phase<EPI, pg8::TileOrder, ALIGN, true>(ldsp, g, S, E, wave)
#endif

__global__ void __launch_bounds__(NWAVES * 64, 2) mk_fwd(Args args) {
    extern __shared__ __attribute__((aligned(16))) unsigned char lds[];
    LAS unsigned char* ldsp = (LAS unsigned char*)lds;
    volatile LAS unsigned* MISC = (volatile LAS unsigned*)(ldsp + MISC_OFF);
    const int wave = __builtin_amdgcn_readfirstlane((int)threadIdx.x >> 6);
#define tid mk_tid(wave)
#define lane mk_lane()
    const int G = gridDim.x, bid = blockIdx.x;
    const int vcu = (G % 8 == 0) ? (bid % 8) * (G / 8) + bid / 8 : bid;
    const int gw = vcu * NWAVES + wave, NGW = G * NWAVES;
    unsigned char* ws = args.ws;
    gu32* ctl = (gu32*)(ws + WS_CTL);
    const float* x = args.in[0]; const float* mem = args.in[1]; const float* norm_mix_g = args.in[2]; const float* w_in = args.in[3];
    const float* conv_w = args.in[4]; const float* conv_b = args.in[5]; const float* conv_ln_g = args.in[6]; const float* conv_ln_b = args.in[7];
    const float* lq1 = args.in[8]; const float* lk1 = args.in[9]; const float* lq2 = args.in[10]; const float* lk2 = args.in[11]; const float* subln_g = args.in[12];
    const float* w_out = args.in[13]; const float* norm_cross_g = args.in[14]; const float* norm_mem_g = args.in[15];
    const float* w_cq = args.in[16]; const float* w_ckv = args.in[17]; const float* w_co = args.in[18]; const float* norm_peer_g = args.in[19]; const float* w_pq = args.in[20];
    const float* keys1 = args.in[21]; const float* keys2 = args.in[22]; const float* peer_u = args.in[23]; const float* peer_v = args.in[24]; const float* final_g = args.in[25];
    float* out = args.out;
    float* PART1 = (float*)(ws + WS_PART1); float* PART2 = (float*)(ws + WS_PART2);
    bf16* ABD = (bf16*)(ws + WS_ABD); bf16* W1T = (bf16*)(ws + WS_W1T); bf16* WOUTT = (bf16*)(ws + WS_WOUTT); bf16* WCQ = (bf16*)(ws + WS_WCQ); bf16* WCKVT = (bf16*)(ws + WS_WCKVT);
    bf16* WCOT = (bf16*)(ws + WS_WCOT); bf16* WPQ = (bf16*)(ws + WS_WPQ); bf16* MN = (bf16*)(ws + WS_MN); bf16* KV = (bf16*)(ws + WS_KV); bf16* WKT = (bf16*)(ws + WS_WKT);
    bf16* VWT = (bf16*)(ws + WS_VWT); bf16* WST = (bf16*)(ws + WS_WST); bf16* ACT = (bf16*)(ws + WS_ACT); bf16* UB = (bf16*)(ws + WS_U); bf16* QB = (bf16*)(ws + WS_Q);
    bf16* KB = (bf16*)(ws + WS_K); bf16* VB = (bf16*)(ws + WS_V); bf16* O0 = (bf16*)(ws + WS_O0); bf16* O1 = (bf16*)(ws + WS_O1); bf16* MIX = (bf16*)(ws + WS_MIX);
    bf16* PB = (bf16*)(ws + WS_P); float* SALL = (float*)(ws + WS_SALL); unsigned char* UTAB = ws + WS_UTAB; unsigned char* VTAB = ws + WS_VTAB;

    for (int u = tid; u < (LDS_BYTES - LDSCTL_OFF) / 4; u += NWAVES * 64) ((LAS unsigned*)(ldsp + LDSCTL_OFF))[u] = 0u;
    __syncthreads();
    const int lo = args.ph_lo, hi = args.ph_hi;
    const bool one_launch = (hi - lo) > 1;
    XcdBarrier bar; bar.bar = (unsigned*)(ctl + CW_BAR); bar.x = 0; bar.st = nullptr;
    if (one_launch) bar = xcd_barrier_post((unsigned*)(ctl + CW_BAR), MISC + 8, wave);
#define IN(k) (lo <= (k) && (k) < hi)
#if MK_LAUNCH_PER_PHASE
#define REP(k)
#else
#define REP(k) for (int rep_ = 0; rep_ < 1 + ((MK_REPEAT_MASK >> (k)) & 1); ++rep_)
#endif
#define SEAM(k) do { if (IN(k) && IN((k) + 1)) xcd_barrier(bar, wave); } while (0)
    if (one_launch && tid == 0) {
        const unsigned mine = bar.x + 1u, old = atomicCAS((unsigned*)(ctl + CW_LAB + (bid & 7)), 0u, mine);
        if ((old != 0u && old != mine) || G != 256) atomicOr((unsigned*)(ctl + CW_FLAG), 1u);
    }
    unsigned loc_epoch = 0u;
#define SEAM_LOCAL(k) do { if (IN(k) && IN((k) + 1)) { \
        if (__hip_atomic_load((unsigned*)(ctl + CW_FLAG), __ATOMIC_RELAXED, __HIP_MEMORY_SCOPE_AGENT) == 0u) { ++loc_epoch; xcc_local_barrier(bar.bar, (unsigned*)(ctl + CW_LOC + 64 * bar.x), loc_epoch * MISC[8], wave); } \
        else xcd_barrier(bar, wave); } } while (0)

    if (IN(0)) REP(0) {
        LAS float* scr = (LAS float*)(ldsp + RING_OFF + wave * 16384);
        constexpr int I_IN = 32 * (INW / 32), I_CKV = 32 * (2 * DMODEL / 32);
        for (int it = gw; it < I_IN + I_CKV + NTOK + NMEM; it += NGW) {
            int r = it;
            if (r < I_IN) { const int nblk = INW / 32, kb = r / nblk, nb = r % nblk, n0 = 32 * nb;
                const int dst = (n0 < 2048) ? (((n0 & 1023) >> 7) * 256 + (n0 >> 10) * 128 + (n0 & 127)) : n0;
                p0_transpose_item(w_in, DMODEL, INW, W1T, 64 * kb, n0, dst, scr, lane); continue; } r -= I_IN;
            if (r < I_CKV) { const int nblk = 2 * DMODEL / 32; p0_transpose_item(w_ckv, DMODEL, 2 * DMODEL, WCKVT, 64 * (r / nblk), 32 * (r % nblk), 32 * (r % nblk), scr, lane); continue; } r -= I_CKV;
            if (r < NTOK) rms_row_to_bf16(x + (size_t)r * DMODEL, norm_mix_g, ACT + (size_t)r * DMODEL, lane);
            else rms_row_to_bf16(mem + (size_t)(r - NTOK) * DMODEL, norm_mem_g, MN + (size_t)(r - NTOK) * DMODEL, lane);
        }
        constexpr int C_W = DMODEL * DMODEL / 512;
        for (int it = gw; it < C_W; it += 4 * NGW) cvt_item4(w_pq, WPQ, it, NGW, C_W, lane);
        for (int it = gw; it < 8 * 256 * 256 / 512; it += NGW) {
            const int e0 = it * 512 + lane * 8, h = e0 >> 16, m = (e0 >> 8) & 255, k = e0 & 255;
            v4u o = (v4u){0u, 0u, 0u, 0u};
            const float* src = nullptr;
            if (m < 128 && k < 128) src = keys1 + ((size_t)h * 128 + m) * 128 + k;
            else if (m >= 128 && k >= 128) src = keys2 + ((size_t)h * 128 + (m - 128)) * 128 + (k - 128);
            if (src) { const f32x4 a = *(const f32x4*)src, b = *(const f32x4*)(src + 4); o.x = pk2(a.x, a.y); o.y = pk2(a.z, a.w); o.z = pk2(b.x, b.y); o.w = pk2(b.z, b.w); }
            *(GAS v4u*)(ABD + e0) = o;
        }
    }
    SEAM(0);

    if (IN(1)) REP(1) {
        { pg8::Gemm g{ACT, W1T, DMODEL, DMODEL, DMODEL, 1, 0, 0, 0, 0}; pg8::TileOrder S; S.init(NTOK / 256, INW / 256, 1, G, bid);
          pg8::EpiZ E{UB, QB, (long)((WS_K - WS_Q) / 2), C2Q}; RUN_GEMM(pg8::EpiZ, true, g, S, E); }
        { pg8::Gemm g{MN, WCKVT, DMODEL, DMODEL, DMODEL, 1, 0, 0, 0, 0}; pg8::TileOrder S; S.init(NMEM / 256, 2 * DMODEL / 256, 1, G, (bid + G - 128) % G);
          pg8::EpiBf16S E{KV, 2 * DMODEL, 1, 0, 0, nullptr, 1.f}; RUN_GEMM(pg8::EpiBf16S, true, g, S, E); }
        if (bid >= 160) { const int nw = (G - 160) * NWAVES, w0 = (bid - 160) * NWAVES + wave;
            for (int it = w0; it < C_T / 2; it += 4 * nw) cvt8_item4(peer_u, UTAB, it, nw, C_T / 2, USCALE, lane);
            LAS float* scr = (LAS float*)(ldsp + RING_OFF + wave * 16384); constexpr int I_SQ = 32 * (DMODEL / 32), nblk = DMODEL / 32;
            for (int it = w0; it < 2 * I_SQ; it += nw) { const int r = it % I_SQ;
                p0_transpose_item(it < I_SQ ? w_out : w_co, DMODEL, DMODEL, it < I_SQ ? WOUTT : WCOT, 64 * (r / nblk), 32 * (r % nblk), 32 * (r % nblk), scr, lane); }
            constexpr int C_W = DMODEL * DMODEL / 512;
            for (int it = w0; it < C_W; it += 4 * nw) cvt_item4(w_cq, WCQ, it, nw, C_W, lane); }
    }
    SEAM(1);

    if (IN(2)) REP(2) {
#if MK_NAIVE_ATTN
        attn_naive(QB, KB, VB, O0, O1, ldsp, gw, NGW, wave, lane);
#else
#if MK_ATTN128
        const float lam = expf(wave_sum(lq1[lane] * lk1[lane])) - expf(wave_sum(lq2[lane] * lk2[lane])) + LAM_INIT;
        const unsigned slow = one_launch ? __hip_atomic_load((unsigned*)(ctl + CW_FLAG), __ATOMIC_RELAXED, __HIP_MEMORY_SCOPE_AGENT) : 1u;
        for (int idx = vcu; idx < 256; idx += G) {
            const int st = idx >> 3, s = idx & 7, hq = st & 15, b = st >> 4, h = hq >> 1;
#pragma unroll 1
            for (int i = 0; i < 2; ++i) { const int qb = (i == 0) ? 15 - s : s, hqi = hq ^ i;
                attn128::attn_unit128<8>(b, hqi, h, qb, (const attn_body::bf16*)QB, (const attn_body::bf16*)KB, (const attn_body::bf16*)VB, (attn_body::bf16*)O0, (char*)lds, wave,
                                         hqi & 1, (unsigned*)(ctl + CW_OFL + 16 * (((b * 8 + h) * 16) + qb)), (attn_body::bf16*)MIX, lam, subln_g, slow); }
        }
#else
        for (int idx = vcu; idx < 256; idx += G) {
            const int st = idx >> 2, s = idx & 3, vh = st & 1, hq = (st >> 1) & 15, b = st >> 5, c = hq & 1, hv = (hq >> 1) * 2 + vh;
            attn_body::bf16* Oc = (attn_body::bf16*)(c ? O1 : O0);
#pragma unroll 1
            for (int i = 0; i < 4; ++i) { const int qb = (i == 0) ? 15 - s : (i == 1) ? s : (i == 2) ? 11 - s : 4 + s;
                attn_body::attn_unit<8>(b, hq, hv, qb, (const attn_body::bf16*)QB, (const attn_body::bf16*)KB, (const attn_body::bf16*)VB, Oc, (char*)lds, wave); }
        }
#endif
#endif
        { const int npass = (bid >= 64) ? ((wave < 4) ? 2 : 0) : 1;
          for (int u = vcu; u < NBATCH * (SEQL / 32); u += G)
#pragma unroll 1
              for (int ps = 0; ps < npass; ++ps) conv_unit(UB, conv_w, conv_b, conv_ln_g, conv_ln_b, MIX, u / (SEQL / 32), (u % (SEQL / 32)) * 32, tid + 256 * ps); }
        { pg8::Gemm g{KV, WCQ, 2 * DMODEL, DMODEL, 512, 4, (long)MEMLEN * 2 * DMODEL, 512, 0, 512}; pg8::TileOrder S; S.init(1, DMODEL / 256, 8, G, bid);
          pg8::EpiBf16S E{WKT, DMODEL, 4, (long)1024 * DMODEL, (long)256 * DMODEL, norm_cross_g, CROSS_SC}; RUN_GEMM(pg8::EpiBf16S, true, g, S, E); }
        if (bid >= 64 && wave >= 4) { const int nw = (G - 64) * 4; for (int it = (bid - 64) * 4 + (wave - 4); it < C_T / 2; it += 4 * nw) cvt8_item4<true>(peer_v, VTAB, it, nw, C_T / 2, VSCALE, lane); }
    }
    SEAM(2);

#if !(MK_ATTN128 && !MK_NAIVE_ATTN)
    if (IN(3)) REP(3) {
        const float l1 = wave_sum(lq1[lane] * lk1[lane]), l2 = wave_sum(lq2[lane] * lk2[lane]);
        const float lam = expf(l1) - expf(l2) + LAM_INIT;
        combine_rows(O0, O1, subln_g, lam, MIX, gw, NGW, lane);
    }
    SEAM_LOCAL(3);
#endif

    if (IN(4)) REP(4) {
        pg8::Gemm g{MIX, WOUTT, DMODEL, DMODEL, DMODEL, 1, 0, 0, 0, 0}; pg8::TileOrder S; S.init(NTOK / 256, DMODEL / 256, 1, G, bid);
        pg8::EpiRes<true> E{x, ACT, PART1, 0}; RUN_GEMM(pg8::EpiRes<true>, true, g, S, E);
    }
    SEAM_LOCAL(4);

    if (IN(5)) REP(5) {
        { pg8::Gemm g{ACT, WKT, DMODEL, DMODEL, DMODEL, 1, (long)SEQL * DMODEL, 0, (long)1024 * DMODEL, 0}; pg8::TileOrder S; S.init(SEQL / 256, 4, NBATCH, G, bid < 128 ? bid : -1);
          pg8::Unit u0; LAS float* rt = (LAS float*)(ldsp + RSTD_OFF); if (S.next(0, u0)) tile_rstd(PART1, u0.z * SEQL + u0.pm * 256, rt, tid);
          pg8::EpiSoftmax E{rt, PB, SEQL}; RUN_GEMM(pg8::EpiSoftmax, false, g, S, E); }
        { pg8::Gemm g{WCOT, KV + DMODEL, DMODEL, 2 * DMODEL, 512, 4, 0, 512, (long)MEMLEN * 2 * DMODEL, 512}; pg8::TileOrder S; S.init(DMODEL / 256, 1, 8, G, (bid >= 128 && bid < 192) ? bid - 128 : -1);
          pg8::EpiBf16S E{VWT, 1024, 4, (long)DMODEL * 1024, 256, nullptr, 1.f}; RUN_GEMM(pg8::EpiBf16S, true, g, S, E); }
        { pg8::Gemm g{ABD, WPQ, 256, DMODEL, 256, 1, 65536, 0, 256, 0}; pg8::TileOrder S; S.init(1, DMODEL / 256, 8, G, (bid >= 192 && bid < 256) ? bid - 192 : -1);
          pg8::EpiBf16S E{WST, DMODEL, 1, (long)256 * DMODEL, 0, norm_peer_g, 1.f}; RUN_GEMM(pg8::EpiBf16S, true, g, S, E); }
        if (bid >= 128) { const int nw = (G - 128) * NWAVES; for (int it = C_T / 2 + (bid - 128) * NWAVES + wave; it < C_T; it += 4 * nw) cvt8_item4(peer_v, VTAB, it, nw, C_T, VSCALE, lane); }
        if (bid >= 128) { const int nw = (G - 128) * NWAVES; for (int it = C_T / 2 + (bid - 128) * NWAVES + wave; it < C_T; it += 4 * nw) cvt8_item4(peer_u, UTAB, it, nw, C_T, USCALE, lane); }
    }
    SEAM(5);

    if (IN(6)) REP(6) {
        pg8::Gemm g{PB, VWT, 1024, 1024, 1024, 1, (long)SEQL * 1024, 0, (long)DMODEL * 1024, 0}; pg8::TileOrder S; S.init(SEQL / 256, DMODEL / 256, NBATCH, G, bid);
        pg8::EpiRes<false> E{nullptr, ACT, PART2, SEQL}; RUN_GEMM(pg8::EpiRes<false>, true, g, S, E);
    }
    SEAM_LOCAL(6);

    if (IN(7)) REP(7) {
        pg8::Gemm g{ACT, WST, DMODEL, DMODEL, DMODEL, 1, 0, 0, 0, 0}; pg8::TileOrder S; S.init(NTOK / 256, DMODEL / 256, 1, G, bid);
        pg8::Unit u0; LAS float* rt = (LAS float*)(ldsp + RSTD_OFF); if (S.next(0, u0)) tile_rstd(PART2, u0.pm * 256, rt, tid);
#if MK_ROUTE_FUSED
        EpiRoute E{rt, (int*)SALL, SALL + (size_t)NTOK * 128}; RUN_GEMM(EpiRoute, false, g, S, E);
#else
        pg8::EpiScore E{rt, SALL}; RUN_GEMM(pg8::EpiScore, true, g, S, E);
#endif
    }
    SEAM_LOCAL(7);

    if (IN(8)) REP(8) peer_phase(ACT, out, SALL, UTAB, VTAB, norm_peer_g, final_g, ldsp, gw, NGW, wave, lane);
#undef IN
#undef REP
#undef SEAM
#undef SEAM_LOCAL
}

#undef tid
#undef lane
extern "C" void kernel_launch(void* const* d_in, const int* in_sizes, int n_in, void* d_out, int out_size, void* d_ws, size_t ws_size, hipStream_t stream) {
    static int grid = 0;
    if (grid == 0) {
        if (n_in != 26 || in_sizes[0] != NTOK * DMODEL || out_size != NTOK * DMODEL || ws_size < WS_END) {
            fprintf(stderr, "kernel_launch: unexpected shapes (n_in %d, in0 %d, out %d, ws %zu); nothing launched\n", n_in, n_in > 0 ? in_sizes[0] : -1, out_size, ws_size); grid = -1; return; }
        int dev = 0, cus = 0, per_cu = 0;
        if (hipGetDevice(&dev) != hipSuccess || hipDeviceGetAttribute(&cus, hipDeviceAttributeMultiprocessorCount, dev) != hipSuccess) { fprintf(stderr, "kernel_launch: device query failed\n"); grid = -1; return; }
        if (hipFuncSetAttribute((const void*)mk_fwd, hipFuncAttributeMaxDynamicSharedMemorySize, LDS_BYTES) != hipSuccess) { fprintf(stderr, "kernel_launch: hipFuncSetAttribute failed\n"); grid = -1; return; }
        if (hipOccupancyMaxActiveBlocksPerMultiprocessor(&per_cu, (const void*)mk_fwd, NWAVES * 64, LDS_BYTES) != hipSuccess || per_cu < 1) {
            fprintf(stderr, "kernel_launch: occupancy query reports %d workgroups per CU; nothing launched\n", per_cu); (void)hipGetLastError(); grid = -1; return; }
        grid = cus;
        if (grid != 256) { fprintf(stderr, "kernel_launch: built for a 256-CU device, found %d CUs; nothing launched\n", cus); grid = -1; return; }
    }
    if (grid < 0) return;
    (void)hipMemsetAsync((char*)d_ws + WS_CTL, 0, CTL_ZERO_BYTES, stream);
    Args a{};
    for (int i = 0; i < 26; ++i) a.in[i] = (const float*)d_in[i];
    a.out = (float*)d_out; a.ws = (unsigned char*)d_ws;
#if MK_LAUNCH_PER_PHASE
    for (int p = 0; p < N_PHASES; ++p) for (int rep = 0; rep < 1 + ((MK_REPEAT_MASK >> p) & 1); ++rep) { a.ph_lo = p; a.ph_hi = p + 1; hipLaunchKernelGGL(mk_fwd, dim3(grid), dim3(NWAVES * 64), LDS_BYTES, stream, a); }
#else
    a.ph_lo = 0; a.ph_hi = N_PHASES; hipLaunchKernelGGL(mk_fwd, dim3(grid), dim3(NWAVES * 64), LDS_BYTES, stream, a);
#endif
}
```

```cpp
#include <hip/hip_runtime.h>
#include <hip/hip_bf16.h>
#include <cstdio>
#include <cstdint>
#include <cmath>

#ifndef MK_LAUNCH_PER_PHASE
#define MK_LAUNCH_PER_PHASE 0
#endif
#ifndef MK_REPEAT_MASK
#define MK_REPEAT_MASK 0
#endif
#ifndef MK_ATTN128
#define MK_ATTN128 1
#endif
#ifndef MK_NAIVE_GEMM
#define MK_NAIVE_GEMM 0
#endif
#ifndef MK_NAIVE_ATTN
#define MK_NAIVE_ATTN 0
#endif

__device__ __forceinline__ int mk_lane() { int l = (int)__builtin_amdgcn_mbcnt_hi(~0u, __builtin_amdgcn_mbcnt_lo(~0u, 0u)); asm volatile("" : "+v"(l)); return l; }
__device__ __forceinline__ int mk_tid(int wave) { return wave * 64 + mk_lane(); }
namespace pg8 {
#define PG8_LAS __attribute__((address_space(3)))
typedef unsigned short bf16_t;
typedef short bf16x8 __attribute__((ext_vector_type(8)));
typedef float f32x4 __attribute__((ext_vector_type(4)));
typedef unsigned u32x4 __attribute__((ext_vector_type(4)));
typedef float f32x2_t __attribute__((ext_vector_type(2)));
typedef __bf16 bf16x2_t __attribute__((ext_vector_type(2)));
constexpr int BM = 256, BK = 64, HALF = 128, HTB = HALF * BK * 2  , STAGE_BYTES = 8 * HTB, NXCD = 8, WGM = 4;

__host__ __device__ __forceinline__ int lds_byte(int r, int c) { const int st = (r >> 4) * 2 + (c >> 5), rr = r & 15, cc = c & 31, ob = rr * 64 + cc * 2; return st * 1024 + (ob ^ (((ob >> 9) & 1) << 5)); }
__host__ __device__ __forceinline__ void stage_rc(int b, int& R, int& C) { const int st = b / 1024, sb = b % 1024, swz = sb ^ (((sb >> 9) & 1) << 5); R = (st >> 1) * 16 + swz / 64; C = (st & 1) * 32 + (swz % 64) / 2; }
__host__ __device__ __forceinline__ int perm32(int rho) { const int n = rho >> 4, i = rho & 15; return 8 * (i >> 2) + 4 * n + (i & 3); }

struct Unit { int pm, pn, z; };
struct Gemm { const bf16_t* A; const bf16_t* Bt; int lda, ldb, K, Z1; long sa0, sa1, sb0, sb1; };
__device__ __forceinline__ const char* a_tile(const Gemm& g, const Unit& u) { const int z0 = u.z / g.Z1, z1 = u.z % g.Z1; return (const char*)(g.A + z0 * g.sa0 + z1 * g.sa1 + (long)u.pm * BM * g.lda); }
__device__ __forceinline__ const char* b_tile(const Gemm& g, const Unit& u) { const int z0 = u.z / g.Z1, z1 = u.z % g.Z1; return (const char*)(g.Bt + z0 * g.sb0 + z1 * g.sb1 + (long)u.pn * BM * g.ldb); }

struct TileOrder {
    int nM, nN, per, nwg, G, c;
    __device__ __forceinline__ void init(int nM_, int nN_, int Z, int G_, int c_) { nM = nM_; nN = nN_; per = nM_ * nN_; nwg = per * Z; G = G_; c = c_; }
    __device__ __forceinline__ bool next(int i, Unit& u) const {
        if (c < 0) return false;
        const long L = (long)i * G + c; if (L >= nwg) return false;
        int wgid = (int)L; { const int q = nwg / NXCD, r = nwg % NXCD, xcd = wgid % NXCD, off = wgid / NXCD; wgid = (xcd < r ? xcd * (q + 1) : r * (q + 1) + (xcd - r) * q) + off; }
        u.z = wgid / per; const int w = wgid % per;
        const int nig = WGM * nN, gid = w / nig, fm = gid * WGM, gsz = (nM - fm) < WGM ? (nM - fm) : WGM;
        u.pm = fm + ((w % nig) % gsz); u.pn = (w % nig) / gsz; return true;
    }
    __device__ __forceinline__ void a_ready(const Unit&) const {}
    __device__ __forceinline__ void done(const Unit&) const {}
};

__device__ __forceinline__ unsigned pk2(float lo, float hi) { f32x2_t v = {lo, hi}; bf16x2_t b = __builtin_convertvector(v, bf16x2_t); return __builtin_bit_cast(unsigned, b); }
__device__ __forceinline__ u32x4 pk8(const f32x4& a, const f32x4& b) { u32x4 w; w.x = pk2(a[0], a[1]); w.y = pk2(a[2], a[3]); w.z = pk2(b[0], b[1]); w.w = pk2(b[2], b[3]); return w; }
__device__ __forceinline__ float dot2bf(unsigned a, unsigned b, float c) { return __builtin_amdgcn_fdot2_f32_bf16(__builtin_bit_cast(bf16x2_t, a), __builtin_bit_cast(bf16x2_t, b), c, false); }

__device__ __forceinline__ float rstd_from_parts(const float* part, int row) {
    const f32x4* p = (const f32x4*)(part + (size_t)row * 32); float s = 0.f;
#pragma unroll
    for (int i = 0; i < 8; ++i) { const f32x4 v = p[i]; s += (v[0] + v[1]) + (v[2] + v[3]); }
    return 1.0f / sqrtf(s * (1.0f / 2048.0f) + 1e-6f);
}


struct NoPre {};
struct RstdPre { f32x4 v[4]; };
__device__ __forceinline__ void rstd_pre_issue(const float* part, int row0, int tid, RstdPre& ps) {
    const f32x4* p = (const f32x4*)(part + (size_t)(row0 + (tid >> 1)) * 32 + (tid & 1) * 16);
#pragma unroll
    for (int i = 0; i < 4; ++i) ps.v[i] = p[i];
}
__device__ __forceinline__ void rstd_pre_finish(const RstdPre& ps, PG8_LAS float* tab, int tid) {
    float s = 0.f;
#pragma unroll
    for (int i = 0; i < 4; ++i) s += (ps.v[i][0] + ps.v[i][1]) + (ps.v[i][2] + ps.v[i][3]);
    s += __shfl_xor(s, 1);
    if ((tid & 1) == 0) tab[tid >> 1] = 1.0f / sqrtf(s * (1.0f / 2048.0f) + 1e-6f);
}
struct EpiZ {
    static constexpr bool PERM = true, AFTER_DRAIN = false, PRE = false; using PreState = NoPre;
    bf16_t *U, *Q; long qkv_stride; float qscale; const float* rstd0;
    __device__ __forceinline__ void operator()(const f32x4 (&acc)[2][2][4][2], const Unit& u, int wr, int wc, int fr, int fq) const {
        const int row0 = u.pm * BM + wr * 64 + fr;
        float rsr[2][4];
#pragma unroll
        for (int ai = 0; ai < 2; ++ai)
#pragma unroll
            for (int m = 0; m < 4; ++m) rsr[ai][m] = rstd0[row0 + ai * HALF + m * 16];
        if (u.pn < 8) {
            const int col = 128 * u.pn + 32 * wc + 8 * fq;
#pragma unroll
            for (int ai = 0; ai < 2; ++ai)
#pragma unroll
                for (int m = 0; m < 4; ++m) {
                    f32x4 o[2];
#pragma unroll
                    for (int n = 0; n < 2; ++n)
#pragma unroll
                        for (int e = 0; e < 4; ++e) { const float a = acc[ai][0][m][n][e] * rsr[ai][m], g = acc[ai][1][m][n][e] * rsr[ai][m]; o[n][e] = a * __builtin_amdgcn_rcpf(1.0f + __builtin_amdgcn_exp2f(-1.4426950408889634f * g)); }
                    *(u32x4*)(U + (size_t)(row0 + ai * HALF + m * 16) * 1024 + col) = pk8(o[0], o[1]);
                }
        } else {
            const int t = (u.pn - 8) >> 2; bf16_t* base = Q + (long)t * qkv_stride; const float sc = (t == 0) ? qscale : 1.0f;
            const int colt = ((u.pn - 8) & 3) * BM + 32 * wc + 8 * fq;
#pragma unroll
            for (int ai = 0; ai < 2; ++ai)
#pragma unroll
                for (int m = 0; m < 4; ++m)
#pragma unroll
                    for (int bj = 0; bj < 2; ++bj) { const float scr = sc * rsr[ai][m]; const f32x4 v0 = acc[ai][bj][m][0] * scr, v1 = acc[ai][bj][m][1] * scr;
                        *(u32x4*)(base + (size_t)(row0 + ai * HALF + m * 16) * 1024 + colt + bj * HALF) = pk8(v0, v1); }
        }
    }
};
struct EpiBf16S {
    static constexpr bool PERM = true, AFTER_DRAIN = false, PRE = false; using PreState = NoPre;
    bf16_t* O; int ldc, Z1; long so0, so1; const float* colscale; float cs;
    __device__ __forceinline__ void operator()(const f32x4 (&acc)[2][2][4][2], const Unit& u, int wr, int wc, int fr, int fq) const {
        const int row0 = u.pm * BM + wr * 64 + fr, col0 = u.pn * BM + wc * 32 + 8 * fq;
        bf16_t* base = O + (u.z / Z1) * so0 + (u.z % Z1) * so1;
        f32x4 sv[2][2];
#pragma unroll
        for (int bj = 0; bj < 2; ++bj)
#pragma unroll
            for (int n = 0; n < 2; ++n) { sv[bj][n] = colscale ? *(const f32x4*)(colscale + col0 + bj * HALF + 4 * n) : (f32x4){1.f, 1.f, 1.f, 1.f}; sv[bj][n] = sv[bj][n] * cs; }
#pragma unroll
        for (int ai = 0; ai < 2; ++ai)
#pragma unroll
            for (int m = 0; m < 4; ++m)
#pragma unroll
                for (int bj = 0; bj < 2; ++bj) { const f32x4 v0 = acc[ai][bj][m][0] * sv[bj][0], v1 = acc[ai][bj][m][1] * sv[bj][1];
                    *(u32x4*)(base + (size_t)(row0 + ai * HALF + m * 16) * ldc + col0 + bj * HALF) = pk8(v0, v1); }
    }
};
template <bool RESF32> struct EpiRes {
    static constexpr bool PERM = true, AFTER_DRAIN = false, PRE = false; using PreState = NoPre;
    const float* resf; bf16_t* Hb; float* part; int rows_per_z;
    __device__ __forceinline__ void finish(const f32x4& r0, const f32x4& r1, const f32x4& a0, const f32x4& a1, size_t off, float& ss) const {
        const f32x4 h0 = r0 + a0, h1 = r1 + a1;
        *(u32x4*)(Hb + off) = pk8(h0, h1);
        ss += (h0[0] * h0[0] + h0[1] * h0[1]) + (h0[2] * h0[2] + h0[3] * h0[3]) + (h1[0] * h1[0] + h1[1] * h1[1]) + (h1[2] * h1[2] + h1[3] * h1[3]);
    }
    __device__ __forceinline__ void operator()(const f32x4 (&acc)[2][2][4][2], const Unit& u, int wr, int wc, int fr, int fq) const {
        const int row0 = u.z * rows_per_z + u.pm * BM + wr * 64 + fr, colw = u.pn * BM + wc * 32 + 8 * fq;
        if (!RESF32) {
            u32x4 rw[2][4][2];
#pragma unroll
            for (int ai = 0; ai < 2; ++ai)
#pragma unroll
                for (int m = 0; m < 4; ++m)
#pragma unroll
                    for (int bj = 0; bj < 2; ++bj) rw[ai][m][bj] = *(const u32x4*)(Hb + (size_t)(row0 + ai * HALF + m * 16) * 2048 + colw + bj * HALF);
#pragma unroll
            for (int ai = 0; ai < 2; ++ai)
#pragma unroll
                for (int m = 0; m < 4; ++m) { const int row = row0 + ai * HALF + m * 16; float ss = 0.f;
#pragma unroll
                    for (int bj = 0; bj < 2; ++bj) { const size_t off = (size_t)row * 2048 + colw + bj * HALF; const u32x4 w = rw[ai][m][bj];
                        const f32x4 r0 = (f32x4){__builtin_bit_cast(float, w.x << 16), __builtin_bit_cast(float, w.x & 0xffff0000u), __builtin_bit_cast(float, w.y << 16), __builtin_bit_cast(float, w.y & 0xffff0000u)};
                        const f32x4 r1 = (f32x4){__builtin_bit_cast(float, w.z << 16), __builtin_bit_cast(float, w.z & 0xffff0000u), __builtin_bit_cast(float, w.w << 16), __builtin_bit_cast(float, w.w & 0xffff0000u)};
                        finish(r0, r1, acc[ai][bj][m][0], acc[ai][bj][m][1], off, ss); }
                    ss += __shfl_xor(ss, 16); ss += __shfl_xor(ss, 32);
                    if (fq == 0) part[(size_t)row * 32 + u.pn * 4 + wc] = ss; }
        } else {
            f32x4 bA[4][2], bB[4][2];
#define ER_LOAD(BUF, G) _Pragma("unroll") for (int mm = 0; mm < 2; ++mm) _Pragma("unroll") for (int bj = 0; bj < 2; ++bj) { \
                const size_t off = (size_t)(row0 + ((G) >> 1) * HALF + (((G) & 1) * 2 + mm) * 16) * 2048 + colw + bj * HALF; \
                BUF[mm * 2 + bj][0] = __builtin_nontemporal_load((const f32x4*)(resf + off)); BUF[mm * 2 + bj][1] = __builtin_nontemporal_load((const f32x4*)(resf + off + 4)); }
#define ER_PROC(BUF, G) _Pragma("unroll") for (int mm = 0; mm < 2; ++mm) { const int ai = (G) >> 1, m = ((G) & 1) * 2 + mm, row = row0 + ai * HALF + m * 16; float ss = 0.f; \
                _Pragma("unroll") for (int bj = 0; bj < 2; ++bj) finish(BUF[mm * 2 + bj][0], BUF[mm * 2 + bj][1], acc[ai][bj][m][0], acc[ai][bj][m][1], (size_t)row * 2048 + colw + bj * HALF, ss); \
                ss += __shfl_xor(ss, 16); ss += __shfl_xor(ss, 32); \
                if (fq == 0) part[(size_t)row * 32 + u.pn * 4 + wc] = ss; }
            ER_LOAD(bA, 0); ER_LOAD(bB, 1);
            ER_PROC(bA, 0); ER_LOAD(bA, 2);
            ER_PROC(bB, 1); ER_LOAD(bB, 3);
            ER_PROC(bA, 2); ER_PROC(bB, 3);
#undef ER_LOAD
#undef ER_PROC
        }
    }
};
struct EpiScore {
    static constexpr bool PERM = true, AFTER_DRAIN = false, PRE = false; using PreState = NoPre;
    const PG8_LAS float* rstd; float* S;
    __device__ __forceinline__ void operator()(const f32x4 (&acc)[2][2][4][2], const Unit& u, int wr, int wc, int fr, int fq) const {
        const int row0 = u.pm * BM + wr * 64 + fr, colw = u.pn * BM + wc * 32 + 8 * fq;
#pragma unroll
        for (int ai = 0; ai < 2; ++ai)
#pragma unroll
            for (int m = 0; m < 4; ++m) { const int row = row0 + ai * HALF + m * 16; const float rs = rstd[ai * HALF + wr * 64 + m * 16 + fr];
#pragma unroll
                for (int bj = 0; bj < 2; ++bj) { const size_t off = (size_t)row * 2048 + colw + bj * HALF;
                    *(f32x4*)(S + off) = acc[ai][bj][m][0] * rs; *(f32x4*)(S + off + 4) = acc[ai][bj][m][1] * rs; } }
    }
};
struct EpiSoftmax {
    static constexpr bool PERM = true, AFTER_DRAIN = true, PRE = true; using PreState = RstdPre;
    const PG8_LAS float* rstd; bf16_t* P; int rows_per_z; const float* part;
    __device__ __forceinline__ void pre_issue(const Unit& u, int tid, RstdPre& ps) const { rstd_pre_issue(part, u.z * rows_per_z + u.pm * BM, tid, ps); }
    __device__ __forceinline__ void pre_finish(const RstdPre& ps, int tid) const { rstd_pre_finish(ps, (PG8_LAS float*)rstd, tid); }
    __device__ __forceinline__ void fused(f32x4 (&acc)[2][2][4][2], const Unit& u, int wr, int wc, int fr, int fq, PG8_LAS unsigned char* lds, int wid, int lane) const {
        PG8_LAS float* Pm = (PG8_LAS float*)lds; PG8_LAS float* Ps = (PG8_LAS float*)(lds + 4096);
        const int rl0 = wr * 64 + fr, grow0 = u.z * rows_per_z + u.pm * BM + rl0;
#pragma unroll
        for (int ai = 0; ai < 2; ++ai)
#pragma unroll
            for (int m = 0; m < 4; ++m) { const float rs = rstd[rl0 + ai * HALF + m * 16]; float mx = -INFINITY;
#pragma unroll
                for (int bj = 0; bj < 2; ++bj)
#pragma unroll
                    for (int n = 0; n < 2; ++n) { acc[ai][bj][m][n] = acc[ai][bj][m][n] * rs; const f32x4 v = acc[ai][bj][m][n]; mx = fmaxf(mx, fmaxf(fmaxf(v[0], v[1]), fmaxf(v[2], v[3]))); }
                mx = fmaxf(mx, __shfl_xor(mx, 16)); mx = fmaxf(mx, __shfl_xor(mx, 32));
                if (fq == 0) Pm[(rl0 + ai * HALF + m * 16) * 4 + wc] = mx; }
        asm volatile("s_waitcnt lgkmcnt(0)" ::: "memory"); __builtin_amdgcn_s_barrier(); asm volatile("" ::: "memory");
#pragma unroll
        for (int ai = 0; ai < 2; ++ai)
#pragma unroll
            for (int m = 0; m < 4; ++m) { const int rl = rl0 + ai * HALF + m * 16; const f32x4 q = *(const PG8_LAS f32x4*)(Pm + rl * 4);
                const float mx = fmaxf(fmaxf(q[0], q[1]), fmaxf(q[2], q[3])); float s = 0.f;
#pragma unroll
                for (int bj = 0; bj < 2; ++bj)
#pragma unroll
                    for (int n = 0; n < 2; ++n)
#pragma unroll
                        for (int e = 0; e < 4; ++e) { const float p = __builtin_amdgcn_exp2f(acc[ai][bj][m][n][e] - mx); acc[ai][bj][m][n][e] = p; s += p; }
                s += __shfl_xor(s, 16); s += __shfl_xor(s, 32);
                if (fq == 0) Ps[rl * 4 + wc] = s; }
        asm volatile("s_waitcnt lgkmcnt(0)" ::: "memory"); __builtin_amdgcn_s_barrier(); asm volatile("" ::: "memory");
#pragma unroll
        for (int ai = 0; ai < 2; ++ai)
#pragma unroll
            for (int m = 0; m < 4; ++m) { const int rl = rl0 + ai * HALF + m * 16; const f32x4 q = *(const PG8_LAS f32x4*)(Ps + rl * 4);
                const float inv = 1.0f / ((q[0] + q[1]) + (q[2] + q[3]));
#pragma unroll
                for (int bj = 0; bj < 2; ++bj) { const f32x4 v0 = acc[ai][bj][m][0] * inv, v1 = acc[ai][bj][m][1] * inv;
                    *(u32x4*)(P + (size_t)(grow0 + ai * HALF + m * 16) * 1024 + u.pn * BM + bj * HALF + wc * 32 + 8 * fq) = pk8(v0, v1); } }
        asm volatile("s_waitcnt lgkmcnt(0)" ::: "memory"); __builtin_amdgcn_s_barrier(); asm volatile("" ::: "memory");
    }
};

template <class Epi, class Sched>
__device__ __forceinline__ void gemm_phase_naive(PG8_LAS unsigned char* lds, const Gemm g, const Sched& S, const Epi& E, int wave_in) {
    const int tid = mk_tid(wave_in), wid = wave_in, lane = tid & 63, wr = wid >> 2, wc = wid & 3, fr = lane & 15, fq = lane >> 4;
    Unit cur;
    for (int ui = 0; S.next(ui, cur); ++ui) {
        f32x4 acc[2][2][4][2];
#pragma unroll
        for (int a = 0; a < 2; ++a)
#pragma unroll
            for (int b = 0; b < 2; ++b)
#pragma unroll
                for (int m = 0; m < 4; ++m)
#pragma unroll
                    for (int n = 0; n < 2; ++n) acc[a][b][m][n] = (f32x4){0.f, 0.f, 0.f, 0.f};
        if constexpr (Epi::PRE) { typename Epi::PreState ps; E.pre_issue(cur, tid, ps); E.pre_finish(ps, tid); __syncthreads(); }
        const bf16_t* At = (const bf16_t*)a_tile(g, cur); const bf16_t* Bt = (const bf16_t*)b_tile(g, cur);
        for (int k = 0; k < g.K; k += 8) {
            u32x4 a[2][4];
#pragma unroll
            for (int ai = 0; ai < 2; ++ai)
#pragma unroll
                for (int m = 0; m < 4; ++m) a[ai][m] = *(const u32x4*)(At + (size_t)(ai * HALF + wr * 64 + m * 16 + fr) * g.lda + k);
#pragma unroll
            for (int bj = 0; bj < 2; ++bj)
#pragma unroll
                for (int n = 0; n < 2; ++n)
#pragma unroll
                    for (int e = 0; e < 4; ++e) {
                        const int col = bj * HALF + wc * 32 + (Epi::PERM ? (8 * fq + 4 * n + e) : (16 * n + 4 * fq + e));
                        const u32x4 b = *(const u32x4*)(Bt + (size_t)col * g.ldb + k);
#pragma unroll
                        for (int ai = 0; ai < 2; ++ai)
#pragma unroll
                            for (int m = 0; m < 4; ++m) { float s = acc[ai][bj][m][n][e]; s = dot2bf(a[ai][m].x, b.x, s); s = dot2bf(a[ai][m].y, b.y, s); s = dot2bf(a[ai][m].z, b.z, s); s = dot2bf(a[ai][m].w, b.w, s); acc[ai][bj][m][n][e] = s; }
                    }
        }
        if constexpr (!Epi::AFTER_DRAIN) { E(acc, cur, wr, wc, fr, fq); }
        else { __syncthreads(); E.fused(acc, cur, wr, wc, fr, fq, lds, wid, lane); __syncthreads(); }
    }
}

template <class Epi, class Sched, bool ALIGN_EPI = false, bool SP2 = false>
__device__ __forceinline__ void gemm_phase(PG8_LAS unsigned char* lds, const Gemm g, const Sched& S, const Epi& E, int wave_in) {
    const int tid = mk_tid(wave_in), wid = wave_in, lane = tid & 63, wr = wid >> 2, wc = wid & 3, fr = lane & 15, fq = lane >> 4;
    const int K = g.K, nt = K / BK;
    unsigned voffA[2], voffB[2];
#pragma unroll
    for (int i = 0; i < 2; ++i) { int R, C; stage_rc(tid * 16 + i * 8192, R, C); const int Rb = Epi::PERM ? ((R & ~31) + perm32(R & 31)) : R;
        voffA[i] = (unsigned)(R * g.lda + C) * 2u; voffB[i] = (unsigned)(Rb * g.ldb + C) * 2u; }
    const size_t kstep = (size_t)(BK * 2);
    const size_t hstepA = (size_t)HALF * g.lda * 2, hstepB = (size_t)HALF * g.ldb * 2;
    const unsigned ldsw = (unsigned)wid * 1024u;
    const int aoff = lds_byte(wr * 64 + fr, fq * 8), boff = lds_byte(wc * 32 + fr, fq * 8);
#define PG8_SA(b, h) (((b) * 2 + (h)) * HTB)
#define PG8_SB(b, h) ((4 + (b) * 2 + (h)) * HTB)
#define PG8_STAGE(bufoff, gbase, voff) do { _Pragma("unroll") for (int _i = 0; _i < 2; ++_i) \
        __builtin_amdgcn_global_load_lds((const unsigned*)((const char*)(gbase) + (voff)[_i]), (PG8_LAS unsigned*)(lds + (bufoff) + ldsw + _i * 8192), 16, 0, 0); } while (0)
#define PG8_LDA(dst, b, h) do { _Pragma("unroll") for (int m = 0; m < 4; ++m) _Pragma("unroll") for (int k = 0; k < 2; ++k) dst[m][k] = *(const PG8_LAS bf16x8*)(lds + PG8_SA(b, h) + aoff + m * 2048 + k * 1024); } while (0)
#define PG8_LDB(dst, b, h) do { _Pragma("unroll") for (int n = 0; n < 2; ++n) _Pragma("unroll") for (int k = 0; k < 2; ++k) dst[n][k] = *(const PG8_LAS bf16x8*)(lds + PG8_SB(b, h) + boff + n * 2048 + k * 1024); } while (0)
#define PG8_MMA(ai, bj, At, Bt) do { __builtin_amdgcn_s_setprio(1); _Pragma("unroll") for (int m = 0; m < 4; ++m) _Pragma("unroll") for (int n = 0; n < 2; ++n) _Pragma("unroll") for (int k = 0; k < 2; ++k) \
        acc[ai][bj][m][n] = __builtin_amdgcn_mfma_f32_16x16x32_bf16(Bt[n][k], At[m][k], acc[ai][bj][m][n], 0, 0, 0); __builtin_amdgcn_s_setprio(0); } while (0)
#define PG8_WAIT_V(n) asm volatile("s_waitcnt vmcnt(" #n ")" ::: "memory")
#define PG8_WAIT_L(n) asm volatile("s_waitcnt lgkmcnt(" #n ")" ::: "memory")
#define PG8_BAR __builtin_amdgcn_s_barrier()
#define PG8_SCHED __builtin_amdgcn_sched_barrier(0)
    Unit cur, nxt; int ui = 0;
    if (!S.next(0, cur)) return;
    f32x4 acc[2][2][4][2];
#pragma unroll
    for (int a = 0; a < 2; ++a)
#pragma unroll
        for (int b = 0; b < 2; ++b)
#pragma unroll
            for (int m = 0; m < 4; ++m)
#pragma unroll
                for (int n = 0; n < 2; ++n) acc[a][b][m][n] = (f32x4){0.f, 0.f, 0.f, 0.f};
    bf16x8 At[4][2], B0[2][2], B1[2][2];
    const char* cA = a_tile(g, cur); const char* cB = b_tile(g, cur);
    S.a_ready(cur);
    typename Epi::PreState pre_state; if constexpr (Epi::PRE) E.pre_issue(cur, tid, pre_state);
    if constexpr (SP2) {
        PG8_STAGE(PG8_SB(0, 0), cB, voffB); PG8_STAGE(PG8_SB(0, 1), cB + hstepB, voffB); PG8_STAGE(PG8_SA(0, 0), cA, voffA); PG8_STAGE(PG8_SA(0, 1), cA + hstepA, voffA);
        if (wr == 1) PG8_BAR;
        PG8_WAIT_V(2); PG8_BAR;
        if constexpr (Epi::PRE) E.pre_finish(pre_state, tid);
        PG8_STAGE(PG8_SB(1, 0), cB + kstep, voffB); PG8_STAGE(PG8_SA(1, 0), cA + kstep, voffA); PG8_STAGE(PG8_SB(1, 1), cB + hstepB + kstep, voffB);
        PG8_WAIT_V(6); PG8_BAR;
    } else {
        PG8_STAGE(PG8_SB(0, 0), cB, voffB); PG8_STAGE(PG8_SA(0, 0), cA, voffA); PG8_STAGE(PG8_SB(0, 1), cB + hstepB, voffB); PG8_STAGE(PG8_SA(0, 1), cA + hstepA, voffA);
        if (wr == 1) PG8_BAR;
        PG8_WAIT_V(4); PG8_BAR;
        if constexpr (Epi::PRE) E.pre_finish(pre_state, tid);
        PG8_STAGE(PG8_SB(1, 0), cB + kstep, voffB); PG8_STAGE(PG8_SA(1, 0), cA + kstep, voffA); PG8_STAGE(PG8_SB(1, 1), cB + hstepB + kstep, voffB);
        PG8_WAIT_V(6); PG8_BAR;
    }
    for (;;) {
        const bool has_next = S.next(ui + 1, nxt);
        const char* nA = has_next ? a_tile(g, nxt) : cA; const char* nB = has_next ? b_tile(g, nxt) : cB;
        for (int t = 0; t < nt; t += 2) {
            const bool last = (t == nt - 2);
            const char* a1 = cA + (size_t)(t + 1) * kstep;
            const char* a2 = last ? nA : cA + (size_t)(t + 2) * kstep; const char* b2 = last ? nB : cB + (size_t)(t + 2) * kstep;
            const char* a3 = a2 + kstep; const char* b3 = b2 + kstep;
            if (last && has_next) S.a_ready(nxt);
            if constexpr (SP2) {
            PG8_LDB(B0, 0, 0); PG8_LDB(B1, 0, 1); PG8_SCHED; PG8_LDA(At, 0, 0); PG8_STAGE(PG8_SA(1, 1), a1 + hstepA, voffA);
            PG8_WAIT_V(8); PG8_WAIT_L(0); PG8_BAR; PG8_MMA(0, 0, At, B0); PG8_MMA(0, 1, At, B1); PG8_BAR; PG8_SCHED;
            PG8_LDA(At, 0, 1); PG8_STAGE(PG8_SB(0, 0), b2, voffB); PG8_STAGE(PG8_SB(0, 1), b2 + hstepB, voffB); PG8_STAGE(PG8_SA(0, 0), a2, voffA);
            PG8_WAIT_V(8); PG8_WAIT_L(0); PG8_BAR; PG8_MMA(1, 0, At, B0); PG8_MMA(1, 1, At, B1); PG8_BAR; PG8_SCHED;
            PG8_LDB(B0, 1, 0); PG8_LDB(B1, 1, 1); PG8_SCHED; PG8_LDA(At, 1, 0); PG8_STAGE(PG8_SA(0, 1), a2 + hstepA, voffA);
            PG8_WAIT_V(8); PG8_WAIT_L(0); PG8_BAR; PG8_MMA(0, 0, At, B0); PG8_MMA(0, 1, At, B1); PG8_BAR; PG8_SCHED;
            PG8_LDA(At, 1, 1); PG8_STAGE(PG8_SB(1, 0), b3, voffB); PG8_STAGE(PG8_SB(1, 1), b3 + hstepB, voffB); PG8_STAGE(PG8_SA(1, 0), a3, voffA);
            PG8_WAIT_V(8); PG8_WAIT_L(0); PG8_BAR; PG8_MMA(1, 0, At, B0); PG8_MMA(1, 1, At, B1); PG8_BAR; PG8_SCHED;
            } else {
            PG8_LDB(B0, 0, 0); PG8_SCHED; PG8_LDA(At, 0, 0); PG8_STAGE(PG8_SA(1, 1), a1 + hstepA, voffA);
            PG8_WAIT_L(8); PG8_BAR; PG8_WAIT_L(0); PG8_MMA(0, 0, At, B0); PG8_BAR; PG8_SCHED;
            PG8_LDB(B1, 0, 1); PG8_STAGE(PG8_SB(0, 0), b2, voffB);
            PG8_BAR; PG8_WAIT_L(0); PG8_MMA(0, 1, At, B1); PG8_BAR;
            PG8_LDA(At, 0, 1); PG8_STAGE(PG8_SA(0, 0), a2, voffA);
            PG8_BAR; PG8_WAIT_L(0); PG8_MMA(1, 0, At, B0); PG8_BAR; PG8_SCHED;
            PG8_STAGE(PG8_SB(0, 1), b2 + hstepB, voffB);
            PG8_WAIT_V(6); PG8_BAR; PG8_MMA(1, 1, At, B1); PG8_BAR;
            PG8_LDB(B0, 1, 0); PG8_SCHED; PG8_LDA(At, 1, 0); PG8_STAGE(PG8_SA(0, 1), a2 + hstepA, voffA);
            PG8_WAIT_L(8); PG8_BAR; PG8_WAIT_L(0); PG8_MMA(0, 0, At, B0); PG8_BAR; PG8_SCHED;
            PG8_LDB(B1, 1, 1); PG8_STAGE(PG8_SB(1, 0), b3, voffB);
            PG8_BAR; PG8_WAIT_L(0); PG8_MMA(0, 1, At, B1); PG8_BAR;
            PG8_LDA(At, 1, 1); PG8_STAGE(PG8_SA(1, 0), a3, voffA);
            PG8_BAR; PG8_WAIT_L(0); PG8_MMA(1, 0, At, B0); PG8_BAR; PG8_SCHED;
            PG8_STAGE(PG8_SB(1, 1), b3 + hstepB, voffB);
            PG8_WAIT_V(6); PG8_BAR; PG8_MMA(1, 1, At, B1); PG8_BAR;
            }
        }
        if constexpr (ALIGN_EPI) { if (wr == 0) PG8_BAR; }
        if constexpr (!Epi::AFTER_DRAIN) { E(acc, cur, wr, wc, fr, fq); S.done(cur); }
        if (!has_next) break;
#pragma unroll
        for (int a = 0; a < 2; ++a)
#pragma unroll
            for (int b = 0; b < 2; ++b)
#pragma unroll
                for (int m = 0; m < 4; ++m)
#pragma unroll
                    for (int n = 0; n < 2; ++n) acc[a][b][m][n] = (f32x4){0.f, 0.f, 0.f, 0.f};
        cur = nxt; cA = nA; cB = nB; ++ui;
        if constexpr (ALIGN_EPI) { if (wr == 1) PG8_BAR; }
    }
    PG8_WAIT_V(0);
    if constexpr (!ALIGN_EPI) { if (wr == 0) PG8_BAR; }
    PG8_BAR;
    if constexpr (Epi::AFTER_DRAIN) { E.fused(acc, cur, wr, wc, fr, fq, lds, wid, lane); S.done(cur); }
#undef PG8_SA
#undef PG8_SB
#undef PG8_STAGE
#undef PG8_LDA
#undef PG8_LDB
#undef PG8_MMA
#undef PG8_WAIT_V
#undef PG8_WAIT_L
#undef PG8_BAR
#undef PG8_SCHED
}
}
namespace attn_body {
using bf16=__hip_bfloat16;
using bf16x8=__attribute__((ext_vector_type(8)))short;
using s16x4=__attribute__((ext_vector_type(4)))short;
using f32x16=__attribute__((ext_vector_type(16)))float;
using u32x4=__attribute__((ext_vector_type(4)))unsigned;
constexpr int BATCH=2,NHEAD=16,SEQ=4096,D=64,DM=NHEAD*D;
constexpr int NW=8,QBLK=32,QB=QBLK*NW,KVBLK=64,NQB=SEQ/QB;
constexpr int ATTN_PITCH=DM, ATTN_UNIT_ROWS=QB;
__device__ __forceinline__ int crow(int r,int hi){return (r&3)+8*(r>>2)+4*hi;}
#define SBAR() __builtin_amdgcn_sched_barrier(0)
__device__ __forceinline__ void cmask(f32x16&p0,f32x16&p1,int jb,int qrel,int hi){
  const float NEG=-INFINITY; int kb=64*jb+4*hi;
  #pragma unroll
  for(int r=0;r<16;++r){int kv=kb+(r&3)+8*(r>>2); if(kv>qrel)p0[r]=NEG; if(kv+32>qrel)p1[r]=NEG;}
}

constexpr int NSLOT=3, SLOTB=8192;
constexpr int LDS_K=0, LDS_V=NSLOT*SLOTB, LDS_WS=2*NSLOT*SLOTB, LDS_OST=LDS_WS+NW*64*4, LDS_BYTES=LDS_OST+NW*4096;
constexpr float C2=0.125f*1.4426950408889634f;
__device__ __forceinline__ void glds16(const void*gsrc,unsigned lds_dst){unsigned keep;
  asm volatile("s_mov_b32 %0, m0\n\ts_mov_b32 m0, %2\n\ts_nop 0\n\tglobal_load_lds_dwordx4 %1, off\n\ts_mov_b32 m0, %0":"=&s"(keep):"v"(gsrc),"s"(lds_dst):"memory");}
__device__ __forceinline__ float max3f(float a,float b,float c){float r;asm("v_max3_f32 %0, %1, %2, %3":"=v"(r):"v"(a),"v"(b),"v"(c));return r;}
__device__ __forceinline__ float max2f(float a,float b){float r;asm("v_max_f32_e32 %0, %1, %2":"=v"(r):"v"(a),"v"(b));return r;}
__device__ __forceinline__ float fadd_s(float a,float b){float r;asm("v_add_f32_e32 %0, %1, %2":"=v"(r):"v"(a),"v"(b));return r;}
__device__ __forceinline__ float fsub_s(float a,float b){float r;asm("v_sub_f32_e32 %0, %1, %2":"=v"(r):"v"(a),"v"(b));return r;}
typedef float f32x2_t __attribute__((ext_vector_type(2))); typedef __bf16 bf16x2_t __attribute__((ext_vector_type(2)));
__device__ __forceinline__ unsigned cvtpk_s(float lo,float hi){f32x2_t v={lo,hi};bf16x2_t b=__builtin_convertvector(v,bf16x2_t);return __builtin_bit_cast(unsigned,b);}
#define WAIT_BAR(N) asm volatile("s_waitcnt vmcnt(" #N ") lgkmcnt(0)\n\ts_barrier":::"memory")

__device__ __forceinline__ void qkt(f32x16&p0,f32x16&p1,const char*Kslot,const bf16x8*qr,const f32x16&negm,int r32,int hi){
  const char*kb=Kslot+hi*1024+r32*16;
  #pragma unroll
  for(int d0=0;d0<4;++d0){
    const bf16x8 b0=*reinterpret_cast<const bf16x8*>(kb+d0*2048);
    const bf16x8 b1=*reinterpret_cast<const bf16x8*>(kb+d0*2048+512);
    if(d0==0){p0=__builtin_amdgcn_mfma_f32_32x32x16_bf16(b0,qr[0],negm,0,0,0);p1=__builtin_amdgcn_mfma_f32_32x32x16_bf16(b1,qr[0],negm,0,0,0);}
    else{p0=__builtin_amdgcn_mfma_f32_32x32x16_bf16(b0,qr[d0],p0,0,0,0);p1=__builtin_amdgcn_mfma_f32_32x32x16_bf16(b1,qr[d0],p1,0,0,0);}}
}
typedef __attribute__((address_space(3))) const char* lds_cptr;
typedef short v4i16_t __attribute__((ext_vector_type(4)));
__device__ __forceinline__ void kload8(bf16x8*kf,lds_cptr kp){
  kf[0]=*(const __attribute__((address_space(3))) bf16x8*)(kp);      kf[1]=*(const __attribute__((address_space(3))) bf16x8*)(kp+512);
  kf[2]=*(const __attribute__((address_space(3))) bf16x8*)(kp+2048); kf[3]=*(const __attribute__((address_space(3))) bf16x8*)(kp+2560);
  kf[4]=*(const __attribute__((address_space(3))) bf16x8*)(kp+4096); kf[5]=*(const __attribute__((address_space(3))) bf16x8*)(kp+4608);
  kf[6]=*(const __attribute__((address_space(3))) bf16x8*)(kp+6144); kf[7]=*(const __attribute__((address_space(3))) bf16x8*)(kp+6656);
}
__device__ __forceinline__ void kload2(bf16x8*kf,lds_cptr kp,int j){ kf[2*j]=*(const __attribute__((address_space(3))) bf16x8*)(kp+j*2048); kf[2*j+1]=*(const __attribute__((address_space(3))) bf16x8*)(kp+j*2048+512); }
__device__ __forceinline__ s16x4 vtr(lds_cptr p){ return __builtin_bit_cast(s16x4,__builtin_amdgcn_ds_read_tr16_b64_v4i16((__attribute__((address_space(3))) v4i16_t*)p)); }
__device__ __forceinline__ float rowmax(const f32x16&p0,const f32x16&p1){
  float a=max3f(p0[0],p0[1],p1[0]),b=max3f(p0[2],p0[3],p1[1]);a=max3f(a,p1[2],p1[3]);
  #pragma unroll
  for(int r=4;r<16;r+=4){a=max3f(a,p0[r],p0[r+1]);b=max3f(b,p0[r+2],p0[r+3]);a=max3f(a,p1[r],p1[r+1]);b=max3f(b,p1[r+2],p1[r+3]);}
  const float m=max2f(a,b);
  auto rr=__builtin_amdgcn_permlane32_swap(__float_as_uint(m),__float_as_uint(m),false,false);
  return max2f(__uint_as_float(rr[0]),__uint_as_float(rr[1]));
}
__device__ __forceinline__ void pv(f32x16*o,int vb,bf16x8 pa0,bf16x8 pa1,bf16x8 pa2,bf16x8 pa3){
  #pragma unroll
  for(int d0=0;d0<2;++d0){s16x4 lo[4],hi[4];
    #pragma unroll
    for(int ks=0;ks<4;++ks){
      asm volatile("ds_read_b64_tr_b16 %0,%1 offset:%c2":"=&v"(lo[ks]):"v"(vb),"i"(d0*4096+ks*1024):"memory");
      asm volatile("ds_read_b64_tr_b16 %0,%1 offset:%c2":"=&v"(hi[ks]):"v"(vb),"i"(d0*4096+ks*1024+512):"memory");}
    asm volatile("s_waitcnt lgkmcnt(0)":::"memory");SBAR();
    #define PK(k) (bf16x8){lo[k][0],lo[k][1],lo[k][2],lo[k][3],hi[k][0],hi[k][1],hi[k][2],hi[k][3]}
    o[d0]=__builtin_amdgcn_mfma_f32_32x32x16_bf16(pa0,PK(0),o[d0],0,0,0);
    o[d0]=__builtin_amdgcn_mfma_f32_32x32x16_bf16(pa1,PK(1),o[d0],0,0,0);
    o[d0]=__builtin_amdgcn_mfma_f32_32x32x16_bf16(pa2,PK(2),o[d0],0,0,0);
    o[d0]=__builtin_amdgcn_mfma_f32_32x32x16_bf16(pa3,PK(3),o[d0],0,0,0);
    #undef PK
  }
}

#ifndef ATTN_STORE16
#define ATTN_STORE16(p,v) (*(u32x4*)(p)=(v))
#endif
template<int THRL> __device__ __forceinline__ void attn_unit(int b,int hq,int hv,int qb,const bf16*Q,const bf16*__restrict__ K,const bf16*__restrict__ V,bf16*O,char*shm,int wave_in){
  int tid_=mk_tid(wave_in); asm volatile("":"+v"(tid_)); const int tid=tid_,lane=tid&63,r32=lane&31,hi=lane>>5; const int wid=wave_in;
  const long rowbase=(long)b*SEQ; const int q0=qb*QB;
  const bf16*Qw=Q+(rowbase+q0+wid*QBLK)*DM+hq*D;
  const bf16*Kh=K+rowbase*DM+hq*D,*Vh=V+rowbase*DM+hv*D;
  const unsigned lds0=(unsigned)(uintptr_t)shm;
  float*wsf=(float*)(shm+LDS_WS)+wid*64;
  const bf16*ksrc=Kh+(long)lane*DM+wid*8;
  const bf16*vsrc=Vh+(long)(16*(wid&3)+(lane>>2))*DM+(wid>>2)*32+(lane&3)*8;
  const unsigned kdst=lds0+LDS_K+wid*1024, vdst=lds0+LDS_V+wid*1024;
  #define DMA_K(t,slot) glds16(ksrc+(long)(t)*KVBLK*DM,(unsigned)__builtin_amdgcn_readfirstlane(kdst+(slot)))
  #define DMA_V(t,slot) glds16(vsrc+(long)(t)*KVBLK*DM,(unsigned)__builtin_amdgcn_readfirstlane(vdst+(slot)))
  const int vb0=(int)(lds0+LDS_V)+((lane>>4)&1)*32+(lane&3)*8+(4*hi+((lane&15)>>2))*64;
  const char*Kbase=shm+LDS_K; bf16x8 kf[8];
  const lds_cptr shm3=(lds_cptr)shm; const lds_cptr kp0=shm3+LDS_K+hi*1024+r32*16; const lds_cptr vp0=shm3+LDS_V+((lane>>4)&1)*32+(lane&3)*8+(4*hi+((lane&15)>>2))*64;
  const int NT=(q0+QB)/KVBLK;
  DMA_K(0,0);DMA_V(0,0);DMA_K(1,SLOTB);
  bf16x8 qr[4];
  #pragma unroll
  for(int d0=0;d0<4;++d0)qr[d0]=*reinterpret_cast<const bf16x8*>(&Qw[(long)r32*DM+d0*16+hi*8]);
  float zz_=0.f; asm volatile("":"+v"(zz_)); float mhat=0.f,l_reg=0.f;f32x16 o[2],negm;
  #pragma unroll
  for(int r=0;r<16;++r){o[0][r]=zz_;o[1][r]=zz_;negm[r]=zz_;}
  asm volatile("":"+v"(negm));
  const int qrel=wid*QBLK+r32;
  #define CMASK(P0,P1,t) do{int jb_=(t)-(NT-4); if(jb_>=0)cmask(P0,P1,jb_,qrel,hi);}while(0)
  bool resc=false;
  #define START(P0,P1) do{ const float rm=rowmax(P0,P1); resc=false; \
    { const float dl=rm; mhat=fadd_s(mhat,dl); \
      _Pragma("unroll") for(int r=0;r<16;++r){P0[r]=fsub_s(P0[r],dl);P1[r]=fsub_s(P1[r],dl);} \
      _Pragma("unroll") for(int r=0;r<16;++r)negm[r]=-mhat; asm volatile("":"+v"(negm)); } \
    _Pragma("unroll") for(int r=0;r<16;++r)P0[r]=__builtin_amdgcn_exp2f(P0[r]); }while(0)
  #define RESC() do{ if(resc){ asm volatile("s_waitcnt lgkmcnt(0)":::"memory"); \
      _Pragma("unroll") for(int d_=0;d_<2;++d_) _Pragma("unroll") for(int r=0;r<16;++r)o[d_][r]*=wsf[crow(r,hi)]; } }while(0)
  f32x16 pA0,pA1,pB0,pB1;
  int sl_prev=0,sl_cur=0,sl_next=SLOTB;
  #define ROT() do{sl_prev=sl_cur;sl_cur=sl_next;sl_next=(sl_next==(NSLOT-1)*SLOTB)?0:sl_next+SLOTB;}while(0)
  DMA_K(2,2*SLOTB);
  WAIT_BAR(3);
  qkt(pA0,pA1,Kbase,qr,negm,r32,hi);asm volatile("s_nop 15\n\ts_nop 7":"+v"(pA0),"+v"(pA1));CMASK(pA0,pA1,0);
  START(pA0,pA1);
  _Pragma("unroll") for(int r=0;r<16;++r)pA1[r]=__builtin_amdgcn_exp2f(pA1[r]);
  WAIT_BAR(0);
  DMA_K(3,0);DMA_V(1,SLOTB);
  ROT();
  kload8(kf,kp0+sl_cur);
  WAIT_BAR(2);
  s16x4 vlo[8],vhi[8]; u32x4 pw0,pw1,pw2,pw3;
  #define PKW(P,B) cvtpk_s(P[B],P[B+1])
  #define PAF(k) __builtin_bit_cast(bf16x8,pw##k)
  #define VFR(i) (bf16x8){vlo[i][0],vlo[i][1],vlo[i][2],vlo[i][3],vhi[i][0],vhi[i][1],vhi[i][2],vhi[i][3]}
  #define PIN(x) asm volatile("":"+v"(x))
  #define MX3(a,b,c) __builtin_fmaxf(__builtin_fmaxf((a),(b)),(c))
  #define GAPA(MF,A0,A1,A2,A3,W0,W1,PW) do{ MF; sacc+=A0; sacc+=A1; sacc+=A2; sacc+=A3; PIN(sacc); W0; W1; PIN(PW); SBAR(); }while(0)
  #define EX(v) __builtin_amdgcn_exp2f(v)
  #define GAPB(MF,X,B) do{ MF; X[B]=EX(X[B]); X[B+1]=EX(X[B+1]); X[B+2]=EX(X[B+2]); X[B+3]=EX(X[B+3]); PIN(X); SBAR(); }while(0)
  #define VRD(i) do{ vlo[i]=vtr(vp_+(((i)>>2)*4096+((i)&3)*1024)); vhi[i]=vtr(vp_+(((i)>>2)*4096+((i)&3)*1024+512)); }while(0)
  #define KRD(G,j) do{ if(G){ kload2(kf,kp0+sl_next,j); SBAR(); } }while(0)
  #define STEP(C0,C1,P0,P1,t,GK,GV,GL) do{ SBAR(); \
    const lds_cptr vp_=vp0+sl_prev; \
    VRD(0); SBAR(); float sacc=(P0[0]+P0[1]); \
    GAPA(C0=__builtin_amdgcn_mfma_f32_32x32x16_bf16(kf[0],qr[0],negm,0,0,0), P0[2],P0[3],P0[4],P0[5],     pw0[0]=PKW(P0,0), pw0[1]=PKW(P0,2), pw0); \
    VRD(4); SBAR(); GAPA(C1=__builtin_amdgcn_mfma_f32_32x32x16_bf16(kf[1],qr[0],negm,0,0,0), P0[6],P0[7],P0[8],P0[9],     pw0[2]=PKW(P0,4), pw0[3]=PKW(P0,6), pw0); \
    VRD(1); SBAR(); GAPA(C0=__builtin_amdgcn_mfma_f32_32x32x16_bf16(kf[2],qr[1],C0,0,0,0),   P0[10],P0[11],P0[12],P0[13], pw1[0]=PKW(P0,8), pw1[1]=PKW(P0,10), pw1); \
    VRD(5); SBAR(); GAPA(C1=__builtin_amdgcn_mfma_f32_32x32x16_bf16(kf[3],qr[1],C1,0,0,0),   P0[14],P0[15],P1[0],P1[1],   pw1[2]=PKW(P0,12),pw1[3]=PKW(P0,14), pw1); \
    VRD(2); SBAR(); GAPA(C0=__builtin_amdgcn_mfma_f32_32x32x16_bf16(kf[4],qr[2],C0,0,0,0),   P1[2],P1[3],P1[4],P1[5],     pw2[0]=PKW(P1,0), pw2[1]=PKW(P1,2), pw2); \
    VRD(6); SBAR(); GAPA(C1=__builtin_amdgcn_mfma_f32_32x32x16_bf16(kf[5],qr[2],C1,0,0,0),   P1[6],P1[7],P1[8],P1[9],     pw2[2]=PKW(P1,4), pw2[3]=PKW(P1,6), pw2); \
    VRD(3); SBAR(); GAPA(C0=__builtin_amdgcn_mfma_f32_32x32x16_bf16(kf[6],qr[3],C0,0,0,0),   P1[10],P1[11],P1[12],P1[13], pw3[0]=PKW(P1,8), pw3[1]=PKW(P1,10), pw3); \
    VRD(7); SBAR(); GAPA(C1=__builtin_amdgcn_mfma_f32_32x32x16_bf16(kf[7],qr[3],C1,0,0,0),   P1[14],P1[15],0.f,0.f,       pw3[2]=PKW(P1,12),pw3[3]=PKW(P1,14), pw3); \
    l_reg+=sacc; \
    if(GK){DMA_K((t)+3,sl_cur);} if(GV){DMA_V((t)+1,sl_next);} \
    CMASK(C0,C1,t); \
    { float a=MX3(C0[0],C0[1],C1[0]),b=MX3(C0[2],C0[3],C1[1]); a=MX3(a,C1[2],C1[3]); \
      _Pragma("unroll") for(int r=4;r<16;r+=4){a=MX3(a,C0[r],C0[r+1]);b=MX3(b,C0[r+2],C0[r+3]);a=MX3(a,C1[r],C1[r+1]);b=MX3(b,C1[r+2],C1[r+3]);} \
      float rm=__builtin_fmaxf(a,b); { auto rr=__builtin_amdgcn_permlane32_swap(__float_as_uint(rm),__float_as_uint(rm),false,false); rm=__builtin_fmaxf(__uint_as_float(rr[0]),__uint_as_float(rr[1])); } \
      resc=false; \
      if(__builtin_expect(__any(rm>(float)THRL),0)){ const float dl=__builtin_fmaxf(rm,0.f); mhat+=dl; \
        _Pragma("unroll") for(int r=0;r<16;++r){C0[r]-=dl;C1[r]-=dl;} \
        _Pragma("unroll") for(int r=0;r<16;++r)negm[r]=-mhat; asm volatile("":"+v"(negm)); \
        const float f=__builtin_amdgcn_exp2f(-dl); l_reg*=f; if(hi==0)wsf[r32]=f; resc=true; } } \
    SBAR(); \
    GAPB(o[0]=__builtin_amdgcn_mfma_f32_32x32x16_bf16(PAF(0),VFR(0),o[0],0,0,0), C0,0); \
    GAPB(o[1]=__builtin_amdgcn_mfma_f32_32x32x16_bf16(PAF(0),VFR(4),o[1],0,0,0), C0,4); \
    KRD(GL,0); GAPB(o[0]=__builtin_amdgcn_mfma_f32_32x32x16_bf16(PAF(1),VFR(1),o[0],0,0,0), C0,8); \
    KRD(GL,1); GAPB(o[1]=__builtin_amdgcn_mfma_f32_32x32x16_bf16(PAF(1),VFR(5),o[1],0,0,0), C0,12); \
    KRD(GL,2); GAPB(o[0]=__builtin_amdgcn_mfma_f32_32x32x16_bf16(PAF(2),VFR(2),o[0],0,0,0), C1,0); \
    KRD(GL,3); GAPB(o[1]=__builtin_amdgcn_mfma_f32_32x32x16_bf16(PAF(2),VFR(6),o[1],0,0,0), C1,4); \
    GAPB(o[0]=__builtin_amdgcn_mfma_f32_32x32x16_bf16(PAF(3),VFR(3),o[0],0,0,0), C1,8); \
    GAPB(o[1]=__builtin_amdgcn_mfma_f32_32x32x16_bf16(PAF(3),VFR(7),o[1],0,0,0), C1,12); \
    }while(0)
  int t=1;
  #undef CMASK
  #define CMASK(P0,P1,t) do{}while(0)
  for(;t+5<NT;t+=2){
    STEP(pB0,pB1,pA0,pA1,t,true,true,true);     WAIT_BAR(2); RESC(); ROT();
    STEP(pA0,pA1,pB0,pB1,t+1,true,true,true);   WAIT_BAR(2); RESC(); ROT();
  }
  #undef CMASK
  #define CMASK(P0,P1,t) do{int jb_=(t)-(NT-4); if(jb_>=0)cmask(P0,P1,jb_,qrel,hi);}while(0)
  #define ENDW(tt) do{ if((tt)+3<NT){WAIT_BAR(2);} else if((tt)+2<NT){WAIT_BAR(1);} else {WAIT_BAR(0);} }while(0)
  for(;t+1<NT;t+=2){
    STEP(pB0,pB1,pA0,pA1,t,(t+3<NT),(t+1<NT),(t+1<NT));       ENDW(t);   RESC(); ROT();
    STEP(pA0,pA1,pB0,pB1,t+1,(t+4<NT),(t+2<NT),(t+2<NT));     ENDW(t+1); RESC(); ROT();
  }
  STEP(pB0,pB1,pA0,pA1,NT-1,false,false,false); RESC();
  { float sacc=pB0[0]+pB0[1]; _Pragma("unroll") for(int r=2;r<16;++r)sacc+=pB0[r]; _Pragma("unroll") for(int r=0;r<16;++r)sacc+=pB1[r]; l_reg+=sacc;
    pw0=(u32x4){PKW(pB0,0),PKW(pB0,2),PKW(pB0,4),PKW(pB0,6)};pw1=(u32x4){PKW(pB0,8),PKW(pB0,10),PKW(pB0,12),PKW(pB0,14)};pw2=(u32x4){PKW(pB1,0),PKW(pB1,2),PKW(pB1,4),PKW(pB1,6)};pw3=(u32x4){PKW(pB1,8),PKW(pB1,10),PKW(pB1,12),PKW(pB1,14)};
    SBAR(); pv(o,vb0+sl_cur,PAF(0),PAF(1),PAF(2),PAF(3)); }
  #undef PKW
  #undef PAF
  #undef VFR
  #undef PIN
  #undef MX3
  #undef GAPA
  #undef GAPB
  #undef EX
  #undef VRD
  #undef KRD
  #undef STEP
  #undef ENDW
  {auto rr=__builtin_amdgcn_permlane32_swap(__float_as_uint(l_reg),__float_as_uint(l_reg),false,false);l_reg=__uint_as_float(rr[0])+__uint_as_float(rr[1]);}
  if(hi==0)wsf[32+r32]=l_reg;asm volatile("s_waitcnt lgkmcnt(0)":::"memory");
  float rli[16];
  #pragma unroll
  for(int r=0;r<16;++r)rli[r]=__builtin_amdgcn_rcpf(wsf[32+crow(r,hi)]);
  bf16*Ow=O+(rowbase+q0+wid*QBLK)*DM+hv*D;
  { bf16*stg=(bf16*)(shm+LDS_OST)+wid*2048;
    #pragma unroll
    for(int r=0;r<16;++r){const int orow=crow(r,hi);
      #pragma unroll
      for(int d0=0;d0<2;++d0)stg[orow*64+d0*32+r32]=__float2bfloat16(o[d0][r]*rli[r]);}
    asm volatile("s_waitcnt lgkmcnt(0)":::"memory");
    #pragma unroll
    for(int i=0;i<4;++i){const int row=i*8+(lane>>3),ch=lane&7; const u32x4 v=*(const u32x4*)(stg+row*64+ch*8); ATTN_STORE16(Ow+(long)row*DM+ch*8,v);} }
  asm volatile("s_waitcnt lgkmcnt(0)\n\ts_barrier":::"memory");
  #undef DMA_K
  #undef DMA_V
  #undef CMASK
  #undef START
  #undef RESC
  #undef ROT
}
constexpr int ATTN_LDS_BYTES=LDS_BYTES;
#undef SBAR
#undef WAIT_BAR
}
namespace attn128 {
using namespace attn_body;
#define SBAR() __builtin_amdgcn_sched_barrier(0)
#define WAIT_BAR(N) asm volatile("s_waitcnt vmcnt(" #N ") lgkmcnt(0)\n\ts_barrier":::"memory")
constexpr int L_K=0, L_V=3*8192, L_WS=L_V+3*16384, L_OST=0, L_BYTES=L_WS+NW*64*4;
__device__ __forceinline__ void pv4(f32x16*o,int vb,bf16x8 pa0,bf16x8 pa1,bf16x8 pa2,bf16x8 pa3){
  #pragma unroll
  for(int d0=0;d0<4;++d0){s16x4 lo[4],hi[4];
    #pragma unroll
    for(int ks=0;ks<4;++ks){
      asm volatile("ds_read_b64_tr_b16 %0,%1 offset:%c2":"=&v"(lo[ks]):"v"(vb),"i"(d0*4096+ks*1024):"memory");
      asm volatile("ds_read_b64_tr_b16 %0,%1 offset:%c2":"=&v"(hi[ks]):"v"(vb),"i"(d0*4096+ks*1024+512):"memory");}
    asm volatile("s_waitcnt lgkmcnt(0)":::"memory");SBAR();
    #define PK(k) (bf16x8){lo[k][0],lo[k][1],lo[k][2],lo[k][3],hi[k][0],hi[k][1],hi[k][2],hi[k][3]}
    o[d0]=__builtin_amdgcn_mfma_f32_32x32x16_bf16(pa0,PK(0),o[d0],0,0,0);
    o[d0]=__builtin_amdgcn_mfma_f32_32x32x16_bf16(pa1,PK(1),o[d0],0,0,0);
    o[d0]=__builtin_amdgcn_mfma_f32_32x32x16_bf16(pa2,PK(2),o[d0],0,0,0);
    o[d0]=__builtin_amdgcn_mfma_f32_32x32x16_bf16(pa3,PK(3),o[d0],0,0,0);
    #undef PK
  }
}
template<int THRL> __device__ __forceinline__ void attn_unit128(int b,int hq,int hv,int qb,const bf16*Q,const bf16*__restrict__ K,const bf16*__restrict__ V,bf16*O,char*shm,int wave_in,int cmode,unsigned*flg,bf16*MIXo,float lam,const float*subg,unsigned slow){
  int tid_=mk_tid(wave_in); asm volatile("":"+v"(tid_)); const int tid=tid_,lane=tid&63,r32=lane&31,hi=lane>>5; const int wid=wave_in;
  if(wid>=4)__builtin_amdgcn_s_setprio(1);
  const long rowbase=(long)b*SEQ; const int q0=qb*QB;
  const bf16*Qw=Q+(rowbase+q0+wid*QBLK)*DM+hq*D;
  const bf16*Kh=K+rowbase*DM+hq*D,*Vh=V+rowbase*DM+hv*128;
  const unsigned lds0=(unsigned)(uintptr_t)shm;
  float*wsf=(float*)(shm+L_WS)+wid*64;
  const bf16*ksrc=Kh+(long)lane*DM+wid*8;
  const bf16*vsrc=Vh+(long)(16*(wid&3)+(lane>>2))*DM+(wid>>2)*32+(lane&3)*8;
  const unsigned kdst=lds0+L_K+wid*1024, vdst=lds0+L_V+wid*1024;
  #define DMA_K(t,slot) glds16(ksrc+(long)(t)*KVBLK*DM,(unsigned)__builtin_amdgcn_readfirstlane(kdst+(slot)))
  #define DMA_V(t,slot) do{ glds16(vsrc+(long)(t)*KVBLK*DM,(unsigned)__builtin_amdgcn_readfirstlane(vdst+2*(slot))); glds16(vsrc+(long)(t)*KVBLK*DM+64,(unsigned)__builtin_amdgcn_readfirstlane(vdst+2*(slot)+8192)); }while(0)
  const int vb0=(int)(lds0+L_V)+((lane>>4)&1)*32+(lane&3)*8+(4*hi+((lane&15)>>2))*64;
  const char*Kbase=shm+L_K; bf16x8 kf[8];
  const lds_cptr shm3=(lds_cptr)shm; const lds_cptr kp0=shm3+L_K+hi*1024+r32*16; const lds_cptr vp0=shm3+L_V+((lane>>4)&1)*32+(lane&3)*8+(4*hi+((lane&15)>>2))*64;
  const int NT=(q0+QB)/KVBLK;
  DMA_K(0,0);DMA_V(0,0);DMA_K(1,SLOTB);
  bf16x8 qr[4];
  #pragma unroll
  for(int d0=0;d0<4;++d0)qr[d0]=*reinterpret_cast<const bf16x8*>(&Qw[(long)r32*DM+d0*16+hi*8]);
  float zz_=0.f; asm volatile("":"+v"(zz_)); float mhat=0.f,l_reg=0.f;f32x16 o[4],negm;
  #pragma unroll
  for(int r=0;r<16;++r){o[0][r]=zz_;o[1][r]=zz_;o[2][r]=zz_;o[3][r]=zz_;negm[r]=zz_;}
  asm volatile("":"+v"(negm));
  const int qrel=wid*QBLK+r32;
  #define CMASK(P0,P1,t) do{int jb_=(t)-(NT-4); if(jb_>=0)cmask(P0,P1,jb_,qrel,hi);}while(0)
  bool resc=false;
  #define START(P0,P1) do{ const float rm=rowmax(P0,P1); resc=false; \
    { const float dl=rm; mhat=fadd_s(mhat,dl); \
      _Pragma("unroll") for(int r=0;r<16;++r){P0[r]=fsub_s(P0[r],dl);P1[r]=fsub_s(P1[r],dl);} \
      _Pragma("unroll") for(int r=0;r<16;++r)negm[r]=-mhat; asm volatile("":"+v"(negm)); } \
    _Pragma("unroll") for(int r=0;r<16;++r)P0[r]=__builtin_amdgcn_exp2f(P0[r]); }while(0)
  #define RESC() do{ if(resc){ asm volatile("s_waitcnt lgkmcnt(0)":::"memory"); \
      _Pragma("unroll") for(int d_=0;d_<4;++d_) _Pragma("unroll") for(int r=0;r<16;++r)o[d_][r]*=wsf[crow(r,hi)]; } }while(0)
  f32x16 pA0,pA1,pB0,pB1;
  int sl_prev=0,sl_cur=0,sl_next=SLOTB;
  #define ROT() do{sl_prev=sl_cur;sl_cur=sl_next;sl_next=(sl_next==(NSLOT-1)*SLOTB)?0:sl_next+SLOTB;}while(0)
  DMA_K(2,2*SLOTB);
  WAIT_BAR(4);
  qkt(pA0,pA1,Kbase,qr,negm,r32,hi);asm volatile("s_nop 15\n\ts_nop 7":"+v"(pA0),"+v"(pA1));CMASK(pA0,pA1,0);
  START(pA0,pA1);
  _Pragma("unroll") for(int r=0;r<16;++r)pA1[r]=__builtin_amdgcn_exp2f(pA1[r]);
  WAIT_BAR(0);
  DMA_K(3,0);DMA_V(1,SLOTB);
  ROT();
  kload8(kf,kp0+sl_cur);
  WAIT_BAR(3);
  s16x4 vlo[8],vhi[8]; u32x4 pw0,pw1,pw2,pw3;
  #define PKW(P,B) cvtpk_s(P[B],P[B+1])
  #define PAF(k) __builtin_bit_cast(bf16x8,pw##k)
  #define VFR(i) (bf16x8){vlo[i][0],vlo[i][1],vlo[i][2],vlo[i][3],vhi[i][0],vhi[i][1],vhi[i][2],vhi[i][3]}
  #define PIN(x) asm volatile("":"+v"(x))
  #define MX3(a,b,c) __builtin_fmaxf(__builtin_fmaxf((a),(b)),(c))
  #define GAPA(MF,A0,A1,A2,A3,W0,W1,PW) do{ MF; sacc+=A0; sacc+=A1; sacc+=A2; sacc+=A3; PIN(sacc); W0; W1; PIN(PW); SBAR(); }while(0)
  #define EX(v) __builtin_amdgcn_exp2f(v)
  #define GAPB(MF,X,B) do{ MF; X[B]=EX(X[B]); X[B+1]=EX(X[B+1]); X[B+2]=EX(X[B+2]); X[B+3]=EX(X[B+3]); PIN(X); SBAR(); }while(0)
  #define VRD(i) do{ vlo[i]=vtr(vp_+(((i)>>2)*4096+((i)&3)*1024)); vhi[i]=vtr(vp_+(((i)>>2)*4096+((i)&3)*1024+512)); }while(0)
  #define VRD2(i) do{ vlo[i]=vtr(vp_+((((i)+8)>>2)*4096+((i)&3)*1024)); vhi[i]=vtr(vp_+((((i)+8)>>2)*4096+((i)&3)*1024+512)); }while(0)
  #define GAPB2(MF,X,B) do{ MF; X[B]=EX(X[B]); X[B+1]=EX(X[B+1]); PIN(X); SBAR(); }while(0)
  #define KRD(G,j) do{ if(G){ kload2(kf,kp0+sl_next,j); SBAR(); } }while(0)
  #define STEP(C0,C1,P0,P1,t,GK,GV,GL) do{ SBAR(); \
    const lds_cptr vp_=vp0+2*sl_prev; \
    VRD(0); SBAR(); float sacc=(P0[0]+P0[1]); \
    GAPA(C0=__builtin_amdgcn_mfma_f32_32x32x16_bf16(kf[0],qr[0],negm,0,0,0), P0[2],P0[3],P0[4],P0[5],     pw0[0]=PKW(P0,0), pw0[1]=PKW(P0,2), pw0); \
    VRD(4); SBAR(); GAPA(C1=__builtin_amdgcn_mfma_f32_32x32x16_bf16(kf[1],qr[0],negm,0,0,0), P0[6],P0[7],P0[8],P0[9],     pw0[2]=PKW(P0,4), pw0[3]=PKW(P0,6), pw0); \
    VRD(1); SBAR(); GAPA(C0=__builtin_amdgcn_mfma_f32_32x32x16_bf16(kf[2],qr[1],C0,0,0,0),   P0[10],P0[11],P0[12],P0[13], pw1[0]=PKW(P0,8), pw1[1]=PKW(P0,10), pw1); \
    VRD(5); SBAR(); GAPA(C1=__builtin_amdgcn_mfma_f32_32x32x16_bf16(kf[3],qr[1],C1,0,0,0),   P0[14],P0[15],P1[0],P1[1],   pw1[2]=PKW(P0,12),pw1[3]=PKW(P0,14), pw1); \
    VRD(2); SBAR(); GAPA(C0=__builtin_amdgcn_mfma_f32_32x32x16_bf16(kf[4],qr[2],C0,0,0,0),   P1[2],P1[3],P1[4],P1[5],     pw2[0]=PKW(P1,0), pw2[1]=PKW(P1,2), pw2); \
    VRD(6); SBAR(); GAPA(C1=__builtin_amdgcn_mfma_f32_32x32x16_bf16(kf[5],qr[2],C1,0,0,0),   P1[6],P1[7],P1[8],P1[9],     pw2[2]=PKW(P1,4), pw2[3]=PKW(P1,6), pw2); \
    VRD(3); SBAR(); GAPA(C0=__builtin_amdgcn_mfma_f32_32x32x16_bf16(kf[6],qr[3],C0,0,0,0),   P1[10],P1[11],P1[12],P1[13], pw3[0]=PKW(P1,8), pw3[1]=PKW(P1,10), pw3); \
    VRD(7); SBAR(); GAPA(C1=__builtin_amdgcn_mfma_f32_32x32x16_bf16(kf[7],qr[3],C1,0,0,0),   P1[14],P1[15],0.f,0.f,       pw3[2]=PKW(P1,12),pw3[3]=PKW(P1,14), pw3); \
    l_reg+=sacc; \
    if(GK){DMA_K((t)+3,sl_cur);} if(GV){DMA_V((t)+1,sl_next);} \
    CMASK(C0,C1,t); \
    { float a=MX3(C0[0],C0[1],C1[0]),b=MX3(C0[2],C0[3],C1[1]); a=MX3(a,C1[2],C1[3]); \
      _Pragma("unroll") for(int r=4;r<16;r+=4){a=MX3(a,C0[r],C0[r+1]);b=MX3(b,C0[r+2],C0[r+3]);a=MX3(a,C1[r],C1[r+1]);b=MX3(b,C1[r+2],C1[r+3]);} \
      float rm=__builtin_fmaxf(a,b); { auto rr=__builtin_amdgcn_permlane32_swap(__float_as_uint(rm),__float_as_uint(rm),false,false); rm=__builtin_fmaxf(__uint_as_float(rr[0]),__uint_as_float(rr[1])); } \
      resc=false; \
      if(__builtin_expect(__any(rm>(float)THRL),0)){ const float dl=__builtin_fmaxf(rm,0.f); mhat+=dl; \
        _Pragma("unroll") for(int r=0;r<16;++r){C0[r]-=dl;C1[r]-=dl;} \
        _Pragma("unroll") for(int r=0;r<16;++r)negm[r]=-mhat; asm volatile("":"+v"(negm)); \
        const float f=__builtin_amdgcn_exp2f(-dl); l_reg*=f; if(hi==0)wsf[r32]=f; resc=true; } } \
    SBAR(); \
    GAPB2(o[0]=__builtin_amdgcn_mfma_f32_32x32x16_bf16(PAF(0),VFR(0),o[0],0,0,0), C0,0);  VRD2(0); SBAR(); \
    GAPB2(o[1]=__builtin_amdgcn_mfma_f32_32x32x16_bf16(PAF(0),VFR(4),o[1],0,0,0), C0,2);  VRD2(4); SBAR(); \
    GAPB2(o[0]=__builtin_amdgcn_mfma_f32_32x32x16_bf16(PAF(1),VFR(1),o[0],0,0,0), C0,4);  VRD2(1); SBAR(); \
    GAPB2(o[1]=__builtin_amdgcn_mfma_f32_32x32x16_bf16(PAF(1),VFR(5),o[1],0,0,0), C0,6);  VRD2(5); SBAR(); \
    GAPB2(o[0]=__builtin_amdgcn_mfma_f32_32x32x16_bf16(PAF(2),VFR(2),o[0],0,0,0), C0,8);  VRD2(2); SBAR(); \
    GAPB2(o[1]=__builtin_amdgcn_mfma_f32_32x32x16_bf16(PAF(2),VFR(6),o[1],0,0,0), C0,10); VRD2(6); SBAR(); \
    GAPB2(o[0]=__builtin_amdgcn_mfma_f32_32x32x16_bf16(PAF(3),VFR(3),o[0],0,0,0), C0,12); VRD2(3); SBAR(); \
    GAPB2(o[1]=__builtin_amdgcn_mfma_f32_32x32x16_bf16(PAF(3),VFR(7),o[1],0,0,0), C0,14); VRD2(7); SBAR(); \
    GAPB2(o[2]=__builtin_amdgcn_mfma_f32_32x32x16_bf16(PAF(0),VFR(0),o[2],0,0,0), C1,0); \
    GAPB2(o[3]=__builtin_amdgcn_mfma_f32_32x32x16_bf16(PAF(0),VFR(4),o[3],0,0,0), C1,2); \
    KRD(GL,0); GAPB2(o[2]=__builtin_amdgcn_mfma_f32_32x32x16_bf16(PAF(1),VFR(1),o[2],0,0,0), C1,4); \
    KRD(GL,1); GAPB2(o[3]=__builtin_amdgcn_mfma_f32_32x32x16_bf16(PAF(1),VFR(5),o[3],0,0,0), C1,6); \
    KRD(GL,2); GAPB2(o[2]=__builtin_amdgcn_mfma_f32_32x32x16_bf16(PAF(2),VFR(2),o[2],0,0,0), C1,8); \
    KRD(GL,3); GAPB2(o[3]=__builtin_amdgcn_mfma_f32_32x32x16_bf16(PAF(2),VFR(6),o[3],0,0,0), C1,10); \
    GAPB2(o[2]=__builtin_amdgcn_mfma_f32_32x32x16_bf16(PAF(3),VFR(3),o[2],0,0,0), C1,12); \
    GAPB2(o[3]=__builtin_amdgcn_mfma_f32_32x32x16_bf16(PAF(3),VFR(7),o[3],0,0,0), C1,14); \
    }while(0)
  int t=1;
  #undef CMASK
  #define CMASK(P0,P1,t) do{}while(0)
  for(;t+5<NT;t+=2){
    STEP(pB0,pB1,pA0,pA1,t,true,true,true);     WAIT_BAR(3); RESC(); ROT();
    STEP(pA0,pA1,pB0,pB1,t+1,true,true,true);   WAIT_BAR(3); RESC(); ROT();
  }
  #undef CMASK
  #define CMASK(P0,P1,t) do{int jb_=(t)-(NT-4); if(jb_>=0)cmask(P0,P1,jb_,qrel,hi);}while(0)
  #define ENDW(tt) do{ if((tt)+3<NT){WAIT_BAR(3);} else if((tt)+2<NT){WAIT_BAR(2);} else {WAIT_BAR(0);} }while(0)
  for(;t+1<NT;t+=2){
    STEP(pB0,pB1,pA0,pA1,t,(t+3<NT),(t+1<NT),(t+1<NT));       ENDW(t);   RESC(); ROT();
    STEP(pA0,pA1,pB0,pB1,t+1,(t+4<NT),(t+2<NT),(t+2<NT));     ENDW(t+1); RESC(); ROT();
  }
  STEP(pB0,pB1,pA0,pA1,NT-1,false,false,false); RESC();
  { float sacc=pB0[0]+pB0[1]; _Pragma("unroll") for(int r=2;r<16;++r)sacc+=pB0[r]; _Pragma("unroll") for(int r=0;r<16;++r)sacc+=pB1[r]; l_reg+=sacc;
    pw0=(u32x4){PKW(pB0,0),PKW(pB0,2),PKW(pB0,4),PKW(pB0,6)};pw1=(u32x4){PKW(pB0,8),PKW(pB0,10),PKW(pB0,12),PKW(pB0,14)};pw2=(u32x4){PKW(pB1,0),PKW(pB1,2),PKW(pB1,4),PKW(pB1,6)};pw3=(u32x4){PKW(pB1,8),PKW(pB1,10),PKW(pB1,12),PKW(pB1,14)};
    SBAR(); pv4(o,vb0+2*sl_cur,PAF(0),PAF(1),PAF(2),PAF(3)); }
  #undef PKW
  #undef PAF
  #undef VFR
  #undef PIN
  #undef MX3
  #undef GAPA
  #undef GAPB
  #undef GAPB2
  #undef VRD2
  #undef EX
  #undef VRD
  #undef KRD
  #undef STEP
  #undef ENDW
  {auto rr=__builtin_amdgcn_permlane32_swap(__float_as_uint(l_reg),__float_as_uint(l_reg),false,false);l_reg=__uint_as_float(rr[0])+__uint_as_float(rr[1]);}
  if(hi==0)wsf[32+r32]=l_reg;asm volatile("s_waitcnt lgkmcnt(0)":::"memory");
  float rli[16];
  #pragma unroll
  for(int r=0;r<16;++r)rli[r]=__builtin_amdgcn_rcpf(wsf[32+crow(r,hi)]);
  bf16*Ow=O+(rowbase+q0+wid*QBLK)*DM+hv*128;
  asm volatile("s_waitcnt lgkmcnt(0)\n\ts_barrier":::"memory");
  { bf16*stg=(bf16*)(shm+L_OST)+wid*4096;
    #pragma unroll
    for(int r=0;r<16;++r){const int orow=crow(r,hi);
      #pragma unroll
      for(int d0=0;d0<4;++d0)stg[orow*128+d0*32+r32]=__float2bfloat16(o[d0][r]*rli[r]);}
    asm volatile("s_waitcnt lgkmcnt(0)":::"memory");
    if(cmode!=1){
      #pragma unroll
      for(int i=0;i<8;++i){const int row=i*4+(lane>>4),ch=lane&15; const u32x4 v=*(const u32x4*)(stg+row*128+ch*8); ATTN_STORE16(Ow+(long)row*DM+ch*8,v);}
    } else {
      while(__hip_atomic_load(flg,__ATOMIC_RELAXED,__HIP_MEMORY_SCOPE_AGENT)==0u)__builtin_amdgcn_s_sleep(1);
      if(slow)__builtin_amdgcn_fence(__ATOMIC_ACQUIRE,"agent");
      asm volatile("":::"memory");
      const int ch=lane&15; const float*gp=subg+ch*8; const float g0=gp[0],g1=gp[1],g2=gp[2],g3=gp[3],g4=gp[4],g5=gp[5],g6=gp[6],g7=gp[7];
      u32x4 a0[8];
      #pragma unroll
      for(int i=0;i<8;++i){const int row=i*4+(lane>>4); const bf16*ap=Ow+(long)row*DM+ch*8; asm volatile("global_load_dwordx4 %0, %1, off sc0 sc1":"=v"(a0[i]):"v"(ap):"memory");}
      asm volatile("s_waitcnt vmcnt(0)":::"memory");
      #pragma unroll
      for(int i=0;i<8;++i){const int row=i*4+(lane>>4); const u32x4 b=*(const u32x4*)(stg+row*128+ch*8); const u32x4 a=a0[i]; float d[8];
        #define LO_(w) __builtin_bit_cast(float,(w)<<16)
        #define HI_(w) __builtin_bit_cast(float,(w)&0xffff0000u)
        d[0]=LO_(a[0])-lam*LO_(b[0]); d[1]=HI_(a[0])-lam*HI_(b[0]); d[2]=LO_(a[1])-lam*LO_(b[1]); d[3]=HI_(a[1])-lam*HI_(b[1]);
        d[4]=LO_(a[2])-lam*LO_(b[2]); d[5]=HI_(a[2])-lam*HI_(b[2]); d[6]=LO_(a[3])-lam*LO_(b[3]); d[7]=HI_(a[3])-lam*HI_(b[3]);
        #undef LO_
        #undef HI_
        float ss=(d[0]*d[0]+d[1]*d[1])+(d[2]*d[2]+d[3]*d[3])+(d[4]*d[4]+d[5]*d[5])+(d[6]*d[6]+d[7]*d[7]);
        ss+=__builtin_bit_cast(float,__builtin_amdgcn_update_dpp(0,__builtin_bit_cast(int,ss),0xB1,0xF,0xF,false)); ss+=__builtin_bit_cast(float,__builtin_amdgcn_update_dpp(0,__builtin_bit_cast(int,ss),0x4E,0xF,0xF,false));
        ss+=__builtin_bit_cast(float,__builtin_amdgcn_update_dpp(0,__builtin_bit_cast(int,ss),0x124,0xF,0xF,false)); ss+=__builtin_bit_cast(float,__builtin_amdgcn_update_dpp(0,__builtin_bit_cast(int,ss),0x128,0xF,0xF,false));
        const float rs=0.8f*__builtin_amdgcn_rsqf(ss*(1.f/128.f)+1e-6f);
        u32x4 o4; o4[0]=cvtpk_s(d[0]*rs*g0,d[1]*rs*g1); o4[1]=cvtpk_s(d[2]*rs*g2,d[3]*rs*g3); o4[2]=cvtpk_s(d[4]*rs*g4,d[5]*rs*g5); o4[3]=cvtpk_s(d[6]*rs*g6,d[7]*rs*g7);
        *(u32x4*)(MIXo+((rowbase+q0+wid*QBLK+row)*2048L+1024+hv*128+ch*8))=o4; }
    } }
  asm volatile("s_waitcnt vmcnt(0) lgkmcnt(0)\n\ts_barrier":::"memory");
  if(cmode==0&&tid==0){ if(slow)__builtin_amdgcn_fence(__ATOMIC_RELEASE,"agent"); __hip_atomic_store(flg,1u,__ATOMIC_RELAXED,__HIP_MEMORY_SCOPE_AGENT); }
  __builtin_amdgcn_s_setprio(0);
  #undef DMA_K
  #undef DMA_V
  #undef CMASK
  #undef START
  #undef RESC
  #undef ROT
}
#undef SBAR
#undef WAIT_BAR
}
#define GAS __attribute__((address_space(1)))
#define LAS __attribute__((address_space(3)))
typedef unsigned short bf16;
typedef unsigned v4u __attribute__((ext_vector_type(4)));
typedef float f32x4 __attribute__((ext_vector_type(4)));
typedef short bf16x8 __attribute__((ext_vector_type(8)));
typedef GAS unsigned gu32;
typedef GAS unsigned long long gu64;
#define RLX_AGENT __ATOMIC_RELAXED, __HIP_MEMORY_SCOPE_AGENT
#define LDS_WAIT() asm volatile("s_waitcnt lgkmcnt(0)" ::: "memory")
#define VM_WAIT() asm volatile("s_waitcnt vmcnt(0)" ::: "memory")
__device__ __forceinline__ unsigned long long rt() { return __builtin_amdgcn_s_memrealtime(); }
__device__ __forceinline__ unsigned f2bf(float f) { unsigned u = __builtin_bit_cast(unsigned, f); return (u + 0x7fffu + ((u >> 16) & 1u)) >> 16; }
__device__ __forceinline__ unsigned pk2(float lo, float hi) { pg8::f32x2_t v = {lo, hi}; pg8::bf16x2_t b = __builtin_convertvector(v, pg8::bf16x2_t); return __builtin_bit_cast(unsigned, b); }

#define XB_TMO      128
#define XB_XCNT(j)  (256  + 64 * (j))
#define XB_XSUB(j)  (1280 + 64 * (j))
#define XB_XGEN(j)  (2304 + 64 * (j))
#define XB_TOP      3328
#define XB_TOPGEN   3392
#define XCD_BAR_WORDS 3456
#define XB_SPIN_CAP (1u << 18)

__device__ __forceinline__ unsigned xb_ld(unsigned* p)              { return __hip_atomic_load(p, __ATOMIC_RELAXED, __HIP_MEMORY_SCOPE_AGENT); }
__device__ __forceinline__ unsigned xb_add(unsigned* p, unsigned v) { return __hip_atomic_fetch_add(p, v, __ATOMIC_RELAXED, __HIP_MEMORY_SCOPE_AGENT); }
__device__ __forceinline__ unsigned xb_xcc_id() { return (unsigned)__builtin_amdgcn_s_getreg((3 << 11) | 20) & 0xFu; }
#define XB_SPIN(cond, bar) do { unsigned _sp = 0; while (cond) { __builtin_amdgcn_s_sleep(1); \
    if ((++_sp & 255u) == 0u) { if (xb_ld(&(bar)[XB_TMO])) break; if (_sp > XB_SPIN_CAP) { atomicAdd(&(bar)[XB_TMO], 1u); break; } } } } while (0)

struct XcdBarrier {
    unsigned* bar; unsigned x;
    volatile LAS unsigned* st;
};

__device__ __forceinline__ XcdBarrier xcd_barrier_post(unsigned* bar, volatile LAS unsigned* st, int wave_in) {
    XcdBarrier b; b.bar = bar; b.x = xb_xcc_id(); b.st = st;
    if (wave_in == 0 && mk_lane() == 0) (void)xb_add(&bar[XB_XCNT(b.x)], 1u);
    return b;
}
__device__ __forceinline__ void xcd_barrier_complete(unsigned* bar, unsigned x, unsigned& nloc, unsigned& nx) {
    const unsigned G = gridDim.x * gridDim.y * gridDim.z;
    unsigned sum, cnt, mine, sp = 0u;
    for (;;) {
        sum = 0u; cnt = 0u; mine = 0u;
#pragma unroll
        for (unsigned j = 0; j < 16; ++j) { const unsigned c = xb_ld(&bar[XB_XCNT(j)]); sum += c; cnt += (c > 0u) ? 1u : 0u; mine = (j == x) ? c : mine; }
        if (sum == G) break;
        __builtin_amdgcn_s_sleep(1);
        if ((++sp & 255u) == 0u) { if (xb_ld(&bar[XB_TMO])) break; if (sp > XB_SPIN_CAP) { atomicAdd(&bar[XB_TMO], 1u); break; } }
    }
    nloc = mine > 0u ? mine : 1u; nx = cnt > 0u ? cnt : 1u;
}

__device__ __forceinline__ void xcd_barrier(const XcdBarrier& b, int wave_in) {
    asm volatile("s_waitcnt vmcnt(0)" ::: "memory");
    __syncthreads();
    if (wave_in == 0 && mk_lane() == 0) {
        unsigned* bar = b.bar;
        __builtin_amdgcn_s_waitcnt(0);
        unsigned nloc = b.st[0], nx = b.st[1];
        if (nloc == 0u) { xcd_barrier_complete(bar, b.x, nloc, nx); b.st[0] = nloc; b.st[1] = nx; }
        const unsigned old = xb_add(&bar[XB_XSUB(b.x)], 1u);
        const unsigned gen = old / nloc;
        if (old + 1u == (gen + 1u) * nloc) {
            __builtin_amdgcn_fence(__ATOMIC_RELEASE, "agent");
            asm volatile("s_waitcnt vmcnt(0)" ::: "memory");
            const unsigned og = xb_add(&bar[XB_TOP], 1u);
            const unsigned tg = og / nx;
            if (og + 1u == (tg + 1u) * nx) xb_add(&bar[XB_TOPGEN], 1u);
            else XB_SPIN(xb_ld(&bar[XB_TOPGEN]) == tg, bar);
            __builtin_amdgcn_fence(__ATOMIC_ACQUIRE, "agent");
            xb_add(&bar[XB_XGEN(b.x)], 1u);
            asm volatile("s_waitcnt vmcnt(0)" ::: "memory");
        } else {
            XB_SPIN(xb_ld(&bar[XB_XGEN(b.x)]) == gen, bar);
            __builtin_amdgcn_fence(__ATOMIC_ACQUIRE, "agent");
            asm volatile("s_waitcnt vmcnt(0)" ::: "memory");
        }
    }
    __syncthreads();
}

constexpr int NWAVES = 8;
constexpr int DMODEL = 2048, NBATCH = 2, SEQL = 4096, NTOK = NBATCH * SEQL, MEMLEN = 256, NMEM = NBATCH * MEMLEN;
constexpr int CONVW = 1024, INW = 5120, NEXP = 16384;
constexpr float C2Q = 0.125f * 1.4426950408889634f;
constexpr float CROSS_SC = 0.044194173824159216f * 1.4426950408889634f;
constexpr float LAM_INIT = 0.2f;
constexpr float USCALE = 256.f, VSCALE = 16.f;

constexpr size_t MiB = 1u << 20;
constexpr size_t WS_CTL = 0, CTL_ZERO_BYTES = 64 * 1024;
constexpr size_t WS_PART1 = 1 * MiB, WS_PART2 = 2 * MiB;
constexpr size_t WS_ABD = 3 * MiB;
constexpr size_t WS_W1T = 4 * MiB;
constexpr size_t WS_WOUTT = 24 * MiB;
constexpr size_t WS_WCQ = 32 * MiB;
constexpr size_t WS_WCKVT = 40 * MiB;
constexpr size_t WS_WCOT = 56 * MiB;
constexpr size_t WS_WPQ = 64 * MiB;
constexpr size_t WS_MN = 72 * MiB;
constexpr size_t WS_KV = 74 * MiB;
constexpr size_t WS_WKT = 78 * MiB;
constexpr size_t WS_VWT = 86 * MiB;
constexpr size_t WS_WST = 94 * MiB;
constexpr size_t WS_ACT = 104 * MiB;
constexpr size_t WS_U = 136 * MiB, WS_Q = 152 * MiB, WS_K = 168 * MiB, WS_V = 184 * MiB;
constexpr size_t WS_O0 = 200 * MiB, WS_O1 = 216 * MiB;
constexpr size_t WS_MIX = 232 * MiB;
constexpr size_t WS_P = 264 * MiB;
constexpr size_t WS_SALL = 280 * MiB;
constexpr size_t WS_UTAB = 352 * MiB, WS_VTAB = 416 * MiB;
constexpr size_t WS_END = 480 * MiB;
constexpr int CW_BAR = 4096, CW_LOC = 8192, CW_LAB = 9216, CW_FLAG = 9280, CW_OFL = 10240;

constexpr int RING_OFF = 0, RING_BYTES = 131072;
constexpr int LDSCTL_OFF = RING_BYTES, MISC_OFF = LDSCTL_OFF + 320, RSTD_OFF = LDSCTL_OFF + 1024;
constexpr int LDS_BYTES = 147456;

template <int CTRL, int RM> __device__ __forceinline__ float dpp_mov(float old, float src) {
    return __builtin_bit_cast(float, __builtin_amdgcn_update_dpp(__builtin_bit_cast(int, old), __builtin_bit_cast(int, src), CTRL, RM, 0xF, false)); }
__device__ __forceinline__ float rdlane63(float v) { return __builtin_bit_cast(float, __builtin_amdgcn_readlane(__builtin_bit_cast(int, v), 63)); }
__device__ __forceinline__ float wave_max_u(float v) {
    v = fmaxf(v, dpp_mov<0xB1, 0xF>(v, v)); v = fmaxf(v, dpp_mov<0x4E, 0xF>(v, v)); v = fmaxf(v, dpp_mov<0x141, 0xF>(v, v)); v = fmaxf(v, dpp_mov<0x140, 0xF>(v, v));
    v = fmaxf(v, dpp_mov<0x142, 0xA>(v, v)); v = fmaxf(v, dpp_mov<0x143, 0xC>(v, v)); return rdlane63(v); }
__device__ __forceinline__ float wave_sum_u(float v) {
    v += dpp_mov<0xB1, 0xF>(0.f, v); v += dpp_mov<0x4E, 0xF>(0.f, v); v += dpp_mov<0x141, 0xF>(0.f, v); v += dpp_mov<0x140, 0xF>(0.f, v);
    v += dpp_mov<0x142, 0xA>(0.f, v); v += dpp_mov<0x143, 0xC>(0.f, v); return rdlane63(v); }
__device__ __forceinline__ float wave_sum(float v) {
#pragma unroll
    for (int o = 1; o < 64; o <<= 1) v += __shfl_xor(v, o);
    return v;
}
__device__ __forceinline__ float bflo(unsigned w) { return __builtin_bit_cast(float, w << 16); }
__device__ __forceinline__ float bfhi(unsigned w) { return __builtin_bit_cast(float, w & 0xffff0000u); }

template <int NV> __device__ __forceinline__ void wave_top16(float (&a)[NV], int lane, float& outv, int& outi) {
    outv = 0.f; outi = 0;
#pragma unroll
    for (int r = 0; r < 16; ++r) {
        float m = a[0];
#pragma unroll
        for (int q = 1; q < NV; ++q) m = fmaxf(m, a[q]);
        m = wave_max_u(m);
        int idx = -1;
#pragma unroll
        for (int q = 0; q < NV; ++q) { if (idx < 0) { const unsigned long long bl = __ballot(a[q] == m); if (bl) idx = q * 64 + (int)__builtin_ctzll(bl); } }
#pragma unroll
        for (int q = 0; q < NV; ++q) if (idx == q * 64 + lane) a[q] = -INFINITY;
        if (lane == r) { outv = m; outi = idx; }
    }
}

__device__ __forceinline__ void p0_transpose_item(const float* W, int K, int N, bf16* WT, int k0, int n0, int dst_row0, LAS float* scr, int lane, const float* gk = nullptr) {
    f32x4 ld[8];
#pragma unroll
    for (int i = 0; i < 8; ++i) ld[i] = __builtin_nontemporal_load((const GAS f32x4*)(W + (size_t)(k0 + 8 * i + (lane >> 3)) * N + n0 + 4 * (lane & 7)));
    if (gk) {
#pragma unroll
        for (int i = 0; i < 8; ++i) ld[i] = ld[i] * gk[k0 + 8 * i + (lane >> 3)]; }
#pragma unroll
    for (int i = 0; i < 8; ++i) { LAS float* d = scr + (8 * i + (lane >> 3)) * 33 + 4 * (lane & 7); d[0] = ld[i].x; d[1] = ld[i].y; d[2] = ld[i].z; d[3] = ld[i].w; }
    LDS_WAIT(); asm volatile("" ::: "memory");
    const int c = lane & 7;
#pragma unroll
    for (int j = 0; j < 4; ++j) { const int n = (lane >> 3) + 8 * j; const LAS float* s = scr + (8 * c) * 33 + n;
        v4u o; o.x = pk2(s[0 * 33], s[1 * 33]); o.y = pk2(s[2 * 33], s[3 * 33]); o.z = pk2(s[4 * 33], s[5 * 33]); o.w = pk2(s[6 * 33], s[7 * 33]);
        *(GAS v4u*)(WT + (size_t)(dst_row0 + n) * K + k0 + 8 * c) = o; }
    LDS_WAIT(); asm volatile("" ::: "memory");
}
__device__ __forceinline__ void rms_row_to_bf16(const float* xrow, const float* g, bf16* orow, int lane) {
    const GAS f32x4* xr = (const GAS f32x4*)xrow + lane; const GAS f32x4* gr = (const GAS f32x4*)g + lane;
    f32x4 v[8]; float s = 0.f;
#pragma unroll
    for (int j = 0; j < 8; ++j) v[j] = __builtin_nontemporal_load(xr + 64 * j);
    f32x4 gv[8];
#pragma unroll
    for (int j = 0; j < 8; ++j) gv[j] = gr[64 * j];
#pragma unroll
    for (int j = 0; j < 8; ++j) s += (v[j].x * v[j].x + v[j].y * v[j].y) + (v[j].z * v[j].z + v[j].w * v[j].w);
    const float rstd = 1.f / sqrtf(wave_sum(s) * (1.f / DMODEL) + 1e-6f);
    GAS unsigned long long* o8 = (GAS unsigned long long*)orow + lane;
#pragma unroll
    for (int j = 0; j < 8; ++j) { const f32x4 gg = gv[j];
        o8[64 * j] = (unsigned long long)pk2(v[j].x * rstd * gg.x, v[j].y * rstd * gg.y) | ((unsigned long long)pk2(v[j].z * rstd * gg.z, v[j].w * rstd * gg.w) << 32); }
}
__device__ __forceinline__ void row_to_bf16_rstd(const float* xrow, bf16* orow, float* rstd_out, int lane) {
    const GAS f32x4* xr = (const GAS f32x4*)xrow + lane;
    f32x4 v[8]; float s = 0.f;
#pragma unroll
    for (int j = 0; j < 8; ++j) v[j] = __builtin_nontemporal_load(xr + 64 * j);
    GAS unsigned long long* o8 = (GAS unsigned long long*)orow + lane;
#pragma unroll
    for (int j = 0; j < 8; ++j) { s += (v[j].x * v[j].x + v[j].y * v[j].y) + (v[j].z * v[j].z + v[j].w * v[j].w);
        o8[64 * j] = (unsigned long long)pk2(v[j].x, v[j].y) | ((unsigned long long)pk2(v[j].z, v[j].w) << 32); }
    const float tot = wave_sum(s);
    if (lane == 0) *rstd_out = 1.f / sqrtf(tot * (1.f / DMODEL) + 1e-6f);
}
__device__ __forceinline__ void cvt_item4(const float* src, bf16* dst, size_t item, size_t stride, size_t nitems, int lane) {
    f32x4 a[4], b[4];
#pragma unroll
    for (int q = 0; q < 4; ++q) { const size_t it = item + q * stride; if (it < nitems) { const GAS f32x4* s = (const GAS f32x4*)(src + it * 512) + 2 * lane; a[q] = __builtin_nontemporal_load(s); b[q] = __builtin_nontemporal_load(s + 1); } }
#pragma unroll
    for (int q = 0; q < 4; ++q) { const size_t it = item + q * stride; if (it < nitems) { v4u o; o.x = pk2(a[q].x, a[q].y); o.y = pk2(a[q].z, a[q].w); o.z = pk2(b[q].x, b[q].y); o.w = pk2(b[q].z, b[q].w);
        *((GAS v4u*)(dst + it * 512) + lane) = o; } }
}
template <bool ALLFLY = false> __device__ __forceinline__ void cvt8_item4(const float* src, unsigned char* dst, size_t item, size_t stride, size_t nitems, float scale, int lane) {
    f32x4 v[4][4];
    if (ALLFLY) {
#pragma unroll
        for (int q = 0; q < 4; ++q) { size_t it = item + q * stride; it = (it < nitems) ? it : item; const GAS f32x4* s = (const GAS f32x4*)(src + it * 1024) + lane;
#pragma unroll
            for (int i = 0; i < 4; ++i) v[q][i] = __builtin_nontemporal_load(s + 64 * i); }
        asm volatile("" ::: "memory");
    } else {
#pragma unroll
    for (int q = 0; q < 4; ++q) { const size_t it = item + q * stride; if (it < nitems) { const GAS f32x4* s = (const GAS f32x4*)(src + it * 1024) + lane;
#pragma unroll
        for (int i = 0; i < 4; ++i) v[q][i] = __builtin_nontemporal_load(s + 64 * i); } }
    }
#pragma unroll
    for (int q = 0; q < 4; ++q) { const size_t it = item + q * stride; if (it < nitems) { GAS unsigned* d = (GAS unsigned*)(dst + it * 1024) + lane;
#pragma unroll
        for (int i = 0; i < 4; ++i) { const f32x4 s4 = v[q][i] * scale;
            const float a = fminf(fmaxf(s4.x, -448.f), 448.f), b = fminf(fmaxf(s4.y, -448.f), 448.f), e = fminf(fmaxf(s4.z, -448.f), 448.f), f = fminf(fmaxf(s4.w, -448.f), 448.f);
            int w = __builtin_amdgcn_cvt_pk_fp8_f32(a, b, 0, false); w = __builtin_amdgcn_cvt_pk_fp8_f32(e, f, w, true); d[64 * i] = (unsigned)w; } } }
}

typedef float f32x2 __attribute__((ext_vector_type(2)));
__device__ __forceinline__ float rows_sum(float v) {
    const auto a = __builtin_amdgcn_permlane16_swap(__builtin_bit_cast(unsigned, v), __builtin_bit_cast(unsigned, v), false, false);
    const float s = __builtin_bit_cast(float, (unsigned)a[0]) + __builtin_bit_cast(float, (unsigned)a[1]);
    const auto b = __builtin_amdgcn_permlane32_swap(__builtin_bit_cast(unsigned, s), __builtin_bit_cast(unsigned, s), false, false);
    return __builtin_bit_cast(float, (unsigned)b[0]) + __builtin_bit_cast(float, (unsigned)b[1]);
}
__device__ __forceinline__ void conv_unit(const bf16* U, const float* cw, const float* cb, const float* lng, const float* lnb, bf16* MIX, int b, int t0, int tid_arg, LAS unsigned char* scr) {
    int tid = tid_arg; asm volatile("" : "+v"(tid));
    const int c0 = 2 * tid;
    {
        const int ln = tid & 63, wv = tid >> 6;
        const bf16* Uw = U + (size_t)b * SEQL * CONVW + wv * 128 + (ln & 15) * 8;
        v4u st[16];
#pragma unroll
        for (int i = 0; i < 16; ++i) { int row = 4 * i + (ln >> 4); row = row < 62 ? row : 61; const int t = t0 + row - 30; st[i] = *(const GAS v4u*)(Uw + (size_t)(t < 0 ? 0 : t) * CONVW); }
#pragma unroll
        for (int i = 0; i < 16; ++i) { const int row = 4 * i + (ln >> 4); if (row < 62) *(LAS v4u*)(scr + row * 256 + (ln & 15) * 16) = st[i]; }
        LDS_WAIT(); asm volatile("" ::: "memory");
    }
    const LAS unsigned* ulds = (const LAS unsigned*)scr + (tid & 63);
    unsigned ua[16], ub[16];
#define CV_LOAD(BUF, BASE) _Pragma("unroll") for (int q = 0; q < 16; ++q) if ((BASE) + q < 62) { BUF[q] = ulds[((BASE) + q) * 64]; }
#define CV_COMP(BUF, BASE) _Pragma("unroll") for (int q = 0; q < 16; ++q) if ((BASE) + q < 62) { const int r = (BASE) + q - 30; \
        const unsigned uq = (t0 + r < 0) ? 0u : BUF[q]; const f32x2 f = (f32x2){bflo(uq), bfhi(uq)}; \
        _Pragma("unroll") for (int tau = (r > 0 ? r : 0); tau <= (r + 30 < 31 ? r + 30 : 31); ++tau) a[tau] += w[r - tau + 30] * f; \
        _Pragma("unroll") for (int tau = (r > 0 ? r : 0); tau <= (r + 30 < 31 ? r + 30 : 31); ++tau) asm volatile("" : "+v"(a[tau])); }
    CV_LOAD(ua, 0); CV_LOAD(ub, 16);
    f32x2 w[31];
#pragma unroll
    for (int j = 0; j < 31; ++j) { const float2 ww = *(const float2*)(cw + j * CONVW + c0); w[j] = (f32x2){ww.x, ww.y}; }
    const float2 bias = *(const float2*)(cb + c0);
    f32x2 a[32];
#pragma unroll
    for (int i = 0; i < 32; ++i) a[i] = (f32x2){bias.x, bias.y};
    __builtin_amdgcn_sched_barrier(0);
    CV_COMP(ua, 0);  __builtin_amdgcn_sched_barrier(0); CV_LOAD(ua, 32); __builtin_amdgcn_sched_barrier(0);
    CV_COMP(ub, 16); __builtin_amdgcn_sched_barrier(0); CV_LOAD(ub, 48); __builtin_amdgcn_sched_barrier(0);
    CV_COMP(ua, 32); __builtin_amdgcn_sched_barrier(0);
    CV_COMP(ub, 48); __builtin_amdgcn_sched_barrier(0);
#undef CV_LOAD
#undef CV_COMP
    LDS_WAIT(); asm volatile("" ::: "memory");
    const bool odd = tid & 1, b1 = tid & 2;
    float q[16];
    {
        float r1[32];
#pragma unroll
        for (int k = 0; k < 16; ++k) {
            const float p0 = a[2 * k].x + a[2 * k].y, p1 = a[2 * k + 1].x + a[2 * k + 1].y;
            const float keep = odd ? p1 : p0, send = odd ? p0 : p1; r1[k] = keep + dpp_mov<0xB1, 0xF>(0.f, send);
        }
#pragma unroll
        for (int k = 0; k < 16; ++k) {
            const float p0 = a[2 * k].x * a[2 * k].x + a[2 * k].y * a[2 * k].y, p1 = a[2 * k + 1].x * a[2 * k + 1].x + a[2 * k + 1].y * a[2 * k + 1].y;
            const float keep = odd ? p1 : p0, send = odd ? p0 : p1; r1[16 + k] = keep + dpp_mov<0xB1, 0xF>(0.f, send);
        }
#pragma unroll
        for (int m = 0; m < 16; ++m) {
            const float keep = b1 ? r1[2 * m + 1] : r1[2 * m], send = b1 ? r1[2 * m] : r1[2 * m + 1]; float t = keep + dpp_mov<0x4E, 0xF>(0.f, send);
            t += dpp_mov<0x124, 0xF>(0.f, t); t += dpp_mov<0x128, 0xF>(0.f, t); q[m] = rows_sum(t);
        }
    }
    float mean8[8], rs8[8];
#pragma unroll
    for (int m = 0; m < 8; ++m) { const float mean = q[m] * (1.f / 128.f), var = fmaxf(q[8 + m] * (1.f / 128.f) - mean * mean, 0.f); mean8[m] = mean; rs8[m] = __builtin_amdgcn_rsqf(var + 1e-5f); }
    const float2 gg = *(const float2*)(lng + c0), bb = *(const float2*)(lnb + c0);
    bf16* Mo = MIX + ((size_t)b * SEQL + t0) * DMODEL + c0;
#pragma unroll
    for (int i = 0; i < 32; ++i) {
        const float mean = __builtin_bit_cast(float, __builtin_amdgcn_readlane(__builtin_bit_cast(int, mean8[i >> 2]), i & 3)), rs = __builtin_bit_cast(float, __builtin_amdgcn_readlane(__builtin_bit_cast(int, rs8[i >> 2]), i & 3));
        const float y0 = (a[i].x - mean) * rs * gg.x + bb.x, y1 = (a[i].y - mean) * rs * gg.y + bb.y;
        const float o0 = y0 * __builtin_amdgcn_rcpf(1.f + __builtin_amdgcn_exp2f(-1.4426950408889634f * y0)), o1 = y1 * __builtin_amdgcn_rcpf(1.f + __builtin_amdgcn_exp2f(-1.4426950408889634f * y1));
        *(unsigned*)(Mo + (size_t)i * DMODEL) = pk2(o0, o1);
    }
}

__device__ __forceinline__ void combine_rows(const bf16* O0, const bf16* O1, const float* subg, float lam, bf16* MIX, int gw, int NGW, int lane) {
    const int e0 = (lane & 15) * 8;
    const f32x4 g0 = *(const f32x4*)(subg + e0), g1 = *(const f32x4*)(subg + e0 + 4);
    for (int rr = 0; rr < NTOK / NGW; rr += 4) { const int row0 = gw * (NTOK / NGW) + rr;
        v4u xa[8], xb[8];
#pragma unroll
        for (int u = 0; u < 8; ++u) { const int row = row0 + (u >> 1), col = ((u & 1) * 4 + (lane >> 4)) * 128 + e0;
            xa[u] = __builtin_nontemporal_load((const GAS v4u*)(O0 + (size_t)row * 1024 + col)); xb[u] = __builtin_nontemporal_load((const GAS v4u*)(O1 + (size_t)row * 1024 + col)); }
#pragma unroll
        for (int u = 0; u < 8; ++u) { const int row = row0 + (u >> 1), col = ((u & 1) * 4 + (lane >> 4)) * 128 + e0;
            const v4u a = xa[u], b = xb[u];
            float d[8];
            d[0] = bflo(a.x) - lam * bflo(b.x); d[1] = bfhi(a.x) - lam * bfhi(b.x); d[2] = bflo(a.y) - lam * bflo(b.y); d[3] = bfhi(a.y) - lam * bfhi(b.y);
            d[4] = bflo(a.z) - lam * bflo(b.z); d[5] = bfhi(a.z) - lam * bfhi(b.z); d[6] = bflo(a.w) - lam * bflo(b.w); d[7] = bfhi(a.w) - lam * bfhi(b.w);
            float ss = 0.f;
#pragma unroll
            for (int i = 0; i < 8; ++i) ss += d[i] * d[i];
            ss += dpp_mov<0xB1, 0xF>(0.f, ss); ss += dpp_mov<0x4E, 0xF>(0.f, ss); ss += dpp_mov<0x124, 0xF>(0.f, ss); ss += dpp_mov<0x128, 0xF>(0.f, ss);
            const float rs = (1.f - LAM_INIT) * __builtin_amdgcn_rsqf(ss * (1.f / 128.f) + 1e-6f);
            v4u o; o.x = pk2(d[0] * rs * g0.x, d[1] * rs * g0.y); o.y = pk2(d[2] * rs * g0.z, d[3] * rs * g0.w); o.z = pk2(d[4] * rs * g1.x, d[5] * rs * g1.y); o.w = pk2(d[6] * rs * g1.z, d[7] * rs * g1.w);
            *(GAS v4u*)(MIX + (size_t)row * DMODEL + CONVW + col) = o;
        }
    }
}

#if MK_NAIVE_ATTN
__device__ __forceinline__ void attn_naive(const bf16* Q, const bf16* K, const bf16* V, bf16* O0, bf16* O1, LAS unsigned char* lds, int gw, int NGW, int wave, int lane) {
    LAS float* sc = (LAS float*)(lds + wave * 16384);
    for (int it = gw; it < NBATCH * 16 * 2 * SEQL; it += NGW) {
        const int q = it & (SEQL - 1), st = it >> 12, vh = st & 1, hq = (st >> 1) & 15, b = st >> 5, c = hq & 1, hv = (hq >> 1) * 2 + vh;
        const bf16* Qr = Q + ((size_t)b * SEQL + q) * 1024 + hq * 64;
        v4u qv[8];
#pragma unroll
        for (int i = 0; i < 8; ++i) qv[i] = *(const GAS v4u*)(Qr + 8 * i);
        float mx = -INFINITY;
        for (int j = lane; j <= q; j += 64) {
            const bf16* Kr = K + ((size_t)b * SEQL + j) * 1024 + hq * 64; float s = 0.f;
#pragma unroll
            for (int i = 0; i < 8; ++i) { const v4u kv = *(const GAS v4u*)(Kr + 8 * i);
                s = pg8::dot2bf(qv[i].x, kv.x, s); s = pg8::dot2bf(qv[i].y, kv.y, s); s = pg8::dot2bf(qv[i].z, kv.z, s); s = pg8::dot2bf(qv[i].w, kv.w, s); }
            sc[j] = s; mx = fmaxf(mx, s);
        }
#pragma unroll
        for (int o = 1; o < 64; o <<= 1) mx = fmaxf(mx, __shfl_xor(mx, o));
        float l = 0.f;
        for (int j = lane; j <= q; j += 64) { const float p = exp2f(sc[j] - mx); sc[j] = p; l += p; }
        l = wave_sum(l);
        LDS_WAIT(); asm volatile("" ::: "memory");
        const bf16* Vc = V + (size_t)b * SEQL * 1024 + hv * 64 + lane; float o = 0.f;
        for (int j = 0; j <= q; ++j) o += sc[j] * __builtin_bit_cast(float, (unsigned)Vc[(size_t)j * 1024] << 16);
        bf16* Od = (c ? O1 : O0) + ((size_t)b * SEQL + q) * 1024 + hv * 64 + lane;
        *Od = (bf16)f2bf(o / l);
        LDS_WAIT(); asm volatile("" ::: "memory");
    }
}
#endif

__device__ __forceinline__ float gelu1(float v) {
    const float av = __builtin_fabsf(v), t = __builtin_amdgcn_rcpf(av * 0.2316418882f + 1.0f);
    float q = t * 0.5307027145f + (-0.7265760135f); q = q * t + 0.7107068705f; q = q * t + (-0.142248368f); q = q * t + 0.127414796f; q = q * t;
    const float e = __builtin_amdgcn_exp2f((v * v) * (-0.72134752044f));
    const float m = v * (q * e);
    return v < 0.f ? m : v - m;
}
__device__ __forceinline__ f32x2 gelu2(f32x2 v) { return (f32x2){gelu1(v.x), gelu1(v.y)}; }
__device__ __forceinline__ void load16bf(const bf16* p, f32x2 (&o)[8]) {
    const v4u a = *(const GAS v4u*)p, b = *(const GAS v4u*)(p + 8);
    o[0] = (f32x2){bflo(a.x), bfhi(a.x)}; o[1] = (f32x2){bflo(a.y), bfhi(a.y)}; o[2] = (f32x2){bflo(a.z), bfhi(a.z)}; o[3] = (f32x2){bflo(a.w), bfhi(a.w)};
    o[4] = (f32x2){bflo(b.x), bfhi(b.x)}; o[5] = (f32x2){bflo(b.y), bfhi(b.y)}; o[6] = (f32x2){bflo(b.z), bfhi(b.z)}; o[7] = (f32x2){bflo(b.w), bfhi(b.w)};
}
struct HSet { v4u r[8]; };
__device__ __forceinline__ int set_index(int k, int lane) { return ((lane & 7) >> 1) * 128 + 2 * k + (lane & 1); }
__device__ __forceinline__ void hset_load(HSet& S, const unsigned char* TAB, const LAS int* sid, int k, int lane, int lane_off) {
    const int kv = sid[set_index(k, lane)];
#pragma unroll
    for (int e = 0; e < 8; ++e) S.r[e] = *(const GAS v4u*)(TAB + (size_t)__builtin_amdgcn_readlane(kv, e) * DMODEL + lane_off);
}
__device__ __forceinline__ float dot_h(const v4u& q, const f32x2 (&xf)[8]) {
    f32x2 p = __builtin_amdgcn_cvt_pk_f32_fp8((int)q.x, false) * xf[0], p2 = __builtin_amdgcn_cvt_pk_f32_fp8((int)q.x, true) * xf[1];
    p += __builtin_amdgcn_cvt_pk_f32_fp8((int)q.y, false) * xf[2]; p2 += __builtin_amdgcn_cvt_pk_f32_fp8((int)q.y, true) * xf[3];
    p += __builtin_amdgcn_cvt_pk_f32_fp8((int)q.z, false) * xf[4]; p2 += __builtin_amdgcn_cvt_pk_f32_fp8((int)q.z, true) * xf[5];
    p += __builtin_amdgcn_cvt_pk_f32_fp8((int)q.w, false) * xf[6]; p2 += __builtin_amdgcn_cvt_pk_f32_fp8((int)q.w, true) * xf[7];
    p += p2; return p.x + p.y;
}
__device__ __forceinline__ void acc_h(const v4u& q, f32x2 (&y)[8], float w) {
    y[0] += __builtin_amdgcn_cvt_pk_f32_fp8((int)q.x, false) * w; y[1] += __builtin_amdgcn_cvt_pk_f32_fp8((int)q.x, true) * w;
    y[2] += __builtin_amdgcn_cvt_pk_f32_fp8((int)q.y, false) * w; y[3] += __builtin_amdgcn_cvt_pk_f32_fp8((int)q.y, true) * w;
    y[4] += __builtin_amdgcn_cvt_pk_f32_fp8((int)q.z, false) * w; y[5] += __builtin_amdgcn_cvt_pk_f32_fp8((int)q.z, true) * w;
    y[6] += __builtin_amdgcn_cvt_pk_f32_fp8((int)q.w, false) * w; y[7] += __builtin_amdgcn_cvt_pk_f32_fp8((int)q.w, true) * w;
}
template <int HALF> __device__ __forceinline__ void hset_u(HSet& S, const f32x2 (&xf)[4][8], LAS float* sgt, LAS float* hpart, int k, int lane, const unsigned char* TAB, const LAS int* sid, int kn, int lane_off) {
    float pt[8];
    const int kvn = sid[set_index(kn < 0 ? k : kn, lane)];
#pragma unroll
    for (int e = 0; e < 4; ++e) pt[e] = dot_h(S.r[e], xf[e >> 1]);
    if (kn >= 0) {
#pragma unroll
        for (int e = 0; e < 4; ++e) S.r[e] = *(const GAS v4u*)(TAB + (size_t)__builtin_amdgcn_readlane(kvn, e) * DMODEL + lane_off); }
#pragma unroll
    for (int e = 4; e < 8; ++e) pt[e] = dot_h(S.r[e], xf[e >> 1]);
    if (kn >= 0) {
#pragma unroll
        for (int e = 4; e < 8; ++e) S.r[e] = *(const GAS v4u*)(TAB + (size_t)__builtin_amdgcn_readlane(kvn, e) * DMODEL + lane_off); }
    const bool odd = lane & 1, b1 = lane & 2;
    float q[4];
#pragma unroll
    for (int i = 0; i < 4; ++i) { const float keep = odd ? pt[4 + i] : pt[i], send = odd ? pt[i] : pt[4 + i]; q[i] = keep + dpp_mov<0xB1, 0xF>(0.f, send); }
    float r[2];
#pragma unroll
    for (int i = 0; i < 2; ++i) { const float keep = b1 ? q[2 + i] : q[i], send = b1 ? q[i] : q[2 + i]; r[i] = keep + dpp_mov<0x4E, 0xF>(0.f, send); }
#pragma unroll
    for (int i = 0; i < 2; ++i) { r[i] += dpp_mov<0x124, 0xF>(0.f, r[i]); r[i] += dpp_mov<0x128, 0xF>(0.f, r[i]); r[i] = rows_sum(r[i]); }
    const int idx = ((odd ? 2 : 0) + (b1 ? 1 : 0)) * 128 + 2 * k;
    if (HALF == 0) { if (lane < 4) { hpart[idx] = r[0]; hpart[idx + 1] = r[1]; } }
    else {
        const f32x2 hk = (f32x2){r[0] + hpart[idx], r[1] + hpart[idx + 1]} * (1.f / USCALE);
        const f32x2 g2 = gelu2(hk);
        if (lane < 4) { sgt[idx] = sgt[idx] * g2.x * (1.f / VSCALE); sgt[idx + 1] = sgt[idx + 1] * g2.y * (1.f / VSCALE); }
    }
}
__device__ __forceinline__ void hset_v(HSet& S, f32x2 (&y)[4][8], const LAS float* sgt, int k, int lane, const unsigned char* TAB, const LAS int* sid, int kn, int lane_off) {
    const float wv = sgt[set_index(k, lane)]; const int kvn = sid[set_index(kn < 0 ? k : kn, lane)];
#pragma unroll
    for (int e = 0; e < 4; ++e) acc_h(S.r[e], y[e >> 1], __builtin_bit_cast(float, __builtin_amdgcn_readlane(__builtin_bit_cast(int, wv), e)));
    if (kn >= 0) {
#pragma unroll
        for (int e = 0; e < 4; ++e) S.r[e] = *(const GAS v4u*)(TAB + (size_t)__builtin_amdgcn_readlane(kvn, e) * DMODEL + lane_off); }
#pragma unroll
    for (int e = 4; e < 8; ++e) acc_h(S.r[e], y[e >> 1], __builtin_bit_cast(float, __builtin_amdgcn_readlane(__builtin_bit_cast(int, wv), e)));
    if (kn >= 0) {
#pragma unroll
        for (int e = 4; e < 8; ++e) S.r[e] = *(const GAS v4u*)(TAB + (size_t)__builtin_amdgcn_readlane(kvn, e) * DMODEL + lane_off); }
}
#define RING3(LOAD, COMP) do { HSet A_, B_, C_; LOAD(A_, 0); LOAD(B_, 1); LOAD(C_, 2); \
    _Pragma("unroll 1") for (int k = 0; k < 63; k += 3) { COMP(A_, k, k + 3); COMP(B_, k + 1, (k + 4 < 64) ? k + 4 : -1); COMP(C_, k + 2, (k + 5 < 64) ? k + 5 : -1); } \
    COMP(A_, 63, -1); } while (0)
#define RING3S(LOAD, COMP) do { HSet A_, B_, C_; LOAD(A_, 0); LOAD(B_, 1); \
    _Pragma("unroll 1") for (int k = 0; k < 63; k += 3) { LOAD(C_, k + 2); COMP(A_, k, -1); LOAD(A_, k + 3); COMP(B_, k + 1, -1); if (k + 4 < 64) LOAD(B_, k + 4); COMP(C_, k + 2, -1); } \
    COMP(A_, 63, -1); } while (0)
template <int HALF> __device__ __forceinline__ void peer_u_pass(const bf16* HI, const unsigned char* UT, const float* g_peer, const float (&rs)[4], int t0,
                                                                 const LAS int* sid, LAS float* sgt, LAS float* hpart) {
    int lane = (int)__builtin_amdgcn_mbcnt_hi(~0u, __builtin_amdgcn_mbcnt_lo(~0u, 0u)); asm volatile("" : "+v"(lane));
    f32x2 xf[4][8];
#pragma unroll
    for (int j = 0; j < 4; ++j) {
        const int t = (t0 + j < NTOK) ? t0 + j : t0; load16bf(HI + (size_t)t * DMODEL + HALF * 1024 + lane * 16, xf[j]);
#pragma unroll
        for (int i = 0; i < 4; ++i) { const f32x4 g = *(const f32x4*)(g_peer + HALF * 1024 + lane * 16 + 4 * i);
            xf[j][2 * i] = xf[j][2 * i] * (f32x2){rs[j] * g.x, rs[j] * g.y}; xf[j][2 * i + 1] = xf[j][2 * i + 1] * (f32x2){rs[j] * g.z, rs[j] * g.w}; }
    }
    const int lane_off = HALF * 1024 + lane * 16;
#define PU_LOAD(S, k) hset_load(S, UT, sid, k, lane, lane_off)
#define PU_COMP(S, k, kn) hset_u<HALF>(S, xf, sgt, hpart, k, lane, UT, sid, kn, lane_off)
    RING3S(PU_LOAD, PU_COMP);
#undef PU_LOAD
#undef PU_COMP
}
template <int HALF> __device__ __forceinline__ void peer_v_pass(const bf16* HI, float* HO, const unsigned char* VT, const float* g_final, float (&ss)[4], int t0, const LAS int* sid, const LAS float* sgt, LAS unsigned char* stash) {
    int lane = (int)__builtin_amdgcn_mbcnt_hi(~0u, __builtin_amdgcn_mbcnt_lo(~0u, 0u)); asm volatile("" : "+v"(lane));
    f32x2 y[4][8];
#pragma unroll
    for (int j = 0; j < 4; ++j)
#pragma unroll
        for (int i = 0; i < 8; ++i) y[j][i] = (f32x2){0.f, 0.f};
    const int lane_off = HALF * 1024 + lane * 16;
#define PV_LOAD(S, k) hset_load(S, VT, sid, k, lane, lane_off)
#define PV_COMP(S, k, kn) hset_v(S, y, sgt, k, lane, VT, sid, kn, lane_off)
    RING3S(PV_LOAD, PV_COMP);
#undef PV_LOAD
#undef PV_COMP
#pragma unroll
    for (int j = 0; j < 4; ++j) {
        const int t = t0 + j;
        if (t < NTOK) {
            f32x2 hh[8]; load16bf(HI + (size_t)t * DMODEL + lane_off, hh); float s = 0.f;
#pragma unroll
            for (int i = 0; i < 8; ++i) { y[j][i] += hh[i]; s += y[j][i].x * y[j][i].x + y[j][i].y * y[j][i].y; }
            ss[j] += wave_sum_u(s);
            LAS v4u* st = (LAS v4u*)(stash + j * 2048 + lane * 32);
            if (HALF == 0) {
                st[0] = (v4u){pk2(y[j][0].x, y[j][0].y), pk2(y[j][1].x, y[j][1].y), pk2(y[j][2].x, y[j][2].y), pk2(y[j][3].x, y[j][3].y)};
                st[1] = (v4u){pk2(y[j][4].x, y[j][4].y), pk2(y[j][5].x, y[j][5].y), pk2(y[j][6].x, y[j][6].y), pk2(y[j][7].x, y[j][7].y)};
            } else {
                const float r3 = 1.f / sqrtf(ss[j] * (1.f / DMODEL) + 1e-6f); float* orow = HO + (size_t)t * DMODEL + lane * 16;
#pragma unroll
                for (int i = 0; i < 4; ++i) { const f32x4 g = *(const f32x4*)(g_final + 1024 + lane * 16 + 4 * i);
                    *(f32x4*)(orow + 1024 + 4 * i) = (f32x4){y[j][2 * i].x * r3 * g.x, y[j][2 * i].y * r3 * g.y, y[j][2 * i + 1].x * r3 * g.z, y[j][2 * i + 1].y * r3 * g.w}; }
                const v4u a = st[0], bq = st[1];
                const f32x4 l0 = (f32x4){bflo(a.x), bfhi(a.x), bflo(a.y), bfhi(a.y)}, l1 = (f32x4){bflo(a.z), bfhi(a.z), bflo(a.w), bfhi(a.w)};
                const f32x4 l2 = (f32x4){bflo(bq.x), bfhi(bq.x), bflo(bq.y), bfhi(bq.y)}, l3 = (f32x4){bflo(bq.z), bfhi(bq.z), bflo(bq.w), bfhi(bq.w)};
                const f32x4 g0 = *(const f32x4*)(g_final + lane * 16), g1 = *(const f32x4*)(g_final + lane * 16 + 4), g2 = *(const f32x4*)(g_final + lane * 16 + 8), g3 = *(const f32x4*)(g_final + lane * 16 + 12);
                *(f32x4*)(orow) = l0 * g0 * r3; *(f32x4*)(orow + 4) = l1 * g1 * r3; *(f32x4*)(orow + 8) = l2 * g2 * r3; *(f32x4*)(orow + 12) = l3 * g3 * r3;
            }
        }
    }
}
#ifndef MK_PEER_Q
#define MK_PEER_Q 1
#endif
__device__ __forceinline__ float half_rows_sum(float v) {
    const auto a = __builtin_amdgcn_permlane16_swap(__builtin_bit_cast(unsigned, v), __builtin_bit_cast(unsigned, v), false, false);
    return __builtin_bit_cast(float, (unsigned)a[0]) + __builtin_bit_cast(float, (unsigned)a[1]);
}
__device__ __forceinline__ void qset_load(HSet& S, const unsigned char* TAB, const LAS int* sid, int k, int hi, unsigned lane_off) {
#pragma unroll
    for (int e = 0; e < 8; ++e) { const unsigned id = (unsigned)sid[(e >> 1) * 128 + 4 * k + 2 * (e & 1) + hi]; S.r[e] = *(const GAS v4u*)(TAB + ((id << 11) + lane_off)); }
}
template <int Q> __device__ __forceinline__ void qset_u(const HSet& S, const f32x2 (&xf)[4][8], LAS float* sgt, LAS float* hpart, int k, int lane) {
    float pt[8];
#pragma unroll
    for (int e = 0; e < 8; ++e) pt[e] = dot_h(S.r[e], xf[e >> 1]);
    const bool odd = lane & 1, b1 = lane & 2;
    float q[4];
#pragma unroll
    for (int i = 0; i < 4; ++i) { const float keep = odd ? pt[4 + i] : pt[i], send = odd ? pt[i] : pt[4 + i]; q[i] = keep + dpp_mov<0xB1, 0xF>(0.f, send); }
    float r[2];
#pragma unroll
    for (int i = 0; i < 2; ++i) { const float keep = b1 ? q[2 + i] : q[i], send = b1 ? q[i] : q[2 + i]; r[i] = keep + dpp_mov<0x4E, 0xF>(0.f, send); }
#pragma unroll
    for (int i = 0; i < 2; ++i) { r[i] += dpp_mov<0x124, 0xF>(0.f, r[i]); r[i] += dpp_mov<0x128, 0xF>(0.f, r[i]); r[i] = half_rows_sum(r[i]); }
    const int idx = ((odd ? 2 : 0) + (b1 ? 1 : 0)) * 128 + 4 * k + (lane >> 5);
    const bool wr = (lane & 31) < 4;
    if (Q == 0) { if (wr) { hpart[idx] = r[0]; hpart[idx + 2] = r[1]; } }
    else if (Q < 3) { if (wr) { hpart[idx] += r[0]; hpart[idx + 2] += r[1]; } }
    else {
        const f32x2 hk = (f32x2){r[0] + hpart[idx], r[1] + hpart[idx + 2]} * (1.f / USCALE);
        const f32x2 g2 = gelu2(hk);
        if (wr) { sgt[idx] = sgt[idx] * g2.x * (1.f / VSCALE); sgt[idx + 2] = sgt[idx + 2] * g2.y * (1.f / VSCALE); }
    }
}
__device__ __forceinline__ void qset_v(const HSet& S, f32x2 (&y)[4][8], const LAS float* sgt, int k, int hi) {
#pragma unroll
    for (int e = 0; e < 8; ++e) acc_h(S.r[e], y[e >> 1], sgt[(e >> 1) * 128 + 4 * k + 2 * (e & 1) + hi]);
}
#define RINGQ(LOAD, COMP, LOADN, PRE, HASN, PROG, PSTEP, PBASE) do { HSet C_; if (!(PRE)) { LOAD(A_, 0); LOAD(B_, 1); } RSBQ_; \
    _Pragma("unroll 1") for (int k = 0; k < 30; k += 3) { { const int mine_ = (PBASE) + k; PROG[0] = mine_; if (mine_ < PROG[PSTEP]) __builtin_amdgcn_s_setprio(1); else __builtin_amdgcn_s_setprio(0); } LOAD(C_, k + 2); RSBQ_; COMP(A_, k); RSBQ_; LOAD(A_, k + 3); RSBQ_; COMP(B_, k + 1); RSBQ_; LOAD(B_, k + 4); RSBQ_; COMP(C_, k + 2); RSBQ_; } \
    COMP(A_, 30); RSBQ_; if (HASN) { LOADN(A_, 0); } RSBQ_; COMP(B_, 31); RSBQ_; if (HASN) { LOADN(B_, 1); } RSBQ_; } while (0)
#define RSBQ_ __builtin_amdgcn_sched_barrier(0)
template <int Q> __device__ __forceinline__ void peer_u_pass_q(const bf16* HI, const unsigned char* UT, const unsigned char* VT, const float* g_peer, const float (&rs)[4], int t0,
                                                               const LAS int* sid, LAS float* sgt, LAS float* hpart, HSet& A_, HSet& B_, volatile LAS int* prog, int pstep) {
    int lane = (int)__builtin_amdgcn_mbcnt_hi(~0u, __builtin_amdgcn_mbcnt_lo(~0u, 0u)); asm volatile("" : "+v"(lane));
    const int hi = lane >> 5, col0 = Q * 512 + (lane & 31) * 16;
    f32x2 xf[4][8];
#pragma unroll
    for (int j = 0; j < 4; ++j) {
        const int t = (t0 + j < NTOK) ? t0 + j : t0; load16bf(HI + (size_t)t * DMODEL + col0, xf[j]);
#pragma unroll
        for (int i = 0; i < 4; ++i) { const f32x4 g = *(const f32x4*)(g_peer + col0 + 4 * i);
            xf[j][2 * i] = xf[j][2 * i] * (f32x2){rs[j] * g.x, rs[j] * g.y}; xf[j][2 * i + 1] = xf[j][2 * i + 1] * (f32x2){rs[j] * g.z, rs[j] * g.w}; }
    }
    const unsigned lane_off = (unsigned)col0;
    const unsigned next_off = (unsigned)(((Q + 1) & 3) * 512 + (lane & 31) * 16);
#define PUQ_LOAD(S, k) qset_load(S, UT, sid, k, hi, lane_off)
#define PUQ_LOADN(S, k) qset_load(S, (Q < 3) ? UT : VT, sid, k, hi, next_off)
#define PUQ_COMP(S, k) qset_u<Q>(S, xf, sgt, hpart, k, lane)
    RINGQ(PUQ_LOAD, PUQ_COMP, PUQ_LOADN, Q > 0, true, prog, pstep, Q * 32);
#undef PUQ_LOAD
#undef PUQ_LOADN
#undef PUQ_COMP
}
template <int Q> __device__ __forceinline__ void peer_v_pass_q(const bf16* HI, float* HO, const unsigned char* VT, const float* g_final, float (&ss)[4], int t0, const LAS int* sid, const LAS float* sgt, LAS unsigned char* stash, HSet& A_, HSet& B_, volatile LAS int* prog, int pstep) {
    int lane = (int)__builtin_amdgcn_mbcnt_hi(~0u, __builtin_amdgcn_mbcnt_lo(~0u, 0u)); asm volatile("" : "+v"(lane));
    const int hi = lane >> 5, l32 = lane & 31, col0 = Q * 512 + l32 * 16;
    f32x2 y[4][8];
#pragma unroll
    for (int j = 0; j < 4; ++j)
#pragma unroll
        for (int i = 0; i < 8; ++i) y[j][i] = (f32x2){0.f, 0.f};
    const unsigned lane_off = (unsigned)col0;
    const unsigned next_off = (unsigned)(((Q + 1) & 3) * 512 + l32 * 16);
#define PVQ_LOAD(S, k) qset_load(S, VT, sid, k, hi, lane_off)
#define PVQ_LOADN(S, k) qset_load(S, VT, sid, k, hi, next_off)
#define PVQ_COMP(S, k) qset_v(S, y, sgt, k, hi)
    RINGQ(PVQ_LOAD, PVQ_COMP, PVQ_LOADN, true, Q < 3, prog, pstep, (4 + Q) * 32);
#undef PVQ_LOAD
#undef PVQ_LOADN
#undef PVQ_COMP
#pragma unroll
    for (int j = 0; j < 4; ++j)
#pragma unroll
        for (int i = 0; i < 8; ++i) {
            const float yx = y[j][i].x, yy = y[j][i].y;
            const unsigned ux = __builtin_bit_cast(unsigned, yx), uy = __builtin_bit_cast(unsigned, yy);
            const auto ax = __builtin_amdgcn_permlane32_swap(ux, ux, false, false);
            const auto ay = __builtin_amdgcn_permlane32_swap(uy, uy, false, false);
            y[j][i] = (f32x2){__builtin_bit_cast(float, (unsigned)ax[0]) + __builtin_bit_cast(float, (unsigned)ax[1]), __builtin_bit_cast(float, (unsigned)ay[0]) + __builtin_bit_cast(float, (unsigned)ay[1])}; }
    v4u hw[4][2];
#pragma unroll
    for (int j = 0; j < 4; ++j) { const int t = (t0 + j < NTOK) ? t0 + j : t0; const bf16* p = HI + (size_t)t * DMODEL + col0; hw[j][0] = *(const GAS v4u*)p; hw[j][1] = *(const GAS v4u*)(p + 8); }
    f32x4 gf[4][4];
    if (Q == 3) {
#pragma unroll
        for (int qq = 0; qq < 4; ++qq)
#pragma unroll
            for (int i = 0; i < 4; ++i) gf[qq][i] = *(const f32x4*)(g_final + qq * 512 + l32 * 16 + 4 * i);
    }
#pragma unroll
    for (int j = 0; j < 4; ++j) {
        const int t = t0 + j; const bool act = (hi == (j >> 1)) && (t < NTOK);
        f32x2 hh[8]; float s = 0.f;
        { const v4u a = hw[j][0], bq = hw[j][1];
          hh[0] = (f32x2){bflo(a.x), bfhi(a.x)}; hh[1] = (f32x2){bflo(a.y), bfhi(a.y)}; hh[2] = (f32x2){bflo(a.z), bfhi(a.z)}; hh[3] = (f32x2){bflo(a.w), bfhi(a.w)};
          hh[4] = (f32x2){bflo(bq.x), bfhi(bq.x)}; hh[5] = (f32x2){bflo(bq.y), bfhi(bq.y)}; hh[6] = (f32x2){bflo(bq.z), bfhi(bq.z)}; hh[7] = (f32x2){bflo(bq.w), bfhi(bq.w)}; }
#pragma unroll
        for (int i = 0; i < 8; ++i) { y[j][i] += hh[i]; s += y[j][i].x * y[j][i].x + y[j][i].y * y[j][i].y; }
        ss[j] += wave_sum_u(act ? s : 0.f);
        if (act) {
            if (Q < 3) {
                LAS v4u* st = (LAS v4u*)(stash + (j * 3 + Q) * 1024 + l32 * 32);
                st[0] = (v4u){pk2(y[j][0].x, y[j][0].y), pk2(y[j][1].x, y[j][1].y), pk2(y[j][2].x, y[j][2].y), pk2(y[j][3].x, y[j][3].y)};
                st[1] = (v4u){pk2(y[j][4].x, y[j][4].y), pk2(y[j][5].x, y[j][5].y), pk2(y[j][6].x, y[j][6].y), pk2(y[j][7].x, y[j][7].y)};
            } else {
                const float r3 = 1.f / sqrtf(ss[j] * (1.f / DMODEL) + 1e-6f); float* orow = HO + (size_t)t * DMODEL + l32 * 16;
#pragma unroll
                for (int i = 0; i < 4; ++i) { const f32x4 g = gf[3][i];
                    *(f32x4*)(orow + 1536 + 4 * i) = (f32x4){y[j][2 * i].x * r3 * g.x, y[j][2 * i].y * r3 * g.y, y[j][2 * i + 1].x * r3 * g.z, y[j][2 * i + 1].y * r3 * g.w}; }
#pragma unroll
                for (int qq = 0; qq < 3; ++qq) { const LAS v4u* st = (const LAS v4u*)(stash + (j * 3 + qq) * 1024 + l32 * 32); const v4u a = st[0], bq = st[1];
                    const f32x4 l0 = (f32x4){bflo(a.x), bfhi(a.x), bflo(a.y), bfhi(a.y)}, l1 = (f32x4){bflo(a.z), bfhi(a.z), bflo(a.w), bfhi(a.w)};
                    const f32x4 l2 = (f32x4){bflo(bq.x), bfhi(bq.x), bflo(bq.y), bfhi(bq.y)}, l3 = (f32x4){bflo(bq.z), bfhi(bq.z), bflo(bq.w), bfhi(bq.w)};
                    float* oq = orow + qq * 512;
                    *(f32x4*)(oq) = l0 * gf[qq][0] * r3; *(f32x4*)(oq + 4) = l1 * gf[qq][1] * r3; *(f32x4*)(oq + 8) = l2 * gf[qq][2] * r3; *(f32x4*)(oq + 12) = l3 * gf[qq][3] * r3; }
            }
        }
    }
}
__device__ __forceinline__ void top16_insert(float (&tv)[16], int (&ti)[16], float x, int px) {
    bool c_hi = x > tv[15];
#pragma unroll
    for (int r = 15; r >= 1; --r) { const bool c_lo = x > tv[r - 1]; ti[r] = c_lo ? ti[r - 1] : (c_hi ? px : ti[r]); tv[r] = __builtin_amdgcn_fmed3f(tv[r - 1], tv[r], x); c_hi = c_lo; }
    ti[0] = c_hi ? px : ti[0]; tv[0] = fmaxf(tv[0], x);
}
__device__ __forceinline__ void route_stage2(const float (&tv)[16], const int (&ti)[16], bool half, bool valid, int (&oid)[8], float (&ogt)[8]) {
    float av[16], bv[16]; int ai[16], bi[16];
#pragma unroll
    for (int r = 0; r < 16; ++r) {
        const float pv = dpp_mov<0xB1, 0xF>(tv[r], tv[r]); const int pi = __builtin_amdgcn_update_dpp(ti[r], ti[r], 0xB1, 0xF, 0xF, false);
        av[r] = half ? pv : tv[r]; bv[r] = half ? tv[r] : pv; ai[r] = half ? pi : ti[r]; bi[r] = half ? ti[r] : pi;
    }
    float cv[16]; int ci[16];
    {
        const float a0 = half ? av[1] : av[0]; const int i0 = (half ? ai[1] : ai[0]) << 7;
#pragma unroll
        for (int r = 0; r < 16; ++r) { const float s0 = a0 + bv[r]; cv[r] = (r >= 8 && half) ? -INFINITY : s0; ci[r] = i0 | bi[r]; }
    }
#define CAND(IA, JA, IB, JB) do { const float aS = half ? av[IB] : av[IA], bS = half ? bv[JB] : bv[JA]; const int aI = half ? ai[IB] : ai[IA], bI = half ? bi[JB] : bi[JA]; \
        top16_insert(cv, ci, aS + bS, (aI << 7) | bI); } while (0)
    CAND(2, 0, 3, 0); CAND(2, 1, 3, 1); CAND(2, 2, 3, 2); CAND(2, 3, 3, 3); CAND(2, 4, 7, 0); CAND(4, 0, 7, 1); CAND(4, 1, 9, 0); CAND(4, 2, 10, 0);
    CAND(5, 0, 11, 0); CAND(5, 1, 12, 0); CAND(6, 0, 13, 0); CAND(6, 1, 14, 0); CAND(8, 0, 15, 0);
#undef CAND
    float mv[16]; int mi[16];
#pragma unroll
    for (int r = 0; r < 16; ++r) {
        const float pv = dpp_mov<0xB1, 0xF>(cv[15 - r], cv[15 - r]); const int pi = __builtin_amdgcn_update_dpp(ci[15 - r], ci[15 - r], 0xB1, 0xF, 0xF, false);
        const bool own = cv[r] >= pv; mv[r] = own ? cv[r] : pv; mi[r] = own ? ci[r] : pi;
    }
    const float mx = fmaxf(mv[0], mv[15]);
    float ev[16];
#pragma unroll
    for (int r = 0; r < 16; ++r) ev[r] = __expf(mv[r] - mx);
    const float es = (((ev[0] + ev[15]) + (ev[7] + ev[8])) + ((ev[1] + ev[14]) + (ev[6] + ev[9]))) + (((ev[2] + ev[13]) + (ev[5] + ev[10])) + ((ev[3] + ev[12]) + (ev[4] + ev[11])));
    const float inv = valid ? 1.f / es : 0.f;
#pragma unroll
    for (int r = 0; r < 8; ++r) { oid[r] = mi[r]; ogt[r] = ev[r] * inv; }
}
__device__ __forceinline__ void route4(const float* SALL, int t0, LAS int* ids, LAS float* gts, int lane) {
    const int j = lane >> 4, tj = (t0 + j < NTOK) ? t0 + j : t0;
    const float* sp = SALL + (size_t)tj * 2048 + (lane & 15) * 128;
    float tk[16];
#pragma unroll
    for (int r = 0; r < 16; ++r) tk[r] = -INFINITY;
#pragma unroll 1
    for (int mo = 0; mo < 4; ++mo) {
        f32x4 ln[8];
#pragma unroll
        for (int q = 0; q < 8; ++q) ln[q] = *(const f32x4*)(sp + 32 * mo + 4 * q);
#pragma unroll
        for (int q = 0; q < 8; ++q)
#pragma unroll
            for (int e = 0; e < 4; ++e) {
                const int idx = 32 * mo + 4 * q + e; const float xe = ln[q][e]; const unsigned xb = __builtin_bit_cast(unsigned, xe);
                const float key = __builtin_bit_cast(float, (xb & ~127u) | (unsigned)((xb >> 31) ? idx : 127 - idx));
#pragma unroll
                for (int r = 15; r >= 1; --r) tk[r] = __builtin_amdgcn_fmed3f(tk[r - 1], tk[r], key);
                tk[0] = fmaxf(tk[0], key);
            }
    }
    float tv[16]; int ti[16];
#pragma unroll
    for (int r = 0; r < 16; ++r) { const unsigned kb = __builtin_bit_cast(unsigned, tk[r]); const int lo = (int)(kb & 127u); ti[r] = (kb >> 31) ? lo : 127 - lo; tv[r] = sp[ti[r]]; }
    int oid[8]; float ogt[8];
    route_stage2(tv, ti, lane & 1, t0 + j < NTOK, oid, ogt);
    {
        const int o = j * 128 + ((lane >> 1) & 7) * 16 + ((lane & 1) ? 8 : 0);
#pragma unroll
        for (int r = 0; r < 8; ++r) { ids[o + r] = oid[r]; gts[o + r] = ogt[r]; }
    }
}

#ifndef MK_ROUTE_FUSED
#define MK_ROUTE_FUSED 1
#endif
struct EpiRoute {
    static constexpr bool PERM = true, AFTER_DRAIN = true, PRE = true; using PreState = pg8::RstdPre;
    const LAS float* rstd; int* PID; float* PGT; const float* part;
    __device__ __forceinline__ void pre_issue(const pg8::Unit& u, int tid, pg8::RstdPre& ps) const { pg8::rstd_pre_issue(part, u.pm * 256, tid, ps); }
    __device__ __forceinline__ void pre_finish(const pg8::RstdPre& ps, int tid) const { pg8::rstd_pre_finish(ps, (LAS float*)rstd, tid); }
    __device__ __forceinline__ void operator()(const pg8::f32x4 (&)[2][2][4][2], const pg8::Unit&, int, int, int, int) const {}
    __device__ __forceinline__ void fused(pg8::f32x4 (&acc)[2][2][4][2], const pg8::Unit& u, int wr, int wc, int fr, int fq, LAS unsigned char* lds, int wid, int lane_arg) const {
        LAS float* S = (LAS float*)lds;
        int lane = lane_arg; asm volatile("" : "+v"(lane));
        const int tl = (lane >> 1) & 15, hf = lane & 1, sub = lane >> 5, swz = tl * 4;
        const LAS float* base = S + (wid * 16 + tl) * 256;
        float fv[16]; int fi[16];
#pragma unroll
        for (int r = 0; r < 16; ++r) { fv[r] = 0.f; fi[r] = 0; }
#pragma unroll
        for (int pass = 0; pass < 2; ++pass) {
#pragma unroll
            for (int m = 0; m < 4; ++m) { const int tau = wr * 64 + m * 16 + fr; const float rs = rstd[pass * 128 + tau]; LAS float* d = S + tau * 256;
#pragma unroll
                for (int bj = 0; bj < 2; ++bj) { const int c0 = bj * 128 + wc * 32 + fq * 8;
                    *(LAS pg8::f32x4*)(d + (c0 ^ (fr * 4))) = acc[pass][bj][m][0] * rs; *(LAS pg8::f32x4*)(d + ((c0 + 4) ^ (fr * 4))) = acc[pass][bj][m][1] * rs; } }
            asm volatile("s_waitcnt lgkmcnt(0)" ::: "memory"); __builtin_amdgcn_s_barrier(); asm volatile("" ::: "memory");
            float tk[16];
#pragma unroll
            for (int r = 0; r < 16; ++r) tk[r] = -INFINITY;
#pragma unroll
            for (int i = 0; i < 16; ++i) { const pg8::f32x4 v = *(const LAS pg8::f32x4*)(base + ((hf * 128 + sub * 64 + 4 * i) ^ swz));
#pragma unroll
                for (int e = 0; e < 4; ++e) { const int k = 4 * i + e; const float xe = v[e]; const unsigned xb = __builtin_bit_cast(unsigned, xe);
                    const float key = __builtin_bit_cast(float, (xb & ~127u) | (unsigned)((xb >> 31) ? k : 127 - k));
#pragma unroll
                    for (int r = 15; r >= 1; --r) tk[r] = __builtin_amdgcn_fmed3f(tk[r - 1], tk[r], key);
                    tk[0] = fmaxf(tk[0], key); } }
            const unsigned x6 = sub ? 64u : 0u;
#pragma unroll
            for (int r = 0; r < 16; ++r) tk[r] = __builtin_bit_cast(float, __builtin_bit_cast(unsigned, tk[r]) ^ x6);
            float mk[16];
#pragma unroll
            for (int r = 0; r < 16; ++r) { const unsigned w = __builtin_bit_cast(unsigned, tk[15 - r]); const auto sw = __builtin_amdgcn_permlane32_swap(w, w, false, false);
                const float pr = __builtin_bit_cast(float, sub ? (unsigned)sw[0] : (unsigned)sw[1]); mk[r] = fmaxf(tk[r], pr); }
#pragma unroll
            for (int d = 8; d >= 1; d >>= 1)
#pragma unroll
                for (int i = 0; i < 16; ++i) if ((i & d) == 0) { const float hi = fmaxf(mk[i], mk[i + d]), lo = fminf(mk[i], mk[i + d]); mk[i] = hi; mk[i + d] = lo; }
#pragma unroll
            for (int r = 0; r < 16; ++r) { const unsigned kb = __builtin_bit_cast(unsigned, mk[r]); const int lo = (int)(kb & 127u), idx = (kb >> 31) ? lo : 127 - lo;
                const float val = base[(hf * 128 + idx) ^ swz];
                fv[r] = (sub == pass) ? val : fv[r]; fi[r] = (sub == pass) ? idx : fi[r]; }
            asm volatile("s_waitcnt lgkmcnt(0)" ::: "memory"); __builtin_amdgcn_s_barrier(); asm volatile("" ::: "memory");
        }
        int oid[8]; float ogt[8];
        route_stage2(fv, fi, hf, true, oid, ogt);
        const size_t o = (size_t)(u.pm * 256 + sub * 128 + wid * 16 + tl) * 128 + u.pn * 16 + (hf ? 8 : 0);
        *(GAS v4u*)(PID + o) = (v4u){(unsigned)oid[0], (unsigned)oid[1], (unsigned)oid[2], (unsigned)oid[3]}; *(GAS v4u*)(PID + o + 4) = (v4u){(unsigned)oid[4], (unsigned)oid[5], (unsigned)oid[6], (unsigned)oid[7]};
        *(GAS f32x4*)(PGT + o) = (f32x4){ogt[0], ogt[1], ogt[2], ogt[3]}; *(GAS f32x4*)(PGT + o + 4) = (f32x4){ogt[4], ogt[5], ogt[6], ogt[7]};
    }
};
__device__ __forceinline__ void peer_phase(const bf16* HI, float* HO, const float* SALL, const unsigned char* UT, const unsigned char* VT, const float* g_peer, const float* g_final,
                                           LAS unsigned char* lds, int gw, int NGW, int wave, int lane_arg) {
    LAS unsigned char* wl = lds + wave * 16384;
    LAS int* sid = (LAS int*)wl; LAS float* sgt = (LAS float*)(wl + 2048); LAS float* hpart = (LAS float*)(wl + 4096);
    LAS unsigned* cnt = (LAS unsigned*)(wl + 6144); LAS unsigned* bbase = cnt + 128;
    for (int t0 = gw * 4; t0 < NTOK; t0 += NGW * 4) {
        int lane = (int)__builtin_amdgcn_mbcnt_hi(~0u, __builtin_amdgcn_mbcnt_lo(~0u, 0u)); asm volatile("" : "+v"(lane));
#if MK_ROUTE_FUSED
        {
            const int* PIDr = (const int*)SALL; const float* PGTr = SALL + (size_t)NTOK * 128;
#pragma unroll
            for (int j = 0; j < 4; ++j) { const int t = (t0 + j < NTOK) ? t0 + j : t0;
#pragma unroll
                for (int i = 0; i < 2; ++i) { sid[j * 128 + 64 * i + lane] = PIDr[(size_t)t * 128 + 64 * i + lane]; sgt[j * 128 + 64 * i + lane] = (t0 + j < NTOK) ? PGTr[(size_t)t * 128 + 64 * i + lane] : 0.f; } }
        }
#else
        route4(SALL, t0, sid, sgt, lane);
#endif
        LDS_WAIT(); asm volatile("" ::: "memory");
#pragma unroll 1
        for (int j = 0; j < 4; ++j) {
            LAS int* ids = sid + j * 128; LAS float* gts = sgt + j * 128;
            cnt[lane] = 0u; cnt[64 + lane] = 0u;
            asm volatile("" ::: "memory");
            int key[2]; float gt[2]; unsigned slot[2];
#pragma unroll
            for (int i = 0; i < 2; ++i) { key[i] = ids[lane + 64 * i]; gt[i] = gts[lane + 64 * i]; }
#pragma unroll
            for (int i = 0; i < 2; ++i) slot[i] = __hip_atomic_fetch_add(cnt + (key[i] >> 7), 1u, __ATOMIC_RELAXED, __HIP_MEMORY_SCOPE_WORKGROUP);
            asm volatile("" ::: "memory");
            const unsigned c0 = cnt[2 * lane], c1 = cnt[2 * lane + 1]; unsigned s = c0 + c1;
            int ln = lane; asm volatile("" : "+v"(ln));
#pragma unroll
            for (int d = 1; d < 64; d <<= 1) { const unsigned tt = (unsigned)__builtin_amdgcn_ds_bpermute(((ln >= d) ? ln - d : ln) * 4, (int)s); if (ln >= d) s += tt; }
            bbase[2 * lane] = s - c0 - c1; bbase[2 * lane + 1] = s - c1;
            asm volatile("" ::: "memory");
#pragma unroll
            for (int i = 0; i < 2; ++i) { const unsigned pos = bbase[key[i] >> 7] + slot[i]; ids[pos] = key[i]; gts[pos] = gt[i]; }
            LDS_WAIT(); asm volatile("" ::: "memory");
        }
        float rs[4];
#pragma unroll
        for (int j = 0; j < 4; ++j) {
            const int t = (t0 + j < NTOK) ? t0 + j : t0; float ss = 0.f;
#pragma unroll
            for (int i = 0; i < 2; ++i) { f32x2 hh[8]; load16bf(HI + (size_t)t * DMODEL + i * 1024 + lane * 16, hh);
#pragma unroll
                for (int k = 0; k < 8; ++k) ss += hh[k].x * hh[k].x + hh[k].y * hh[k].y; }
            rs[j] = 1.f / sqrtf(wave_sum_u(ss) * (1.f / DMODEL) + 1e-6f);
        }
#if MK_PEER_Q
#define PQ_SYNC() do { LDS_WAIT(); asm volatile("" ::: "memory"); } while (0)
        HSet RA, RB;
        volatile LAS int* prog = (volatile LAS int*)(lds + RSTD_OFF) + wave; const int pstep = (wave < 4) ? 4 : -4; prog[0] = 0;
        peer_u_pass_q<0>(HI, UT, VT, g_peer, rs, t0, sid, sgt, hpart, RA, RB, prog, pstep); PQ_SYNC();
        peer_u_pass_q<1>(HI, UT, VT, g_peer, rs, t0, sid, sgt, hpart, RA, RB, prog, pstep); PQ_SYNC();
        peer_u_pass_q<2>(HI, UT, VT, g_peer, rs, t0, sid, sgt, hpart, RA, RB, prog, pstep); PQ_SYNC();
        peer_u_pass_q<3>(HI, UT, VT, g_peer, rs, t0, sid, sgt, hpart, RA, RB, prog, pstep); PQ_SYNC();
        float ss3[4] = {0.f, 0.f, 0.f, 0.f};
        peer_v_pass_q<0>(HI, HO, VT, g_final, ss3, t0, sid, sgt, wl + 4096, RA, RB, prog, pstep); PQ_SYNC();
        peer_v_pass_q<1>(HI, HO, VT, g_final, ss3, t0, sid, sgt, wl + 4096, RA, RB, prog, pstep); PQ_SYNC();
        peer_v_pass_q<2>(HI, HO, VT, g_final, ss3, t0, sid, sgt, wl + 4096, RA, RB, prog, pstep); PQ_SYNC();
        peer_v_pass_q<3>(HI, HO, VT, g_final, ss3, t0, sid, sgt, wl + 4096, RA, RB, prog, pstep);
        __builtin_amdgcn_s_setprio(0);
        LDS_WAIT(); asm volatile("" ::: "memory");
#undef PQ_SYNC
#else
        peer_u_pass<0>(HI, UT, g_peer, rs, t0, sid, sgt, hpart);
        LDS_WAIT(); asm volatile("" ::: "memory"); __builtin_amdgcn_s_barrier();
        peer_u_pass<1>(HI, UT, g_peer, rs, t0, sid, sgt, hpart);
        LDS_WAIT(); asm volatile("" ::: "memory"); __builtin_amdgcn_s_barrier();
        float ss3[4] = {0.f, 0.f, 0.f, 0.f};
        peer_v_pass<0>(HI, HO, VT, g_final, ss3, t0, sid, sgt, wl + 8192);
        LDS_WAIT(); asm volatile("" ::: "memory"); __builtin_amdgcn_s_barrier();
        peer_v_pass<1>(HI, HO, VT, g_final, ss3, t0, sid, sgt, wl + 8192);
        LDS_WAIT(); asm volatile("" ::: "memory");
#endif
    }
}

__device__ __forceinline__ void tile_rstd(const float* part, int row0, LAS float* tab, int tid) {
    const int r = tid >> 1, hf = tid & 1; const f32x4* p = (const f32x4*)(part + (size_t)(row0 + r) * 32 + hf * 16); float s = 0.f;
#pragma unroll
    for (int i = 0; i < 4; ++i) { const f32x4 v = p[i]; s += (v[0] + v[1]) + (v[2] + v[3]); }
    s += __shfl_xor(s, 1);
    if (hf == 0) tab[r] = 1.0f / sqrtf(s * (1.0f / 2048.0f) + 1e-6f);
    __syncthreads();
}

__device__ __forceinline__ void xcc_local_barrier(unsigned* bar, unsigned* cnt, unsigned target, int wave_in) {
    asm volatile("s_waitcnt vmcnt(0)" ::: "memory");
    __syncthreads();
    if (wave_in == 0 && mk_lane() == 0) {
        __builtin_amdgcn_s_waitcnt(0);
        (void)xb_add(cnt, 1u);
        XB_SPIN(xb_ld(cnt) < target, bar);
        __builtin_amdgcn_fence(__ATOMIC_ACQUIRE, "agent");
        asm volatile("s_waitcnt vmcnt(0)" ::: "memory");
    }
    __syncthreads();
}

struct Args { const float* in[26]; float* out; unsigned char* ws; int ph_lo, ph_hi; };
constexpr int N_PHASES = 9;
constexpr int C_T = NEXP * (DMODEL / 1024);

#if MK_NAIVE_GEMM
#define RUN_GEMM(EPI, ALIGN, g, S, E) pg8::gemm_phase_naive<EPI, pg8::TileOrder>(ldsp, g, S, E, wave)
#else
#define RUN_GEMM(EPI, ALIGN, g, S, E) pg8::gemm_phase<EPI, pg8::TileOrder, ALIGN, true>(ldsp, g, S, E, wave)
#endif

__global__ void __launch_bounds__(NWAVES * 64, 2) mk_fwd(Args args) {
    extern __shared__ __attribute__((aligned(16))) unsigned char lds[];
    LAS unsigned char* ldsp = (LAS unsigned char*)lds;
    volatile LAS unsigned* MISC = (volatile LAS unsigned*)(ldsp + MISC_OFF);
    const int wave = __builtin_amdgcn_readfirstlane((int)threadIdx.x >> 6);
#define tid mk_tid(wave)
#define lane mk_lane()
    const int G = gridDim.x, bid = blockIdx.x;
    const int vcu = (G % 8 == 0) ? (bid % 8) * (G / 8) + bid / 8 : bid;
    const int gw = vcu * NWAVES + wave, NGW = G * NWAVES;
    unsigned char* ws = args.ws;
    gu32* ctl = (gu32*)(ws + WS_CTL);
    const float* x = args.in[0]; const float* mem = args.in[1]; const float* norm_mix_g = args.in[2]; const float* w_in = args.in[3];
    const float* conv_w = args.in[4]; const float* conv_b = args.in[5]; const float* conv_ln_g = args.in[6]; const float* conv_ln_b = args.in[7];
    const float* lq1 = args.in[8]; const float* lk1 = args.in[9]; const float* lq2 = args.in[10]; const float* lk2 = args.in[11]; const float* subln_g = args.in[12];
    const float* w_out = args.in[13]; const float* norm_cross_g = args.in[14]; const float* norm_mem_g = args.in[15];
    const float* w_cq = args.in[16]; const float* w_ckv = args.in[17]; const float* w_co = args.in[18]; const float* norm_peer_g = args.in[19]; const float* w_pq = args.in[20];
    const float* keys1 = args.in[21]; const float* keys2 = args.in[22]; const float* peer_u = args.in[23]; const float* peer_v = args.in[24]; const float* final_g = args.in[25];
    float* out = args.out;
    float* PART1 = (float*)(ws + WS_PART1); float* PART2 = (float*)(ws + WS_PART2); float* RSTD0 = (float*)(ws + 512 * 1024);
    bf16* ABD = (bf16*)(ws + WS_ABD); bf16* W1T = (bf16*)(ws + WS_W1T); bf16* WOUTT = (bf16*)(ws + WS_WOUTT); bf16* WCQ = (bf16*)(ws + WS_WCQ); bf16* WCKVT = (bf16*)(ws + WS_WCKVT);
    bf16* WCOT = (bf16*)(ws + WS_WCOT); bf16* WPQ = (bf16*)(ws + WS_WPQ); bf16* MN = (bf16*)(ws + WS_MN); bf16* KV = (bf16*)(ws + WS_KV); bf16* WKT = (bf16*)(ws + WS_WKT);
    bf16* VWT = (bf16*)(ws + WS_VWT); bf16* WST = (bf16*)(ws + WS_WST); bf16* ACT = (bf16*)(ws + WS_ACT); bf16* UB = (bf16*)(ws + WS_U); bf16* QB = (bf16*)(ws + WS_Q);
    bf16* KB = (bf16*)(ws + WS_K); bf16* VB = (bf16*)(ws + WS_V); bf16* O0 = (bf16*)(ws + WS_O0); bf16* O1 = (bf16*)(ws + WS_O1); bf16* MIX = (bf16*)(ws + WS_MIX);
    bf16* PB = (bf16*)(ws + WS_P); float* SALL = (float*)(ws + WS_SALL); unsigned char* UTAB = ws + WS_UTAB; unsigned char* VTAB = ws + WS_VTAB;

    for (int u = tid; u < (LDS_BYTES - LDSCTL_OFF) / 4; u += NWAVES * 64) ((LAS unsigned*)(ldsp + LDSCTL_OFF))[u] = 0u;
    __syncthreads();
    const int lo = args.ph_lo, hi = args.ph_hi;
    const bool one_launch = (hi - lo) > 1;
    XcdBarrier bar; bar.bar = (unsigned*)(ctl + CW_BAR); bar.x = 0; bar.st = nullptr;
    if (one_launch) bar = xcd_barrier_post((unsigned*)(ctl + CW_BAR), MISC + 8, wave);
#define IN(k) (lo <= (k) && (k) < hi)
#if MK_LAUNCH_PER_PHASE
#define REP(k)
#else
#define REP(k) for (int rep_ = 0; rep_ < 1 + ((MK_REPEAT_MASK >> (k)) & 1); ++rep_)
#endif
#define SEAM(k) do { if (IN(k) && IN((k) + 1)) xcd_barrier(bar, wave); } while (0)
    if (one_launch && tid == 0) {
        const unsigned mine = bar.x + 1u, old = atomicCAS((unsigned*)(ctl + CW_LAB + (bid & 7)), 0u, mine);
        if ((old != 0u && old != mine) || G != 256) atomicOr((unsigned*)(ctl + CW_FLAG), 1u);
    }
    unsigned loc_epoch = 0u;
#define SEAM_XCC(k) do { if (IN(k) && IN((k) + 1)) { \
        if (__hip_atomic_load((unsigned*)(ctl + CW_FLAG), __ATOMIC_RELAXED, __HIP_MEMORY_SCOPE_AGENT) == 0u) { ++xcc_epoch; xcc_local_barrier(bar.bar, (unsigned*)(ctl + CW_LOC + 512 + 16 * (bid & 7)), xcc_epoch * 32u, wave); } \
        else xcd_barrier(bar, wave); } } while (0)
    unsigned xcc_epoch = 0u;
#define SEAM_LOCAL(k) do { if (IN(k) && IN((k) + 1)) { \
        if (__hip_atomic_load((unsigned*)(ctl + CW_FLAG), __ATOMIC_RELAXED, __HIP_MEMORY_SCOPE_AGENT) == 0u) { ++loc_epoch; xcc_local_barrier(bar.bar, (unsigned*)(ctl + CW_LOC + 16 * ((bid & 7) * 4 + ((bid >> 3) & 3))), loc_epoch * 8u, wave); } \
        else xcd_barrier(bar, wave); } } while (0)

    if (IN(0)) REP(0) {
        LAS float* scr = (LAS float*)(ldsp + RING_OFF + wave * 16384);
        constexpr int I_IN = 32 * (INW / 32), I_CKV = 32 * (2 * DMODEL / 32);
        LAS unsigned* q0 = (LAS unsigned*)(ldsp + MISC_OFF) + 16;
        for (;;) {
            unsigned qi = 0u; if (lane == 0) qi = __hip_atomic_fetch_add(q0, 1u, __ATOMIC_RELAXED, __HIP_MEMORY_SCOPE_WORKGROUP);
            qi = (unsigned)__builtin_amdgcn_readfirstlane((int)qi);
            const int it = vcu * NWAVES + (int)(qi & 7u) + (int)(qi >> 3) * NGW;
            if (it >= I_IN + I_CKV + NTOK + NMEM) break;
            int r = it;
            if (r < I_IN) { const int nblk = INW / 32, kb = r / nblk, nb = r % nblk, n0 = 32 * nb;
                const int dst = (n0 < 2048) ? (((n0 & 1023) >> 7) * 256 + (n0 >> 10) * 128 + (n0 & 127)) : n0;
                p0_transpose_item(w_in, DMODEL, INW, W1T, 64 * kb, n0, dst, scr, lane, norm_mix_g); continue; } r -= I_IN;
            if (r < I_CKV) { const int nblk = 2 * DMODEL / 32; p0_transpose_item(w_ckv, DMODEL, 2 * DMODEL, WCKVT, 64 * (r / nblk), 32 * (r % nblk), 32 * (r % nblk), scr, lane); continue; } r -= I_CKV;
            if (r < NTOK) row_to_bf16_rstd(x + (size_t)r * DMODEL, ACT + (size_t)r * DMODEL, RSTD0 + r, lane);
            else rms_row_to_bf16(mem + (size_t)(r - NTOK) * DMODEL, norm_mem_g, MN + (size_t)(r - NTOK) * DMODEL, lane);
        }
        constexpr int C_W = DMODEL * DMODEL / 512;
        for (int it = gw; it < C_W; it += 4 * NGW) cvt_item4(w_pq, WPQ, it, NGW, C_W, lane);
        for (int it = gw; it < 8 * 256 * 256 / 512; it += NGW) {
            const int e0 = it * 512 + lane * 8, h = e0 >> 16, m = (e0 >> 8) & 255, k = e0 & 255;
            v4u o = (v4u){0u, 0u, 0u, 0u};
            const float* src = nullptr;
            if (m < 128 && k < 128) src = keys1 + ((size_t)h * 128 + m) * 128 + k;
            else if (m >= 128 && k >= 128) src = keys2 + ((size_t)h * 128 + (m - 128)) * 128 + (k - 128);
            if (src) { const f32x4 a = *(const f32x4*)src, b = *(const f32x4*)(src + 4); o.x = pk2(a.x, a.y); o.y = pk2(a.z, a.w); o.z = pk2(b.x, b.y); o.w = pk2(b.z, b.w); }
            *(GAS v4u*)(ABD + e0) = o;
        }
    }
    SEAM(0);

    if (IN(1)) REP(1) {
        { pg8::Gemm g{ACT, W1T, DMODEL, DMODEL, DMODEL, 1, 0, 0, 0, 0}; pg8::TileOrder S; S.init(NTOK / 256, INW / 256, 1, G, bid);
          pg8::EpiZ E{UB, QB, (long)((WS_K - WS_Q) / 2), C2Q, RSTD0}; RUN_GEMM(pg8::EpiZ, true, g, S, E); }
        { pg8::Gemm g{MN, WCKVT, DMODEL, DMODEL, DMODEL, 1, 0, 0, 0, 0}; pg8::TileOrder S; S.init(NMEM / 256, 2 * DMODEL / 256, 1, G, (bid + G - 128) % G);
          pg8::EpiBf16S E{KV, 2 * DMODEL, 1, 0, 0, nullptr, 1.f}; RUN_GEMM(pg8::EpiBf16S, true, g, S, E); }
        if (bid >= 160) { const int nw = (G - 160) * NWAVES, w0 = (bid - 160) * NWAVES + wave;
            for (int it = w0; it < C_T / 2; it += 4 * nw) cvt8_item4(peer_u, UTAB, it, nw, C_T / 2, USCALE, lane);
            LAS float* scr = (LAS float*)(ldsp + RING_OFF + wave * 16384); constexpr int I_SQ = 32 * (DMODEL / 32), nblk = DMODEL / 32;
            for (int it = w0; it < 2 * I_SQ; it += nw) { const int r = it % I_SQ;
                p0_transpose_item(it < I_SQ ? w_out : w_co, DMODEL, DMODEL, it < I_SQ ? WOUTT : WCOT, 64 * (r / nblk), 32 * (r % nblk), 32 * (r % nblk), scr, lane); }
            constexpr int C_W = DMODEL * DMODEL / 512;
            for (int it = w0; it < C_W; it += 4 * nw) cvt_item4(w_cq, WCQ, it, nw, C_W, lane); }
    }
    SEAM(1);

    if (IN(2)) REP(2) {
#if MK_NAIVE_ATTN
        attn_naive(QB, KB, VB, O0, O1, ldsp, gw, NGW, wave, lane);
#else
#if MK_ATTN128
        const float lam = expf(wave_sum(lq1[lane] * lk1[lane])) - expf(wave_sum(lq2[lane] * lk2[lane])) + LAM_INIT;
        const unsigned slow = one_launch ? __hip_atomic_load((unsigned*)(ctl + CW_FLAG), __ATOMIC_RELAXED, __HIP_MEMORY_SCOPE_AGENT) : 1u;
        for (int idx = vcu; idx < 256; idx += G) {
            const int st = idx >> 3, s = idx & 7, hq = st & 15, b = st >> 4, h = hq >> 1;
#pragma unroll 1
            for (int i = 0; i < 2; ++i) { const int qb = (i == 0) ? 15 - s : s, hqi = hq ^ i;
                attn128::attn_unit128<8>(b, hqi, h, qb, (const attn_body::bf16*)QB, (const attn_body::bf16*)KB, (const attn_body::bf16*)VB, (attn_body::bf16*)O0, (char*)lds, wave,
                                         hqi & 1, (unsigned*)(ctl + CW_OFL + 16 * (((b * 8 + h) * 16) + qb)), (attn_body::bf16*)MIX, lam, subln_g, slow); }
        }
#else
        for (int idx = vcu; idx < 256; idx += G) {
            const int st = idx >> 2, s = idx & 3, vh = st & 1, hq = (st >> 1) & 15, b = st >> 5, c = hq & 1, hv = (hq >> 1) * 2 + vh;
            attn_body::bf16* Oc = (attn_body::bf16*)(c ? O1 : O0);
#pragma unroll 1
            for (int i = 0; i < 4; ++i) { const int qb = (i == 0) ? 15 - s : (i == 1) ? s : (i == 2) ? 11 - s : 4 + s;
                attn_body::attn_unit<8>(b, hq, hv, qb, (const attn_body::bf16*)QB, (const attn_body::bf16*)KB, (const attn_body::bf16*)VB, Oc, (char*)lds, wave); }
        }
#endif
#endif
        { const int npass = (bid >= 64) ? ((wave < 4) ? 2 : 0) : 1;
          for (int u = vcu; u < NBATCH * (SEQL / 32); u += G)
#pragma unroll 1
              for (int ps = 0; ps < npass; ++ps) conv_unit(UB, conv_w, conv_b, conv_ln_g, conv_ln_b, MIX, u / (SEQL / 32), (u % (SEQL / 32)) * 32, tid + 256 * ps, ldsp + RING_OFF + wave * 16384); }
        if (bid < 64) __syncthreads();
        { pg8::Gemm g{KV, WCQ, 2 * DMODEL, DMODEL, 512, 4, (long)MEMLEN * 2 * DMODEL, 512, 0, 512}; pg8::TileOrder S; S.init(1, DMODEL / 256, 8, G, bid);
          pg8::EpiBf16S E{WKT, DMODEL, 4, (long)1024 * DMODEL, (long)256 * DMODEL, norm_cross_g, CROSS_SC}; RUN_GEMM(pg8::EpiBf16S, true, g, S, E); }
        if (bid >= 64 && wave >= 4) { const int nw = (G - 64) * 4; for (int it = (bid - 64) * 4 + (wave - 4); it < C_T / 2; it += 4 * nw) cvt8_item4<true>(peer_v, VTAB, it, nw, C_T / 2, VSCALE, lane); }
    }
    SEAM(2);

#if !(MK_ATTN128 && !MK_NAIVE_ATTN)
    if (IN(3)) REP(3) {
        const float l1 = wave_sum(lq1[lane] * lk1[lane]), l2 = wave_sum(lq2[lane] * lk2[lane]);
        const float lam = expf(l1) - expf(l2) + LAM_INIT;
        combine_rows(O0, O1, subln_g, lam, MIX, gw, NGW, lane);
    }
    SEAM_LOCAL(3);
#endif

    if (IN(4)) REP(4) {
        pg8::Gemm g{MIX, WOUTT, DMODEL, DMODEL, DMODEL, 1, 0, 0, 0, 0}; pg8::TileOrder S; S.init(NTOK / 256, DMODEL / 256, 1, G, bid);
        pg8::EpiRes<false> E{nullptr, ACT, PART1, 0}; RUN_GEMM(pg8::EpiRes<false>, true, g, S, E);
    }
    SEAM_LOCAL(4);

    if (IN(5)) REP(5) {
        { pg8::Gemm g{ACT, WKT, DMODEL, DMODEL, DMODEL, 1, (long)SEQL * DMODEL, 0, (long)1024 * DMODEL, 0}; pg8::TileOrder S; S.init(SEQL / 256, 4, NBATCH, G, bid < 128 ? bid : -1);
          LAS float* rt = (LAS float*)(ldsp + RSTD_OFF);
          pg8::EpiSoftmax E{rt, PB, SEQL, PART1}; RUN_GEMM(pg8::EpiSoftmax, false, g, S, E); }
        { pg8::Gemm g{WCOT, KV + DMODEL, DMODEL, 2 * DMODEL, 512, 4, 0, 512, (long)MEMLEN * 2 * DMODEL, 512}; pg8::TileOrder S; S.init(DMODEL / 256, 1, 8, G, (bid >= 128 && bid < 192) ? bid - 128 : -1);
          pg8::EpiBf16S E{VWT, 1024, 4, (long)DMODEL * 1024, 256, nullptr, 1.f}; RUN_GEMM(pg8::EpiBf16S, true, g, S, E); }
        { pg8::Gemm g{ABD, WPQ, 256, DMODEL, 256, 1, 65536, 0, 256, 0}; pg8::TileOrder S; S.init(1, DMODEL / 256, 8, G, (bid >= 192 && bid < 256) ? bid - 192 : -1);
          pg8::EpiBf16S E{WST, DMODEL, 1, (long)256 * DMODEL, 0, norm_peer_g, 1.f}; RUN_GEMM(pg8::EpiBf16S, true, g, S, E); }
        if (bid >= 128) { const int nw = (G - 128) * NWAVES; for (int it = C_T / 2 + (bid - 128) * NWAVES + wave; it < C_T; it += 4 * nw) cvt8_item4(peer_v, VTAB, it, nw, C_T, VSCALE, lane); }
        if (bid >= 128) { const int nw = (G - 128) * NWAVES; for (int it = C_T / 2 + (bid - 128) * NWAVES + wave; it < C_T; it += 4 * nw) cvt8_item4(peer_u, UTAB, it, nw, C_T, USCALE, lane); }
    }
    SEAM(5);

    if (IN(6)) REP(6) {
        pg8::Gemm g{PB, VWT, 1024, 1024, 1024, 1, (long)SEQL * 1024, 0, (long)DMODEL * 1024, 0}; pg8::TileOrder S; S.init(SEQL / 256, DMODEL / 256, NBATCH, G, bid);
        pg8::EpiRes<false> E{nullptr, ACT, PART2, SEQL}; RUN_GEMM(pg8::EpiRes<false>, true, g, S, E);
    }
    SEAM_LOCAL(6);

    if (IN(7)) REP(7) {
        pg8::Gemm g{ACT, WST, DMODEL, DMODEL, DMODEL, 1, 0, 0, 0, 0}; pg8::TileOrder S; S.init(NTOK / 256, DMODEL / 256, 1, G, bid);
        LAS float* rt = (LAS float*)(ldsp + RSTD_OFF);
#if MK_ROUTE_FUSED
        EpiRoute E{rt, (int*)SALL, SALL + (size_t)NTOK * 128, PART2}; RUN_GEMM(EpiRoute, false, g, S, E);
#else
        pg8::EpiScore E{rt, SALL}; RUN_GEMM(pg8::EpiScore, true, g, S, E);
#endif
    }
    SEAM_XCC(7);

    if (IN(8)) REP(8) { const int gwp = (G == 256) ? ((4 * (bid & 7) + ((bid >> 3) & 3)) * 64 + (bid >> 5) * 8 + wave) : gw;
        peer_phase(ACT, out, SALL, UTAB, VTAB, norm_peer_g, final_g, ldsp, gwp, NGW, wave, lane); }
#undef IN
#undef REP
#undef SEAM
#undef SEAM_LOCAL
}

#undef tid
#undef lane
extern "C" void kernel_launch(void* const* d_in, const int* in_sizes, int n_in, void* d_out, int out_size, void* d_ws, size_t ws_size, hipStream_t stream) {
    static int grid = 0;
    if (grid == 0) {
        if (n_in != 26 || in_sizes[0] != NTOK * DMODEL || out_size != NTOK * DMODEL || ws_size < WS_END) {
            fprintf(stderr, "kernel_launch: unexpected shapes (n_in %d, in0 %d, out %d, ws %zu); nothing launched\n", n_in, n_in > 0 ? in_sizes[0] : -1, out_size, ws_size); grid = -1; return; }
        int dev = 0, cus = 0, per_cu = 0;
        if (hipGetDevice(&dev) != hipSuccess || hipDeviceGetAttribute(&cus, hipDeviceAttributeMultiprocessorCount, dev) != hipSuccess) { fprintf(stderr, "kernel_launch: device query failed\n"); grid = -1; return; }
        if (hipFuncSetAttribute((const void*)mk_fwd, hipFuncAttributeMaxDynamicSharedMemorySize, LDS_BYTES) != hipSuccess) { fprintf(stderr, "kernel_launch: hipFuncSetAttribute failed\n"); grid = -1; return; }
        if (hipOccupancyMaxActiveBlocksPerMultiprocessor(&per_cu, (const void*)mk_fwd, NWAVES * 64, LDS_BYTES) != hipSuccess || per_cu < 1) {
            fprintf(stderr, "kernel_launch: occupancy query reports %d workgroups per CU; nothing launched\n", per_cu); (void)hipGetLastError(); grid = -1; return; }
        grid = cus;
        if (grid != 256) { fprintf(stderr, "kernel_launch: built for a 256-CU device, found %d CUs; nothing launched\n", cus); grid = -1; return; }
    }
    if (grid < 0) return;
    (void)hipMemsetAsync((char*)d_ws + WS_CTL, 0, CTL_ZERO_BYTES, stream);
    Args a{};
    for (int i = 0; i < 26; ++i) a.in[i] = (const float*)d_in[i];
    a.out = (float*)d_out; a.ws = (unsigned char*)d_ws;
#if MK_LAUNCH_PER_PHASE
    for (int p = 0; p < N_PHASES; ++p) for (int rep = 0; rep < 1 + ((MK_REPEAT_MASK >> p) & 1); ++rep) { a.ph_lo = p; a.ph_hi = p + 1; hipLaunchKernelGGL(mk_fwd, dim3(grid), dim3(NWAVES * 64), LDS_BYTES, stream, a); }
#else
    a.ph_lo = 0; a.ph_hi = N_PHASES; hipLaunchKernelGGL(mk_fwd, dim3(grid), dim3(NWAVES * 64), LDS_BYTES, stream, a);
#endif
}
```
